# Optimizing an MI355X kernel written in HIP

```python
import jax, jax.numpy as jnp
from jax import lax
import numpy as np

D_MODEL = 2048
BATCH = 2
SEQ = 16384
DEPTH = 2

CONV_DIM = 512
CONV_K = 3
MLA_HEADS = 8
QK_NOPE = 128
QK_ROPE = 64
QK_HEAD = QK_NOPE + QK_ROPE
V_DIM = 128
MLA_DIM = MLA_HEADS * V_DIM
Q_LORA = 512
KV_LORA = 256
ROPE_THETA = 10000.0
Q_BLOCK = 128
RWKV_HEADS = 8
RWKV_N = 64
RWKV_DIM = RWKV_HEADS * RWKV_N
DECAY_LORA = 64
A_LORA = 64
RWKV_SHIFT_SIZES = (RWKV_DIM, DECAY_LORA, RWKV_DIM, RWKV_DIM, A_LORA)
RWKV_SHIFT_DIM = 3 * RWKV_DIM + DECAY_LORA + A_LORA
RWKV_GN_EPS = 64e-5
MIX_DIM = CONV_DIM + MLA_DIM + RWKV_DIM
IN_SIZES = (CONV_DIM, CONV_DIM, CONV_DIM, CONV_DIM,
            Q_LORA, KV_LORA, QK_ROPE, MLA_DIM,
            RWKV_SHIFT_DIM, RWKV_DIM)
IN_TOTAL = sum(IN_SIZES)
LN_EPS = 1e-5
RMS_EPS = 1e-6
DEEPNORM_ALPHA = (2 * DEPTH) ** 0.25
DEEPNORM_BETA = (8 * DEPTH) ** -0.25

kernel_name = "hybrid_conv_mla_rwkv7_deepnorm"


def _split(u, sizes):
    idx, acc = [], 0
    for s in sizes[:-1]:
        acc += s
        idx.append(acc)
    return jnp.split(u, idx, axis=-1)


def _layer_norm(x, g, b):
    xf = x.astype(jnp.float32)
    mu = jnp.mean(xf, -1, keepdims=True)
    var = jnp.mean(jnp.square(xf - mu), -1, keepdims=True)
    return ((xf - mu) * lax.rsqrt(var + LN_EPS)).astype(x.dtype) * g + b


def _rms_norm(x, g):
    xf = x.astype(jnp.float32)
    return (xf * lax.rsqrt(jnp.mean(xf * xf, -1, keepdims=True) + RMS_EPS)).astype(x.dtype) * g


def _causal_shift(u, n):
    return jnp.pad(u, ((0, 0), (n, 0), (0, 0)))[:, :u.shape[1]]


def _rope(x, cos, sin):
    x1, x2 = jnp.split(x, 2, axis=-1)
    return jnp.concatenate([x1 * cos - x2 * sin, x2 * cos + x1 * sin], axis=-1)


def _short_conv_branch(b_gate, c_gate, h, gate, conv_w):
    u = c_gate * h
    S = u.shape[1]
    up = jnp.pad(u, ((0, 0), (CONV_K - 1, 0), (0, 0)))
    y = sum(conv_w[j] * up[:, j:j + S] for j in range(CONV_K))
    return b_gate * y * jax.nn.silu(gate)


def _causal_block_attention(q, k, v):
    B, S, H, D = q.shape
    n_blk = S // Q_BLOCK
    scale = D ** -0.5
    q_blocks = q.reshape(B, n_blk, Q_BLOCK, H, D).transpose(1, 0, 2, 3, 4)
    k_pos = jnp.arange(S)

    def one_block(args):
        qb, blk = args
        s = jnp.einsum('bqhd,bkhd->bhqk', qb, k, preferred_element_type=jnp.float32) * scale
        q_pos = blk * Q_BLOCK + jnp.arange(Q_BLOCK)
        s = jnp.where(k_pos[None, :] <= q_pos[:, None], s, -jnp.inf)
        p = jax.nn.softmax(s, axis=-1).astype(v.dtype)
        return jnp.einsum('bhqk,bkhd->bqhd', p, v)

    o = lax.map(one_block, (q_blocks, jnp.arange(n_blk)))
    return o.transpose(1, 0, 2, 3, 4).reshape(B, S, H, v.shape[-1])


def _mla_branch(c_q, c_kv, k_pe, gate, q_norm_g, w_uq, kv_norm_g, w_ukv, cos, sin):
    B, S, _ = c_q.shape
    q = (_rms_norm(c_q, q_norm_g) @ w_uq).reshape(B, S, MLA_HEADS, QK_HEAD)
    q_nope, q_pe = q[..., :QK_NOPE], q[..., QK_NOPE:]
    kv = (_rms_norm(c_kv, kv_norm_g) @ w_ukv).reshape(B, S, MLA_HEADS, QK_NOPE + V_DIM)
    k_nope, v = kv[..., :QK_NOPE], kv[..., QK_NOPE:]
    q = jnp.concatenate([q_nope, _rope(q_pe, cos, sin)], axis=-1)
    k_pe = _rope(k_pe[:, :, None, :], cos, sin)
    k = jnp.concatenate([k_nope, jnp.broadcast_to(k_pe, (B, S, MLA_HEADS, QK_ROPE))], axis=-1)
    o = _causal_block_attention(q, k, v)
    return o.reshape(B, S, MLA_DIM) * jax.nn.silu(gate)


def _rwkv7_scan(r, decay, k, v, a_vec, b_vec):
    B, S, H, N = r.shape
    xs = tuple(t.astype(jnp.float32).transpose(1, 0, 2, 3) for t in (r, decay, k, v, a_vec, b_vec))

    def step(state, inp):
        r_t, w_t, k_t, v_t, a_t, b_t = inp
        sa = jnp.einsum('bhvk,bhk->bhv', state, a_t)
        state = (state * w_t[:, :, None, :] + sa[..., None] * b_t[:, :, None, :]
                 + v_t[..., None] * k_t[:, :, None, :])
        return state, jnp.einsum('bhvk,bhk->bhv', state, r_t)

    s0 = jnp.zeros((B, H, N, N), jnp.float32)
    _, y = lax.scan(step, s0, xs)
    return y.transpose(1, 0, 2, 3).astype(r.dtype)


def _rwkv7_branch(shift_cols, gate, mu, w0, w2, a0, a2, k_k, k_a, r_k, gn_g, gn_b):
    B, S, _ = shift_cols.shape
    xs = shift_cols + (_causal_shift(shift_cols, 1) - shift_cols) * mu
    r, wd, k, v, ad = _split(xs, RWKV_SHIFT_SIZES)
    w = -jax.nn.softplus(-(w0 + jnp.tanh(wd) @ w2)) - 0.5
    decay = jnp.exp(-jnp.exp(w.astype(jnp.float32)))
    a = jax.nn.sigmoid(a0 + ad @ a2)
    kk = (k * k_k).reshape(B, S, RWKV_HEADS, RWKV_N).astype(jnp.float32)
    kk = (kk / jnp.maximum(jnp.linalg.norm(kk, axis=-1, keepdims=True), 1e-12)).astype(k.dtype)
    k = k * (1 + (a - 1) * k_a)
    hs = lambda t: t.reshape(B, S, RWKV_HEADS, RWKV_N)
    r, k, v, a, decay = hs(r), hs(k), hs(v), hs(a), hs(decay)
    y = _rwkv7_scan(r, decay, k, v, -kk, kk * a)
    yf = y.astype(jnp.float32)
    ym = jnp.mean(yf, -1, keepdims=True)
    yv = jnp.mean(jnp.square(yf - ym), -1, keepdims=True)
    y = ((yf - ym) * lax.rsqrt(yv + RWKV_GN_EPS)).astype(v.dtype)
    y = y * gn_g.reshape(RWKV_HEADS, RWKV_N) + gn_b.reshape(RWKV_HEADS, RWKV_N)
    y = y + jnp.sum(r * k * r_k, axis=-1, keepdims=True) * v
    return y.reshape(B, S, RWKV_DIM) * jax.nn.silu(gate)


def setup_inputs(seed: int = 0) -> dict:
    key = jax.random.key(seed)
    ks = jax.random.split(key, 24)
    n = lambda i, shape: jax.random.normal(ks[i], shape, jnp.float32)
    L = DEPTH
    x = n(0, (BATCH, SEQ, D_MODEL))
    positions = (jnp.arange(SEQ, dtype=jnp.int32)[None, :]
                 + jax.random.randint(ks[1], (BATCH, 1), 0, 4096, dtype=jnp.int32))
    return {
        "x": x,
        "positions": positions,
        "w_in": n(2, (L, D_MODEL, IN_TOTAL)) * D_MODEL ** -0.5,
        "conv_w": n(3, (L, CONV_K, CONV_DIM)) * CONV_K ** -0.5,
        "q_norm_g": 1.0 + 0.02 * n(4, (L, Q_LORA)),
        "w_uq": n(5, (L, Q_LORA, MLA_HEADS * QK_HEAD)) * Q_LORA ** -0.5,
        "kv_norm_g": 1.0 + 0.02 * n(6, (L, KV_LORA)),
        "w_ukv": n(7, (L, KV_LORA, MLA_HEADS * (QK_NOPE + V_DIM))) * KV_LORA ** -0.5,
        "rwkv_mu": jax.random.uniform(ks[8], (L, RWKV_SHIFT_DIM), jnp.float32),
        "rwkv_w0": 0.3 * n(9, (L, RWKV_DIM)),
        "rwkv_w2": n(10, (L, DECAY_LORA, RWKV_DIM)) * 0.5 * DECAY_LORA ** -0.5,
        "rwkv_a0": 0.3 * n(11, (L, RWKV_DIM)),
        "rwkv_a2": n(12, (L, A_LORA, RWKV_DIM)) * 0.5 * A_LORA ** -0.5,
        "rwkv_k_k": 0.85 + 0.05 * n(13, (L, RWKV_DIM)),
        "rwkv_k_a": 1.0 + 0.05 * n(14, (L, RWKV_DIM)),
        "rwkv_r_k": 0.1 * n(15, (L, RWKV_HEADS, RWKV_N)),
        "rwkv_gn_g": 1.0 + 0.02 * n(16, (L, RWKV_DIM)),
        "rwkv_gn_b": 0.02 * n(17, (L, RWKV_DIM)),
        "w_out": n(18, (L, MIX_DIM, D_MODEL)) * MIX_DIM ** -0.5 * DEEPNORM_BETA,
        "ln_g": 1.0 + 0.02 * n(19, (L, D_MODEL)),
        "ln_b": 0.02 * n(20, (L, D_MODEL)),
    }


def reference(x, positions, w_in, conv_w, q_norm_g, w_uq, kv_norm_g, w_ukv,
              rwkv_mu, rwkv_w0, rwkv_w2, rwkv_a0, rwkv_a2, rwkv_k_k, rwkv_k_a,
              rwkv_r_k, rwkv_gn_g, rwkv_gn_b, w_out, ln_g, ln_b):
    inv_freq = ROPE_THETA ** (-jnp.arange(0, QK_ROPE, 2, dtype=jnp.float32) / QK_ROPE)
    ang = positions.astype(jnp.float32)[..., None] * inv_freq
    cos = jnp.cos(ang)[:, :, None, :].astype(x.dtype)
    sin = jnp.sin(ang)[:, :, None, :].astype(x.dtype)

    for l in range(DEPTH):
        u = x @ w_in[l]
        (cb, cc, ch, cg, cq, ckv, kpe, mg, rcols, rg) = _split(u, IN_SIZES)
        y_conv = _short_conv_branch(cb, cc, ch, cg, conv_w[l])
        y_mla = _mla_branch(cq, ckv, kpe, mg, q_norm_g[l], w_uq[l],
                            kv_norm_g[l], w_ukv[l], cos, sin)
        y_rwkv = _rwkv7_branch(rcols, rg, rwkv_mu[l], rwkv_w0[l], rwkv_w2[l],
                               rwkv_a0[l], rwkv_a2[l], rwkv_k_k[l], rwkv_k_a[l],
                               rwkv_r_k[l], rwkv_gn_g[l], rwkv_gn_b[l])
        mix = jnp.concatenate([y_conv, y_mla, y_rwkv], axis=-1)
        x = _layer_norm(DEEPNORM_ALPHA * x + mix @ w_out[l], ln_g[l], ln_b[l])
    return x
```

```cpp
#include <hip/hip_runtime.h>
#include <hip/hip_cooperative_groups.h>
#include <cstdio>
#include <cstdint>
#include <cmath>
namespace cg = cooperative_groups;

#define LAS __attribute__((address_space(3)))
typedef unsigned short bf16_t;
typedef short bf16x8 __attribute__((ext_vector_type(8)));
typedef short s16x4 __attribute__((ext_vector_type(4)));
typedef float f32x4 __attribute__((ext_vector_type(4)));
typedef float f32x2 __attribute__((ext_vector_type(2)));
typedef float f32x16 __attribute__((ext_vector_type(16)));
typedef unsigned u32x4 __attribute__((ext_vector_type(4)));
typedef unsigned u32x2 __attribute__((ext_vector_type(2)));
typedef __bf16 bf16x2_t __attribute__((ext_vector_type(2)));

constexpr int T = 32768, SEQ = 16384, DM = 2048, NIN = 6080, LDU = 6144, DEPTH = 2;
constexpr int C_CB = 0, C_CC = 512, C_CH = 1024, C_CG = 1536, C_CQ = 2048, C_CKV = 2560, C_KPE = 2816, C_MG = 2880, C_RC = 3904, C_RG = 5568;
constexpr int NHEAD = 8;
constexpr float LN_EPS = 1e-5f, RMS_EPS = 1e-6f, GN_EPS = 64e-5f;
constexpr float ALPHA = 1.4142135623730951f;
constexpr float QSCALE = 0.07216878364870323f * 1.4426950408889634f;

constexpr size_t MiB = 1u << 20;
constexpr size_t WS_CTL = 0, WS_WIN = 1 * MiB, WS_WOUT = 25 * MiB, WS_WUQ = 33 * MiB, WS_WUK = 35 * MiB, WS_WUV = 36 * MiB, WS_RS = 37 * MiB,
                 WS_SC2 = 38 * MiB, WS_COS = 42 * MiB, WS_SIN = 46 * MiB, WS_U = 50 * MiB, WS_MIX = 434 * MiB, WS_XB = 562 * MiB, WS_Q = 562 * MiB,
                 WS_KPE = 658 * MiB, WS_KN = 690 * MiB, WS_VT = 754 * MiB, WS_SCAN = 818 * MiB, WS_END = 1010 * MiB;

constexpr int LDS_BYTES = 131072 + 256, LDS_MISC = 131072;

struct Params {
    const float* x; const int* pos; const float* w_in; const float* conv_w; const float* q_norm_g; const float* w_uq; const float* kv_norm_g; const float* w_ukv;
    const float* mu; const float* w0; const float* w2; const float* a0; const float* a2; const float* k_k; const float* k_a; const float* r_k; const float* gn_g; const float* gn_b;
    const float* w_out; const float* ln_g; const float* ln_b;
    float* out; unsigned char* ws;
    float inv_freq[32];
};

typedef const __attribute__((address_space(4))) Params* KP;
#define KP_FENCE(p) asm volatile("" : "+s"(p))
__device__ __forceinline__ float bf2f(unsigned short v) { return __uint_as_float(((unsigned)v) << 16); }
__device__ __forceinline__ unsigned f2bf(float f) { unsigned u = __float_as_uint(f); return (u + 0x7fffu + ((u >> 16) & 1u)) >> 16; }
__device__ __forceinline__ unsigned pk2(float lo, float hi) { f32x2 v = {lo, hi}; bf16x2_t b = __builtin_convertvector(v, bf16x2_t); return __builtin_bit_cast(unsigned, b); }
__device__ __forceinline__ float silu_f(float x) { return x / (1.f + __expf(-x)); }
__device__ __forceinline__ float dppf(float v, int ctrl) { return v; }
template <int CTRL> __device__ __forceinline__ float dpp_mov(float v) { return __int_as_float(__builtin_amdgcn_update_dpp(__float_as_int(v), __float_as_int(v), CTRL, 0xf, 0xf, false)); }
__device__ __forceinline__ float row16_sum(float v) {
    v += dpp_mov<0xB1>(v);
    v += dpp_mov<0x4E>(v);
    v += dpp_mov<0x141>(v);
    v += dpp_mov<0x140>(v);
    return v;
}
__device__ __forceinline__ float wave_sum(float v) { v = row16_sum(v); v += __shfl_xor(v, 16); v += __shfl_xor(v, 32); return v; }

#ifndef PH
#define PH 0xffff
#endif
namespace pg8 {
constexpr int BM = 256, BK = 64, HALF = 128, HTB = HALF * BK * 2, STAGE_BYTES = 8 * HTB, NXCD = 8, WGM = 8;
__host__ __device__ __forceinline__ int lds_byte(int r, int c) { const int st = (r >> 4) * 2 + (c >> 5), rr = r & 15, cc = c & 31, ob = rr * 64 + cc * 2; return st * 1024 + (ob ^ (((ob >> 9) & 1) << 5)); }
__host__ __device__ __forceinline__ void stage_rc(int b, int& R, int& C) { const int st = b / 1024, sb = b % 1024, swz = sb ^ (((sb >> 9) & 1) << 5); R = (st >> 1) * 16 + swz / 64; C = (st & 1) * 32 + (swz % 64) / 2; }
__host__ __device__ __forceinline__ int perm32(int rho) { const int n = rho >> 4, i = rho & 15; return 8 * (i >> 2) + 4 * n + (i & 3); }
struct Unit { int pm, pn; };
struct Gemm { const bf16_t* A; const bf16_t* Bt; int M, N, K, lda, ldb; };
struct StaticOrder {
    int nM, nN, nwg, G, c;
    __device__ void init(int M, int N, int G_, int c_) { nM = M / BM; nN = N / BM; nwg = nM * nN; G = G_; c = c_; }
    __device__ bool next(int i, Unit& u) const {
        const long L = (long)i * G + c; if (L >= nwg) return false;
        int wgid = (int)L; { const int q = nwg / NXCD, r = nwg % NXCD, xcd = wgid % NXCD, off = wgid / NXCD; wgid = (xcd < r ? xcd * (q + 1) : r * (q + 1) + (xcd - r) * q) + off; }
        const int nig = WGM * nN, gid = wgid / nig, fm = gid * WGM, gsz = (nM - fm) < WGM ? (nM - fm) : WGM;
        u.pm = fm + ((wgid % nig) % gsz); u.pn = (wgid % nig) / gsz; return true;
    }
};
template <class Epi>
__device__ __forceinline__ void gemm_phase(LAS unsigned char* lds, const Gemm g, const StaticOrder& S, const Epi& E) {
    int tid = threadIdx.x; asm volatile("" : "+v"(tid));
    const int wid = __builtin_amdgcn_readfirstlane(tid >> 6), lane = tid & 63, wr = wid >> 2, wc = wid & 3, fr = lane & 15, fq = lane >> 4;
    int K = g.K; asm volatile("" : "+s"(K));
    const int nt = K / BK;
    unsigned voffA[2], voffB[2];
#pragma unroll
    for (int i = 0; i < 2; ++i) { int R, C; stage_rc(tid * 16 + i * 8192, R, C); const int Rb = Epi::PERM ? ((R & ~31) + perm32(R & 31)) : R;
        voffA[i] = (unsigned)(R * g.lda + C) * 2u; voffB[i] = (unsigned)(Rb * g.ldb + C) * 2u; }
    const size_t kstep = (size_t)(BK * 2);
    const size_t hstepA = (size_t)HALF * g.lda * 2, hstepB = (size_t)HALF * g.ldb * 2;
    const size_t tstepA = 2 * hstepA, tstepB = 2 * hstepB;
    const unsigned ldsw = (unsigned)wid * 1024u;
    const int aoff = lds_byte(wr * 64 + fr, fq * 8), boff = lds_byte(wc * 32 + fr, fq * 8);
#define PG8_SA(b, h) (((b) * 2 + (h)) * HTB)
#define PG8_SB(b, h) ((4 + (b) * 2 + (h)) * HTB)
#define PG8_STAGE(bufoff, gbase, voff) do { _Pragma("unroll") for (int _i = 0; _i < 2; ++_i) \
        __builtin_amdgcn_global_load_lds((const unsigned*)((const char*)(gbase) + (voff)[_i]), (LAS unsigned*)(lds + (bufoff) + ldsw + _i * 8192), 16, 0, 0); } while (0)
#define PG8_LDA(dst, b, h) do { _Pragma("unroll") for (int m = 0; m < 4; ++m) _Pragma("unroll") for (int k = 0; k < 2; ++k) dst[m][k] = *(const LAS bf16x8*)(lds + PG8_SA(b, h) + aoff + m * 2048 + k * 1024); } while (0)
#define PG8_LDB(dst, b, h) do { _Pragma("unroll") for (int n = 0; n < 2; ++n) _Pragma("unroll") for (int k = 0; k < 2; ++k) dst[n][k] = *(const LAS bf16x8*)(lds + PG8_SB(b, h) + boff + n * 2048 + k * 1024); } while (0)
#define PG8_MMA(ai, bj, At, Bt) do { __builtin_amdgcn_s_setprio(1); _Pragma("unroll") for (int m = 0; m < 4; ++m) _Pragma("unroll") for (int n = 0; n < 2; ++n) _Pragma("unroll") for (int k = 0; k < 2; ++k) \
        acc[ai][bj][m][n] = __builtin_amdgcn_mfma_f32_16x16x32_bf16(Bt[n][k], At[m][k], acc[ai][bj][m][n], 0, 0, 0); __builtin_amdgcn_s_setprio(0); } while (0)
#define PG8_WAIT_V(n) asm volatile("s_waitcnt vmcnt(" #n ")" ::: "memory")
#define PG8_WAIT_L(n) asm volatile("s_waitcnt lgkmcnt(" #n ")" ::: "memory")
#define PG8_BAR __builtin_amdgcn_s_barrier()
#define PG8_SCHED __builtin_amdgcn_sched_barrier(0)
    Unit cur, nxt; int ui = 0;
    if (!S.next(0, cur)) return;
    f32x4 acc[2][2][4][2];
#pragma unroll
    for (int a = 0; a < 2; ++a)
#pragma unroll
        for (int b = 0; b < 2; ++b)
#pragma unroll
            for (int m = 0; m < 4; ++m)
#pragma unroll
                for (int n = 0; n < 2; ++n) acc[a][b][m][n] = (f32x4){0.f, 0.f, 0.f, 0.f};
    bf16x8 At[4][2], B0[2][2], B1[2][2];
    const char* cA = (const char*)g.A + (size_t)cur.pm * tstepA; const char* cB = (const char*)g.Bt + (size_t)cur.pn * tstepB;
    PG8_STAGE(PG8_SB(0, 0), cB, voffB); PG8_STAGE(PG8_SB(0, 1), cB + hstepB, voffB); PG8_STAGE(PG8_SA(0, 0), cA, voffA); PG8_STAGE(PG8_SA(0, 1), cA + hstepA, voffA);
    if (wr == 1) PG8_BAR;
    PG8_WAIT_V(2); PG8_BAR;
    PG8_STAGE(PG8_SB(1, 0), cB + kstep, voffB); PG8_STAGE(PG8_SA(1, 0), cA + kstep, voffA); PG8_STAGE(PG8_SB(1, 1), cB + hstepB + kstep, voffB);
    PG8_WAIT_V(6); PG8_BAR;
    for (;;) {
        const bool has_next = S.next(ui + 1, nxt);
        const char* nA = has_next ? (const char*)g.A + (size_t)nxt.pm * tstepA : cA; const char* nB = has_next ? (const char*)g.Bt + (size_t)nxt.pn * tstepB : cB;
        for (int t = 0; t < nt; t += 2) {
            const bool last = (t == nt - 2);
            const char* a1 = cA + (size_t)(t + 1) * kstep;
            const char* a2 = last ? nA : cA + (size_t)(t + 2) * kstep; const char* b2 = last ? nB : cB + (size_t)(t + 2) * kstep;
            const char* a3 = a2 + kstep; const char* b3 = b2 + kstep;
            PG8_LDB(B0, 0, 0); PG8_LDB(B1, 0, 1); PG8_SCHED; PG8_LDA(At, 0, 0); PG8_STAGE(PG8_SA(1, 1), a1 + hstepA, voffA);
            PG8_WAIT_V(8); PG8_WAIT_L(0); PG8_BAR; PG8_MMA(0, 0, At, B0); PG8_MMA(0, 1, At, B1); PG8_BAR; PG8_SCHED;
            PG8_LDA(At, 0, 1); PG8_STAGE(PG8_SB(0, 0), b2, voffB); PG8_STAGE(PG8_SB(0, 1), b2 + hstepB, voffB); PG8_STAGE(PG8_SA(0, 0), a2, voffA);
            PG8_WAIT_V(8); PG8_WAIT_L(0); PG8_BAR; PG8_MMA(1, 0, At, B0); PG8_MMA(1, 1, At, B1); PG8_BAR; PG8_SCHED;
            PG8_LDB(B0, 1, 0); PG8_LDB(B1, 1, 1); PG8_SCHED; PG8_LDA(At, 1, 0); PG8_STAGE(PG8_SA(0, 1), a2 + hstepA, voffA);
            PG8_WAIT_V(8); PG8_WAIT_L(0); PG8_BAR; PG8_MMA(0, 0, At, B0); PG8_MMA(0, 1, At, B1); PG8_BAR; PG8_SCHED;
            PG8_LDA(At, 1, 1); PG8_STAGE(PG8_SB(1, 0), b3, voffB); PG8_STAGE(PG8_SB(1, 1), b3 + hstepB, voffB); PG8_STAGE(PG8_SA(1, 0), a3, voffA);
            PG8_WAIT_V(8); PG8_WAIT_L(0); PG8_BAR; PG8_MMA(1, 0, At, B0); PG8_MMA(1, 1, At, B1); PG8_BAR; PG8_SCHED;
        }
        if (wr == 0) PG8_BAR;
        E(acc, cur, wr, wc, fr, fq);
        if (!has_next) break;
#pragma unroll
        for (int a = 0; a < 2; ++a)
#pragma unroll
            for (int b = 0; b < 2; ++b)
#pragma unroll
                for (int m = 0; m < 4; ++m)
#pragma unroll
                    for (int n = 0; n < 2; ++n) acc[a][b][m][n] = (f32x4){0.f, 0.f, 0.f, 0.f};
        cur = nxt; cA = nA; cB = nB; ++ui;
        if (wr == 1) PG8_BAR;
    }
    PG8_WAIT_V(0);
    PG8_BAR;
#undef PG8_SA
#undef PG8_SB
#undef PG8_STAGE
#undef PG8_LDA
#undef PG8_LDB
#undef PG8_MMA
#undef PG8_WAIT_V
#undef PG8_WAIT_L
#undef PG8_BAR
#undef PG8_SCHED
}

struct EpiU {
    static constexpr bool PERM = true;
    bf16_t* O; int ldc;
    __device__ __forceinline__ void operator()(const f32x4 (&acc)[2][2][4][2], const Unit& u, int wr, int wc, int fr, int fq) const {
        const int row0 = u.pm * BM + wr * 64 + fr, col0 = u.pn * BM + wc * 32 + 8 * fq;
#pragma unroll
        for (int ai = 0; ai < 2; ++ai)
#pragma unroll
            for (int m = 0; m < 4; ++m) { bf16_t* rowp = O + (size_t)(row0 + ai * HALF + m * 16) * ldc + col0;
#pragma unroll
                for (int bj = 0; bj < 2; ++bj) { const f32x4 v0 = acc[ai][bj][m][0], v1 = acc[ai][bj][m][1];
                    u32x4 w; w.x = pk2(v0[0], v0[1]); w.y = pk2(v0[2], v0[3]); w.z = pk2(v1[0], v1[1]); w.w = pk2(v1[2], v1[3]);
                    *(u32x4*)(rowp + bj * HALF) = w; }
                asm volatile("" ::: "memory"); }
    }
};
struct EpiRowScale {
    static constexpr bool PERM = true;
    bf16_t* O; int ldc; const float* rs; float sc;
    __device__ __forceinline__ void operator()(const f32x4 (&acc)[2][2][4][2], const Unit& u, int wr, int wc, int fr, int fq) const {
        const int row0 = u.pm * BM + wr * 64 + fr, col0 = u.pn * BM + wc * 32 + 8 * fq;
#pragma unroll
        for (int ai = 0; ai < 2; ++ai)
#pragma unroll
            for (int m = 0; m < 4; ++m) { const int row = row0 + ai * HALF + m * 16; const float s = rs[row] * sc; bf16_t* rowp = O + (size_t)row * ldc + col0;
#pragma unroll
                for (int bj = 0; bj < 2; ++bj) { const f32x4 v0 = acc[ai][bj][m][0] * s, v1 = acc[ai][bj][m][1] * s;
                    u32x4 w; w.x = pk2(v0[0], v0[1]); w.y = pk2(v0[2], v0[3]); w.z = pk2(v1[0], v1[1]); w.w = pk2(v1[2], v1[3]);
                    *(u32x4*)(rowp + bj * HALF) = w; }
                asm volatile("" ::: "memory"); }
    }
};
struct EpiQ {
    static constexpr bool PERM = true;
    bf16_t* O; const float* rs; const float* cosT; const float* sinT;
    __device__ __forceinline__ void operator()(const f32x4 (&acc)[2][2][4][2], const Unit& u, int wr, int wc, int fr, int fq) const {
        const int row0 = u.pm * BM + wr * 64 + fr, col0 = u.pn * BM + wc * 32 + 8 * fq;
#pragma unroll
        for (int ai = 0; ai < 2; ++ai)
#pragma unroll
            for (int m = 0; m < 4; ++m) { const int row = row0 + ai * HALF + m * 16; const float s = rs[row] * QSCALE; bf16_t* rowp = O + (size_t)row * 1536 + col0;
#pragma unroll
                for (int bj = 0; bj < 2; ++bj) { f32x4 v0 = acc[ai][bj][m][0] * s, v1 = acc[ai][bj][m][1] * s;
                    const int cin = (col0 + bj * HALF) % 192;
                    if (cin >= 128) { const int j0 = (cin - 128) >> 1;
                        const f32x4 c = *(const f32x4*)(cosT + (size_t)row * 32 + j0), sn = *(const f32x4*)(sinT + (size_t)row * 32 + j0);
                        f32x4 r0, r1;
                        r0[0] = v0[0] * c[0] - v0[1] * sn[0]; r0[1] = v0[1] * c[0] + v0[0] * sn[0];
                        r0[2] = v0[2] * c[1] - v0[3] * sn[1]; r0[3] = v0[3] * c[1] + v0[2] * sn[1];
                        r1[0] = v1[0] * c[2] - v1[1] * sn[2]; r1[1] = v1[1] * c[2] + v1[0] * sn[2];
                        r1[2] = v1[2] * c[3] - v1[3] * sn[3]; r1[3] = v1[3] * c[3] + v1[2] * sn[3];
                        v0 = r0; v1 = r1; }
                    u32x4 w; w.x = pk2(v0[0], v0[1]); w.y = pk2(v0[2], v0[3]); w.z = pk2(v1[0], v1[1]); w.w = pk2(v1[2], v1[3]);
                    *(u32x4*)(rowp + bj * HALF) = w; }
                asm volatile("" ::: "memory"); }
    }
};
struct EpiColScale {
    static constexpr bool PERM = true;
    bf16_t* O; int ldc; const float* cs;
    __device__ __forceinline__ void operator()(const f32x4 (&acc)[2][2][4][2], const Unit& u, int wr, int wc, int fr, int fq) const {
        const int row0 = u.pm * BM + wr * 64 + fr, col0 = u.pn * BM + wc * 32 + 8 * fq;
        f32x4 sv[2][2];
#pragma unroll
        for (int bj = 0; bj < 2; ++bj)
#pragma unroll
            for (int n = 0; n < 2; ++n) sv[bj][n] = *(const f32x4*)(cs + col0 + bj * HALF + 4 * n);
#pragma unroll
        for (int ai = 0; ai < 2; ++ai)
#pragma unroll
            for (int m = 0; m < 4; ++m) { bf16_t* rowp = O + (size_t)(row0 + ai * HALF + m * 16) * ldc + col0;
#pragma unroll
                for (int bj = 0; bj < 2; ++bj) { const f32x4 v0 = acc[ai][bj][m][0] * sv[bj][0], v1 = acc[ai][bj][m][1] * sv[bj][1];
                    u32x4 w; w.x = pk2(v0[0], v0[1]); w.y = pk2(v0[2], v0[3]); w.z = pk2(v1[0], v1[1]); w.w = pk2(v1[2], v1[3]);
                    *(u32x4*)(rowp + bj * HALF) = w; }
                asm volatile("" ::: "memory"); }
    }
};
struct EpiRes {
    static constexpr bool PERM = false;
    float* C; const float* res;
    __device__ __forceinline__ void operator()(const f32x4 (&acc)[2][2][4][2], const Unit& u, int wr, int wc, int fr, int fq) const {
        const int row0 = u.pm * BM + wr * 64 + fr, col0 = u.pn * BM + wc * 32 + 4 * fq;
#pragma unroll
        for (int ai = 0; ai < 2; ++ai)
#pragma unroll
            for (int m = 0; m < 4; ++m) { const size_t ro = (size_t)(row0 + ai * HALF + m * 16) * DM + col0;
#pragma unroll
                for (int bj = 0; bj < 2; ++bj)
#pragma unroll
                    for (int n = 0; n < 2; ++n) { const f32x4 r = *(const f32x4*)(res + ro + bj * HALF + n * 16);
                        *(f32x4*)(C + ro + bj * HALF + n * 16) = r * ALPHA + acc[ai][bj][m][n]; } }
    }
};
}

__device__ __forceinline__ int wmap_col(int kind, int n) {
    if (kind == 0) return n < NIN ? n : -1;
    if (kind == 1) return n;
    if (kind == 2) { const int h = n / 192, c = n % 192; if (c < 128) return n; const int j = (c - 128) >> 1, e = (c - 128) & 1; return h * 192 + 128 + j + 32 * e; }
    if (kind == 3) { const int h = n >> 7, c = n & 127; return h * 256 + c; }
    { const int h = n >> 7, c = n & 127; return h * 256 + 128 + c; }
}
__device__ __forceinline__ void convert_weights(KP p, int l, LAS unsigned char* lds) {
    KP_FENCE(p);
    int tid = threadIdx.x; asm volatile("" : "+v"(tid));
    const int tx = tid & 63, ty = tid >> 6;
    LAS float* tile = (LAS float*)lds;
    const int nK[5] = {32, 32, 8, 4, 4}, nN[5] = {96, 32, 24, 16, 16};
    const int start1 = nK[0] * nN[0], start2 = start1 + nK[1] * nN[1], start3 = start2 + nK[2] * nN[2], start4 = start3 + nK[3] * nN[3], total = start4 + nK[4] * nN[4];
    for (int it = blockIdx.x; it < total; it += gridDim.x) {
        int kind, loc;
        if (it < start1) { kind = 0; loc = it; } else if (it < start2) { kind = 1; loc = it - start1; } else if (it < start3) { kind = 2; loc = it - start2; }
        else if (it < start4) { kind = 3; loc = it - start3; } else { kind = 4; loc = it - start4; }
        const float* src; bf16_t* dst; const float* g = nullptr; int K, Nsrc, nnt;
        if (kind == 0) { src = p->w_in + (size_t)l * DM * NIN; dst = (bf16_t*)(p->ws + WS_WIN); K = 2048; Nsrc = NIN; nnt = 96; }
        else if (kind == 1) { src = p->w_out + (size_t)l * DM * DM; dst = (bf16_t*)(p->ws + WS_WOUT); K = 2048; Nsrc = DM; nnt = 32; }
        else if (kind == 2) { src = p->w_uq + (size_t)l * 512 * 1536; dst = (bf16_t*)(p->ws + WS_WUQ); K = 512; Nsrc = 1536; nnt = 24; g = p->q_norm_g + l * 512; }
        else if (kind == 3) { src = p->w_ukv + (size_t)l * 256 * 2048; dst = (bf16_t*)(p->ws + WS_WUK); K = 256; Nsrc = 2048; nnt = 16; g = p->kv_norm_g + l * 256; }
        else { src = p->w_ukv + (size_t)l * 256 * 2048; dst = (bf16_t*)(p->ws + WS_WUV); K = 256; Nsrc = 2048; nnt = 16; g = p->kv_norm_g + l * 256; }
        const int n0 = (loc % nnt) * 64, k0 = (loc / nnt) * 64;
        const int sc = wmap_col(kind, n0 + tx);
#pragma unroll
        for (int i = 0; i < 8; ++i) { const int k = k0 + ty * 8 + i; float v = 0.f; if (sc >= 0) v = src[(size_t)k * Nsrc + sc]; if (g) v *= g[k]; tile[(ty * 8 + i) * 65 + tx] = v; }
        __syncthreads();
#pragma unroll
        for (int i = 0; i < 8; ++i) { const int n = n0 + ty * 8 + i; dst[(size_t)n * K + k0 + tx] = (bf16_t)f2bf(tile[tx * 65 + ty * 8 + i]); }
        __syncthreads();
    }
}

__device__ __forceinline__ void phase_p0(KP p, LAS unsigned char* lds) {
    KP_FENCE(p);
    const int tid = threadIdx.x;
    if (blockIdx.x == 0 && tid < 64) ((unsigned*)(p->ws + WS_CTL))[tid] = 0u;
    convert_weights(p, 0, lds);
    bf16_t* xb = (bf16_t*)(p->ws + WS_XB);
    const size_t n4 = (size_t)T * DM / 4;
    for (size_t i = (size_t)blockIdx.x * 512 + tid; i < n4; i += (size_t)gridDim.x * 512) {
        const f32x4 v = *(const f32x4*)(p->x + i * 4); u32x2 w; w.x = pk2(v[0], v[1]); w.y = pk2(v[2], v[3]); *(u32x2*)(xb + i * 4) = w; }
    float* cosT = (float*)(p->ws + WS_COS); float* sinT = (float*)(p->ws + WS_SIN);
    for (int i = blockIdx.x * 512 + tid; i < T * 32; i += gridDim.x * 512) {
        const int t = i >> 5, j = i & 31;
        const float ang = (float)p->pos[t] * p->inv_freq[j];
        double rev = (double)ang * 0.15915494309189535; rev -= rint(rev);
        cosT[i] = __builtin_amdgcn_cosf((float)rev); sinT[i] = __builtin_amdgcn_sinf((float)rev);
    }
}

__device__ __forceinline__ void phase_prep(KP p, int l, LAS unsigned char* lds) {
    KP_FENCE(p);
    int tid = threadIdx.x; asm volatile("" : "+v"(tid));
    const int lane = tid & 63, wave = tid >> 6, c = tid;
    const bf16_t* U = (const bf16_t*)(p->ws + WS_U);
    bf16_t* MIX = (bf16_t*)(p->ws + WS_MIX); bf16_t* KPEB = (bf16_t*)(p->ws + WS_KPE); bf16_t* SCAN = (bf16_t*)(p->ws + WS_SCAN);
    float* SC2 = (float*)(p->ws + WS_SC2); float* RSQ = (float*)(p->ws + WS_RS); float* RSKV = RSQ + T;
    const float* cosT = (const float*)(p->ws + WS_COS); const float* sinT = (const float*)(p->ws + WS_SIN);
    LAS float* sth = (LAS float*)lds;
    LAS float* spart = (LAS float*)(lds + 4096);
    float w2r[64], a2r[64];
#pragma unroll
    for (int j = 0; j < 64; ++j) { w2r[j] = p->w2[(size_t)l * 64 * 512 + j * 512 + c]; a2r[j] = p->a2[(size_t)l * 64 * 512 + j * 512 + c]; }
    const float* mu = p->mu + l * 1664;
    const float mu_r = mu[c], mu_k = mu[576 + c], mu_v = mu[1088 + c];
    const float w0c = p->w0[l * 512 + c], a0c = p->a0[l * 512 + c], kkc = p->k_k[l * 512 + c], kac = p->k_a[l * 512 + c], rkc = p->r_k[l * 512 + c];
    const float cw0 = p->conv_w[(l * 3 + 0) * 512 + c], cw1 = p->conv_w[(l * 3 + 1) * 512 + c], cw2 = p->conv_w[(l * 3 + 2) * 512 + c];
    for (int tile = blockIdx.x; tile < T / 128; tile += gridDim.x) {
        const int t0 = tile * 128; const bool first = (t0 % SEQ) == 0;
        float pr = 0.f, pk = 0.f, pv = 0.f, pu1 = 0.f, pu2 = 0.f;
        if (!first) { const bf16_t* up = U + (size_t)(t0 - 1) * LDU; pr = bf2f(up[C_RC + c]); pk = bf2f(up[C_RC + 576 + c]); pv = bf2f(up[C_RC + 1088 + c]);
            pu1 = bf2f(up[C_CC + c]) * bf2f(up[C_CH + c]); const bf16_t* up2 = up - LDU; pu2 = bf2f(up2[C_CC + c]) * bf2f(up2[C_CH + c]); }
        for (int sb = 0; sb < 16; ++sb) {
            const int tb = t0 + sb * 8;
#pragma unroll
            for (int i = 0; i < 2; ++i) { const int idx = tid + 512 * i, tok = idx >> 7, jj = idx & 127; const int t = tb + tok;
                const int cr = (jj < 64) ? (512 + jj) : (1600 + jj - 64);
                const float cur = bf2f(U[(size_t)t * LDU + C_RC + cr]); const float prev = (t % SEQ) == 0 ? 0.f : bf2f(U[(size_t)(t - 1) * LDU + C_RC + cr]);
                float xv = cur + (prev - cur) * mu[cr];
                if (jj < 64) { const float e = __expf(2.f * xv); xv = 1.f - 2.f / (e + 1.f); }
                sth[tok * 128 + jj] = xv; }
            if (tid < 256) { const int tok = tid >> 5, j = tid & 31, t = tb + tok; const bf16_t* ur = U + (size_t)t * LDU + C_KPE;
                const float x1 = bf2f(ur[j]), x2 = bf2f(ur[32 + j]), cs = cosT[t * 32 + j], sn = sinT[t * 32 + j];
                *(unsigned*)(KPEB + (size_t)t * 64 + 2 * j) = pk2(x1 * cs - x2 * sn, x2 * cs + x1 * sn); }
            __syncthreads();
#pragma unroll 2
            for (int tok = 0; tok < 8; ++tok) {
                const int t = tb + tok; const bf16_t* ur = U + (size_t)t * LDU;
                const float ur_ = bf2f(ur[C_RC + c]), uk_ = bf2f(ur[C_RC + 576 + c]), uv_ = bf2f(ur[C_RC + 1088 + c]);
                const float cb = bf2f(ur[C_CB + c]), cc = bf2f(ur[C_CC + c]), ch = bf2f(ur[C_CH + c]), cgt = bf2f(ur[C_CG + c]);
                const float cq = bf2f(ur[C_CQ + c]); const float ckv = (c < 256) ? bf2f(ur[C_CKV + c]) : 0.f;
                const float uc = cc * ch; const float yc = cw0 * pu2 + cw1 * pu1 + cw2 * uc; pu2 = pu1; pu1 = uc;
                MIX[(size_t)t * DM + c] = (bf16_t)f2bf(cb * yc * silu_f(cgt));
                const float sq = wave_sum(cq * cq), skv = wave_sum(ckv * ckv);
                if (lane == 0) { spart[(sb * 8 + tok) * 12 + wave] = sq; if (wave < 4) spart[(sb * 8 + tok) * 12 + 8 + wave] = skv; }
                const float r = ur_ + (pr - ur_) * mu_r, k = uk_ + (pk - uk_) * mu_k, v = uv_ + (pv - uv_) * mu_v; pr = ur_; pk = uk_; pv = uv_;
                float zw = w0c, za = a0c;
#pragma unroll
                for (int j4 = 0; j4 < 16; ++j4) { const f32x4 th = *(const LAS f32x4*)(sth + tok * 128 + j4 * 4), ad = *(const LAS f32x4*)(sth + tok * 128 + 64 + j4 * 4);
                    zw += th[0] * w2r[j4 * 4] + th[1] * w2r[j4 * 4 + 1] + th[2] * w2r[j4 * 4 + 2] + th[3] * w2r[j4 * 4 + 3];
                    za += ad[0] * a2r[j4 * 4] + ad[1] * a2r[j4 * 4 + 1] + ad[2] * a2r[j4 * 4 + 2] + ad[3] * a2r[j4 * 4 + 3]; }
                const float sp = fmaxf(-zw, 0.f) + __logf(1.f + __expf(-fabsf(zw)));
                const float wlog = -sp - 0.5f; const float dec = __expf(-__expf(wlog));
                const float asig = 1.f / (1.f + __expf(-za));
                const float kkr = k * kkc; const float nrm = sqrtf(wave_sum(kkr * kkr)); const float kk = kkr / fmaxf(nrm, 1e-12f);
                const float k2 = k * (1.f + (asig - 1.f) * kac);
                const float av = -kk, bv = kk * asig;
                const float br = wave_sum(bv * r), kr = wave_sum(k2 * r), rkb = wave_sum(r * k2 * rkc);
                bf16_t* so = SCAN + ((size_t)t * 8 + wave) * 384 + lane;
                so[0] = (bf16_t)f2bf(av); so[64] = (bf16_t)f2bf(dec * r); so[128] = (bf16_t)f2bf(dec); so[192] = (bf16_t)f2bf(bv); so[256] = (bf16_t)f2bf(k2); so[320] = (bf16_t)f2bf(v);
                if (lane == 0) { f32x4 o4 = {br, kr, rkb, 0.f}; *(f32x4*)(SC2 + ((size_t)t * 8 + wave) * 4) = o4; }
            }
            __syncthreads();
        }
        if (tid < 128) { float sq = 0.f, skv = 0.f;
#pragma unroll
            for (int w = 0; w < 8; ++w) sq += spart[tid * 12 + w];
#pragma unroll
            for (int w = 0; w < 4; ++w) skv += spart[tid * 12 + 8 + w];
            RSQ[t0 + tid] = rsqrtf(sq * (1.f / 512.f) + RMS_EPS); RSKV[t0 + tid] = rsqrtf(skv * (1.f / 256.f) + RMS_EPS); }
        __syncthreads();
    }
}

namespace att {
constexpr int KROW = 400, VROW = 136, KT_BYTES = 64 * KROW, VT_BYTES = 128 * VROW, BUF_BYTES = KT_BYTES + VT_BYTES;
__device__ __forceinline__ void unit(KP p, int bh, int qb, LAS unsigned char* lds) {
    KP_FENCE(p);
    int tid = threadIdx.x; asm volatile("" : "+v"(tid));
    const int lane = tid & 63, w = __builtin_amdgcn_readfirstlane(tid >> 6), ql = lane & 31, hi = lane >> 5;
    const int b = bh >> 3, h = bh & 7, q0 = qb * 256;
    const bf16_t* Q = (const bf16_t*)(p->ws + WS_Q); const bf16_t* KN = (const bf16_t*)(p->ws + WS_KN); const bf16_t* KPEB = (const bf16_t*)(p->ws + WS_KPE);
    const bf16_t* VT = (const bf16_t*)(p->ws + WS_VT); const bf16_t* U = (const bf16_t*)(p->ws + WS_U); bf16_t* MIX = (bf16_t*)(p->ws + WS_MIX);
    const int qpos = q0 + 32 * w + ql; const size_t tq = (size_t)b * SEQ + qpos;
    bf16x8 qf[12];
    { const bf16_t* qp = Q + tq * 1536 + h * 192 + 8 * hi;
#pragma unroll
      for (int ks = 0; ks < 12; ++ks) qf[ks] = *(const bf16x8*)(qp + 16 * ks); }
    f32x16 o[4];
#pragma unroll
    for (int d = 0; d < 4; ++d)
#pragma unroll
        for (int i = 0; i < 16; ++i) o[d][i] = 0.f;
    float mrow = -1e30f, lsum = 0.f;
    const int nj = 4 * (qb + 1);
    const bf16_t* ksrc[3]; int kdst[3];
#pragma unroll
    for (int i = 0; i < 3; ++i) { const int idx = tid + 512 * i, key = idx / 24, cc = idx % 24; const size_t tk = (size_t)b * SEQ + key;
        ksrc[i] = (cc < 16) ? (KN + tk * 1024 + h * 128 + 8 * cc) : (KPEB + tk * 64 + 8 * (cc - 16)); kdst[i] = key * KROW + 16 * cc; }
    const int kstride[3] = {(tid % 24 < 16) ? 1024 : 64, ((tid + 512) % 24 < 16) ? 1024 : 64, ((tid + 1024) % 24 < 16) ? 1024 : 64};
    const bf16_t* vsrc[2]; int vdst[2];
#pragma unroll
    for (int i = 0; i < 2; ++i) { const int idx = tid + 512 * i, dv = idx >> 3, chn = idx & 7; vsrc[i] = VT + (size_t)(h * 128 + dv) * T + (size_t)b * SEQ + 8 * chn; vdst[i] = KT_BYTES + dv * VROW + 16 * chn; }
    u32x4 kreg[3], vreg[2];
#define ATT_GLOAD(j) do { _Pragma("unroll") for (int i = 0; i < 3; ++i) kreg[i] = *(const u32x4*)(ksrc[i] + (size_t)(j) * 64 * kstride[i]); \
                          _Pragma("unroll") for (int i = 0; i < 2; ++i) vreg[i] = *(const u32x4*)(vsrc[i] + (size_t)(j) * 64); } while (0)
#define ATT_LSTORE(bufo) do { _Pragma("unroll") for (int i = 0; i < 3; ++i) *(LAS u32x4*)(lds + (bufo) + kdst[i]) = kreg[i]; \
                              _Pragma("unroll") for (int i = 0; i < 2; ++i) { u32x2 lo = {vreg[i].x, vreg[i].y}, hi2 = {vreg[i].z, vreg[i].w}; \
                                  *(LAS u32x2*)(lds + (bufo) + vdst[i]) = lo; *(LAS u32x2*)(lds + (bufo) + vdst[i] + 8) = hi2; } } while (0)
    ATT_GLOAD(0); ATT_LSTORE(0);
    __syncthreads();
    for (int j = 0; j < nj; ++j) {
        const int cur = (j & 1) * BUF_BYTES, nxt = BUF_BYTES - cur;
        if (j + 1 < nj) ATT_GLOAD(j + 1);
        const int kt0 = 64 * j;
        if (kt0 <= q0 + 32 * w + 31) {
            f32x16 st0, st1;
#pragma unroll
            for (int i = 0; i < 16; ++i) { st0[i] = 0.f; st1[i] = 0.f; }
            const LAS unsigned char* kb = lds + cur + ql * KROW + 16 * hi;
#pragma unroll
            for (int ks = 0; ks < 12; ++ks) {
                const bf16x8 k0 = *(const LAS bf16x8*)(kb + 32 * ks), k1 = *(const LAS bf16x8*)(kb + 32 * KROW + 32 * ks);
                st0 = __builtin_amdgcn_mfma_f32_32x32x16_bf16(k0, qf[ks], st0, 0, 0, 0);
                st1 = __builtin_amdgcn_mfma_f32_32x32x16_bf16(k1, qf[ks], st1, 0, 0, 0);
            }
            if (kt0 + 63 > q0 + 32 * w) {
#pragma unroll
                for (int i = 0; i < 16; ++i) { const int key = kt0 + 8 * (i >> 2) + 4 * hi + (i & 3); if (key > qpos) st0[i] = -1e30f; if (key + 32 > qpos) st1[i] = -1e30f; }
            }
            float mx = fmaxf(st0[0], st1[0]);
#pragma unroll
            for (int i = 1; i < 16; ++i) mx = fmaxf(mx, fmaxf(st0[i], st1[i]));
            mx = fmaxf(mx, __shfl_xor(mx, 32));
            const float mnew = fmaxf(mrow, mx); const float alpha = __builtin_amdgcn_exp2f(mrow - mnew); mrow = mnew;
            float ps = 0.f;
#pragma unroll
            for (int i = 0; i < 16; ++i) { st0[i] = __builtin_amdgcn_exp2f(st0[i] - mnew); st1[i] = __builtin_amdgcn_exp2f(st1[i] - mnew); ps += st0[i] + st1[i]; }
            lsum = lsum * alpha + ps;
#pragma unroll
            for (int d = 0; d < 4; ++d)
#pragma unroll
                for (int i = 0; i < 16; ++i) o[d][i] *= alpha;
            bf16x8 pf[4];
#pragma unroll
            for (int s2 = 0; s2 < 4; ++s2) { u32x4 pw;
                if (s2 < 2) { pw.x = pk2(st0[8 * s2 + 0], st0[8 * s2 + 1]); pw.y = pk2(st0[8 * s2 + 2], st0[8 * s2 + 3]); pw.z = pk2(st0[8 * s2 + 4], st0[8 * s2 + 5]); pw.w = pk2(st0[8 * s2 + 6], st0[8 * s2 + 7]); }
                else { const int s3 = s2 - 2; pw.x = pk2(st1[8 * s3 + 0], st1[8 * s3 + 1]); pw.y = pk2(st1[8 * s3 + 2], st1[8 * s3 + 3]); pw.z = pk2(st1[8 * s3 + 4], st1[8 * s3 + 5]); pw.w = pk2(st1[8 * s3 + 6], st1[8 * s3 + 7]); }
                pf[s2] = __builtin_bit_cast(bf16x8, pw); }
            const LAS unsigned char* vb = lds + cur + KT_BYTES + ql * VROW + 8 * hi;
#pragma unroll
            for (int d = 0; d < 4; ++d)
#pragma unroll
                for (int s2 = 0; s2 < 4; ++s2) {
                    const u32x2 lo = *(const LAS u32x2*)(vb + d * 32 * VROW + 32 * s2), hi2 = *(const LAS u32x2*)(vb + d * 32 * VROW + 32 * s2 + 16);
                    u32x4 vw = {lo.x, lo.y, hi2.x, hi2.y};
                    o[d] = __builtin_amdgcn_mfma_f32_32x32x16_bf16(__builtin_bit_cast(bf16x8, vw), pf[s2], o[d], 0, 0, 0);
                }
        }
        if (j + 1 < nj) ATT_LSTORE(nxt);
        __syncthreads();
    }
#undef ATT_GLOAD
#undef ATT_LSTORE
    const float ltot = lsum + __shfl_xor(lsum, 32); const float inv = 1.f / ltot;
    const bf16_t* gp = U + tq * LDU + C_MG + h * 128; bf16_t* op = MIX + tq * DM + 512 + h * 128;
#pragma unroll
    for (int d = 0; d < 4; ++d)
#pragma unroll
        for (int g4 = 0; g4 < 4; ++g4) { const int dv0 = 32 * d + 8 * g4 + 4 * hi;
            const u32x2 gw = *(const u32x2*)(gp + dv0);
            const float g0 = __uint_as_float(gw.x << 16), g1 = __uint_as_float(gw.x & 0xffff0000u), g2 = __uint_as_float(gw.y << 16), g3 = __uint_as_float(gw.y & 0xffff0000u);
            u32x2 ow; ow.x = pk2(o[d][4 * g4 + 0] * inv * silu_f(g0), o[d][4 * g4 + 1] * inv * silu_f(g1)); ow.y = pk2(o[d][4 * g4 + 2] * inv * silu_f(g2), o[d][4 * g4 + 3] * inv * silu_f(g3));
            *(u32x2*)(op + dv0) = ow; }
}
}

namespace scan {
constexpr int CT = 32;
constexpr int IN_BYTES = CT * 6 * 64 * 4;
constexpr int OFF_IN = 0, OFF_SC2 = 2 * IN_BYTES, OFF_Y = OFF_SC2 + 2 * CT * 8, Y_BYTES = CT * 32 * 4;
__device__ __forceinline__ void run(KP p, int wg, LAS unsigned char* lds) {
    KP_FENCE(p);
    int tid = threadIdx.x; asm volatile("" : "+v"(tid));
    const int lane = tid & 63, w = __builtin_amdgcn_readfirstlane(tid >> 6);
    const int bh = wg >> 1, half = wg & 1, b = bh >> 3, h = bh & 7;
    const bf16_t* SCAN = (const bf16_t*)(p->ws + WS_SCAN); const float* SC2 = (const float*)(p->ws + WS_SC2); bf16_t* MIX = (bf16_t*)(p->ws + WS_MIX);
    const int nch = SEQ / CT;
    const bool stager = (w >= 4); const int stid = tid - 256;
    const int rg = lane >> 4, kq = lane & 15; const int rl0 = 8 * (w & 3) + 2 * rg;
    f32x4 s0 = {0.f, 0.f, 0.f, 0.f}, s1 = {0.f, 0.f, 0.f, 0.f};
    u32x4 ld[6]; f32x2 ld2 = {0.f, 0.f};
#define SC_GLOAD(c) do { const size_t tb = (size_t)b * SEQ + (size_t)(c) * CT; \
        _Pragma("unroll") for (int i = 0; i < 6; ++i) { const int idx = stid + 256 * i, tok = idx / 48, part = idx % 48; ld[i] = *(const u32x4*)(SCAN + ((tb + tok) * 8 + h) * 384 + 8 * part); } \
        if (stid < CT) ld2 = *(const f32x2*)(SC2 + ((tb + stid) * 8 + h) * 4); } while (0)
#define SC_LSTORE(c) do { const int bo = OFF_IN + ((c) & 1) * IN_BYTES; \
        _Pragma("unroll") for (int i = 0; i < 6; ++i) { const int idx = stid + 256 * i, tok = idx / 48, part = idx % 48; \
            f32x4 lo = {__uint_as_float(ld[i].x << 16), __uint_as_float(ld[i].x & 0xffff0000u), __uint_as_float(ld[i].y << 16), __uint_as_float(ld[i].y & 0xffff0000u)}; \
            f32x4 hi4 = {__uint_as_float(ld[i].z << 16), __uint_as_float(ld[i].z & 0xffff0000u), __uint_as_float(ld[i].w << 16), __uint_as_float(ld[i].w & 0xffff0000u)}; \
            *(LAS f32x4*)(lds + bo + (tok * 384 + part * 8) * 4) = lo; *(LAS f32x4*)(lds + bo + (tok * 384 + part * 8 + 4) * 4) = hi4; } \
        if (stid < CT) *(LAS f32x2*)(lds + OFF_SC2 + ((c) & 1) * CT * 8 + stid * 8) = ld2; } while (0)
#define SC_YOUT(c) do { const size_t tb = (size_t)b * SEQ + (size_t)(c) * CT; const int tok = stid >> 3, r4 = (stid & 7) * 4; \
        const f32x4 y4 = *(const LAS f32x4*)(lds + OFF_Y + ((c) & 1) * Y_BYTES + (tok * 32 + r4) * 4); \
        u32x2 ow; ow.x = pk2(y4[0], y4[1]); ow.y = pk2(y4[2], y4[3]); *(u32x2*)(MIX + (tb + tok) * DM + 1536 + h * 64 + 32 * half + r4) = ow; } while (0)
    if (stager) { SC_GLOAD(0); SC_LSTORE(0); }
    __syncthreads();
    for (int c = 0; c < nch; ++c) {
        if (stager) {
            if (c + 1 < nch) SC_GLOAD(c + 1);
            if (c >= 1) SC_YOUT(c - 1);
            if (c + 1 < nch) SC_LSTORE(c + 1);
        } else {
            const LAS unsigned char* ib = lds + OFF_IN + (c & 1) * IN_BYTES + kq * 16;
            const LAS unsigned char* vb = lds + OFF_IN + (c & 1) * IN_BYTES + (320 + 32 * half + rl0) * 4;
            const LAS unsigned char* sb = lds + OFF_SC2 + (c & 1) * CT * 8;
            LAS unsigned char* yb = lds + OFF_Y + (c & 1) * Y_BYTES + rl0 * 4;
#pragma unroll 4
            for (int tok = 0; tok < CT; ++tok) {
                const f32x4 a = *(const LAS f32x4*)(ib + tok * 1536), wr4 = *(const LAS f32x4*)(ib + tok * 1536 + 256), wd = *(const LAS f32x4*)(ib + tok * 1536 + 512),
                            bb = *(const LAS f32x4*)(ib + tok * 1536 + 768), kk = *(const LAS f32x4*)(ib + tok * 1536 + 1024);
                const f32x2 v2 = *(const LAS f32x2*)(vb + tok * 1536); const f32x2 bk = *(const LAS f32x2*)(sb + tok * 8);
                float p0 = s0[0] * a[0] + s0[1] * a[1] + s0[2] * a[2] + s0[3] * a[3];
                float q0 = s0[0] * wr4[0] + s0[1] * wr4[1] + s0[2] * wr4[2] + s0[3] * wr4[3];
                float p1 = s1[0] * a[0] + s1[1] * a[1] + s1[2] * a[2] + s1[3] * a[3];
                float q1 = s1[0] * wr4[0] + s1[1] * wr4[1] + s1[2] * wr4[2] + s1[3] * wr4[3];
                p0 = row16_sum(p0); q0 = row16_sum(q0); p1 = row16_sum(p1); q1 = row16_sum(q1);
                s0 = s0 * wd + bb * p0 + kk * v2[0];
                s1 = s1 * wd + bb * p1 + kk * v2[1];
                const float y0 = q0 + p0 * bk[0] + v2[0] * bk[1], y1 = q1 + p1 * bk[0] + v2[1] * bk[1];
                if (kq == 0) { f32x2 yy = {y0, y1}; *(LAS f32x2*)(yb + tok * 128) = yy; }
            }
        }
        __syncthreads();
    }
    if (stager) SC_YOUT(nch - 1);
#undef SC_GLOAD
#undef SC_LSTORE
#undef SC_YOUT
    __syncthreads();
}
}

constexpr int N_SCAN_WG = 32, N_ATT_UNITS = 1024;
__device__ __forceinline__ void phase_mix(KP p, int l, LAS unsigned char* lds) {
    KP_FENCE(p);
    if ((PH & 256) && (int)blockIdx.x < N_SCAN_WG) scan::run(p, blockIdx.x, lds);
    unsigned* ctr = (unsigned*)(p->ws + WS_CTL) + l;
    LAS int* qword = (LAS int*)(lds + LDS_MISC);
    for (;;) {
        if (threadIdx.x == 0) *qword = (int)atomicAdd(ctr, 1u);
        __syncthreads();
        const int n = *qword;
        __syncthreads();
        if (n >= N_ATT_UNITS) break;
        if (PH & 512) att::unit(p, n & 15, 63 - (n >> 4), lds);
    }
}

__device__ __forceinline__ void phase_gn(KP p, int l) {
    KP_FENCE(p);
    int tid = threadIdx.x; asm volatile("" : "+v"(tid));
    const int lane = tid & 63, wave = tid >> 6, c = tid;
    bf16_t* MIX = (bf16_t*)(p->ws + WS_MIX); const bf16_t* U = (const bf16_t*)(p->ws + WS_U); const bf16_t* SCAN = (const bf16_t*)(p->ws + WS_SCAN); const float* SC2 = (const float*)(p->ws + WS_SC2);
    const float g = p->gn_g[l * 512 + c], bta = p->gn_b[l * 512 + c];
    for (int t = blockIdx.x; t < T; t += gridDim.x) {
        const float y = bf2f(MIX[(size_t)t * DM + 1536 + c]);
        const float v = bf2f(SCAN[((size_t)t * 8 + wave) * 384 + 320 + lane]);
        const float rkb = SC2[((size_t)t * 8 + wave) * 4 + 2];
        const float gate = bf2f(U[(size_t)t * LDU + C_RG + c]);
        const float mean = wave_sum(y) * (1.f / 64.f); const float d = y - mean; const float var = wave_sum(d * d) * (1.f / 64.f);
        const float yn = d * rsqrtf(var + GN_EPS) * g + bta + rkb * v;
        MIX[(size_t)t * DM + 1536 + c] = (bf16_t)f2bf(yn * silu_f(gate));
    }
}

__device__ __forceinline__ void phase_ln(KP p, int l, bool write_xb) {
    KP_FENCE(p);
    int tid = threadIdx.x; asm volatile("" : "+v"(tid));
    const int lane = tid & 63, wave = tid >> 6;
    bf16_t* xb = (bf16_t*)(p->ws + WS_XB);
    f32x4 g[8], bb[8];
#pragma unroll
    for (int i = 0; i < 8; ++i) { g[i] = *(const f32x4*)(p->ln_g + l * DM + (i * 64 + lane) * 4); bb[i] = *(const f32x4*)(p->ln_b + l * DM + (i * 64 + lane) * 4); }
    for (int row = blockIdx.x * 8 + wave; row < T; row += gridDim.x * 8) {
        float* rp = p->out + (size_t)row * DM;
        f32x4 v[8]; float s = 0.f;
#pragma unroll
        for (int i = 0; i < 8; ++i) { v[i] = *(const f32x4*)(rp + (i * 64 + lane) * 4); s += v[i][0] + v[i][1] + v[i][2] + v[i][3]; }
        const float mean = wave_sum(s) * (1.f / DM);
        float q = 0.f;
#pragma unroll
        for (int i = 0; i < 8; ++i) { v[i] = v[i] - mean; q += v[i][0] * v[i][0] + v[i][1] * v[i][1] + v[i][2] * v[i][2] + v[i][3] * v[i][3]; }
        const float rstd = rsqrtf(wave_sum(q) * (1.f / DM) + LN_EPS);
#pragma unroll
        for (int i = 0; i < 8; ++i) { const f32x4 y = v[i] * rstd * g[i] + bb[i]; *(f32x4*)(rp + (i * 64 + lane) * 4) = y;
            if (write_xb) { u32x2 wv; wv.x = pk2(y[0], y[1]); wv.y = pk2(y[2], y[3]); *(u32x2*)(xb + (size_t)row * DM + (i * 64 + lane) * 4) = wv; } }
    }
}

#define PHASE_FENCE() do { __builtin_amdgcn_sched_barrier(0); asm volatile("" ::: "memory"); __syncthreads(); __builtin_amdgcn_sched_barrier(0); } while (0)
__global__ void __launch_bounds__(512, 2) fwd_megakernel(Params p_in) {
    KP p = (KP)__builtin_amdgcn_kernarg_segment_ptr();
    extern __shared__ __attribute__((aligned(16))) unsigned char smem[];
    LAS unsigned char* lds = (LAS unsigned char*)smem;
    cg::grid_group grid = cg::this_grid();
    const int G = gridDim.x;
    bf16_t* U = (bf16_t*)(p->ws + WS_U); bf16_t* XB = (bf16_t*)(p->ws + WS_XB); bf16_t* MIX = (bf16_t*)(p->ws + WS_MIX);
    float* RSQ = (float*)(p->ws + WS_RS); float* RSKV = RSQ + T;

    if (PH & 1) phase_p0(p, lds);
    grid.sync();
    for (int l = 0; l < DEPTH; ++l) {
        if (PH & 2) { pg8::Gemm g{XB, (const bf16_t*)(p->ws + WS_WIN), T, LDU, DM, DM, DM}; pg8::StaticOrder S; S.init(T, LDU, G, (int)blockIdx.x);
          pg8::EpiU E{U, LDU}; pg8::gemm_phase(lds, g, S, E); }
        grid.sync();
        if (PH & 4) phase_prep(p, l, lds);
        grid.sync();
        PHASE_FENCE();
        if (PH & 8) { pg8::Gemm g{U + C_CQ, (const bf16_t*)(p->ws + WS_WUQ), T, 1536, 512, LDU, 512}; pg8::StaticOrder S; S.init(T, 1536, G, (int)blockIdx.x);
          pg8::EpiQ E{(bf16_t*)(p->ws + WS_Q), RSQ, (const float*)(p->ws + WS_COS), (const float*)(p->ws + WS_SIN)}; pg8::gemm_phase(lds, g, S, E); }
        PHASE_FENCE();
        if (PH & 1024) { pg8::Gemm g{U + C_CKV, (const bf16_t*)(p->ws + WS_WUK), T, 1024, 256, LDU, 256}; pg8::StaticOrder S; S.init(T, 1024, G, (int)blockIdx.x);
          pg8::EpiRowScale E{(bf16_t*)(p->ws + WS_KN), 1024, RSKV, 1.f}; pg8::gemm_phase(lds, g, S, E); }
        PHASE_FENCE();
        if (PH & 2048) { pg8::Gemm g{(const bf16_t*)(p->ws + WS_WUV), U + C_CKV, 1024, T, 256, 256, LDU}; pg8::StaticOrder S; S.init(1024, T, G, (int)blockIdx.x);
          pg8::EpiColScale E{(bf16_t*)(p->ws + WS_VT), T, RSKV}; pg8::gemm_phase(lds, g, S, E); }
        grid.sync();
        if (PH & 16) phase_mix(p, l, lds);
        grid.sync();
        if (PH & 32) phase_gn(p, l);
        grid.sync();
        if (PH & 64) { pg8::Gemm g{MIX, (const bf16_t*)(p->ws + WS_WOUT), T, DM, DM, DM, DM}; pg8::StaticOrder S; S.init(T, DM, G, (int)blockIdx.x);
          pg8::EpiRes E{p->out, l == 0 ? p->x : p->out}; pg8::gemm_phase(lds, g, S, E); }
        grid.sync();
        if (PH & 128) phase_ln(p, l, l + 1 < DEPTH);
        if (l + 1 < DEPTH) { if (PH & 1) convert_weights(p, l + 1, lds); grid.sync(); }
    }
}

extern "C" void kernel_launch(void* const* d_in, const int* in_sizes, int n_in, void* d_out, int out_size, void* d_ws, size_t ws_size, hipStream_t stream) {
    static int grid = 0;
    if (grid == 0) {
        if (n_in != 21 || ws_size < WS_END) { fprintf(stderr, "kernel_launch: unexpected n_in %d or ws_size %zu (need %zu)\n", n_in, ws_size, (size_t)WS_END); grid = -1; return; }
        int dev = 0, cus = 0, per_cu = 0;
        hipGetDevice(&dev); hipDeviceGetAttribute(&cus, hipDeviceAttributeMultiprocessorCount, dev);
        if (hipFuncSetAttribute((const void*)fwd_megakernel, hipFuncAttributeMaxDynamicSharedMemorySize, LDS_BYTES) != hipSuccess) { fprintf(stderr, "kernel_launch: hipFuncSetAttribute failed\n"); grid = -1; return; }
        if (hipOccupancyMaxActiveBlocksPerMultiprocessor(&per_cu, (const void*)fwd_megakernel, 512, LDS_BYTES) != hipSuccess || per_cu < 1) { fprintf(stderr, "kernel_launch: occupancy query gave %d\n", per_cu); per_cu = 1; }
        (void)hipGetLastError();
        grid = cus * per_cu;
    }
    if (grid < 0) return;
    Params p{};
    p.x = (const float*)d_in[0]; p.pos = (const int*)d_in[1]; p.w_in = (const float*)d_in[2]; p.conv_w = (const float*)d_in[3]; p.q_norm_g = (const float*)d_in[4];
    p.w_uq = (const float*)d_in[5]; p.kv_norm_g = (const float*)d_in[6]; p.w_ukv = (const float*)d_in[7]; p.mu = (const float*)d_in[8]; p.w0 = (const float*)d_in[9];
    p.w2 = (const float*)d_in[10]; p.a0 = (const float*)d_in[11]; p.a2 = (const float*)d_in[12]; p.k_k = (const float*)d_in[13]; p.k_a = (const float*)d_in[14];
    p.r_k = (const float*)d_in[15]; p.gn_g = (const float*)d_in[16]; p.gn_b = (const float*)d_in[17]; p.w_out = (const float*)d_in[18]; p.ln_g = (const float*)d_in[19]; p.ln_b = (const float*)d_in[20];
    p.out = (float*)d_out; p.ws = (unsigned char*)d_ws;
    for (int j = 0; j < 32; ++j) p.inv_freq[j] = (float)pow(10000.0, -(double)(2 * j) / 64.0);
    void* args[] = {&p};
    hipError_t e = hipLaunchCooperativeKernel((const void*)fwd_megakernel, dim3(grid), dim3(512), args, LDS_BYTES, stream);
    if (e != hipSuccess) fprintf(stderr, "cooperative launch failed: %s (grid %d)\n", hipGetErrorString(e), grid);
}
```

```cpp
#include <hip/hip_runtime.h>
#include <hip/hip_cooperative_groups.h>
#include <cstdio>
#include <cstdint>
#include <cmath>
namespace cg = cooperative_groups;

#define LAS __attribute__((address_space(3)))
typedef unsigned short bf16_t;
typedef short bf16x8 __attribute__((ext_vector_type(8)));
typedef short s16x4 __attribute__((ext_vector_type(4)));
typedef float f32x4 __attribute__((ext_vector_type(4)));
typedef float f32x2 __attribute__((ext_vector_type(2)));
typedef float f32x16 __attribute__((ext_vector_type(16)));
typedef unsigned u32x4 __attribute__((ext_vector_type(4)));
typedef unsigned u32x2 __attribute__((ext_vector_type(2)));
typedef __bf16 bf16x2_t __attribute__((ext_vector_type(2)));

constexpr int T = 32768, SEQ = 16384, DM = 2048, NIN = 6080, LDU = 6144, DEPTH = 2;
constexpr int C_CB = 0, C_CC = 512, C_CH = 1024, C_CG = 1536, C_CQ = 2048, C_CKV = 2560, C_KPE = 2816, C_MG = 2880, C_RC = 3904, C_RG = 5568;
constexpr int NHEAD = 8;
constexpr float LN_EPS = 1e-5f, RMS_EPS = 1e-6f, GN_EPS = 64e-5f;
constexpr float ALPHA = 1.4142135623730951f;
constexpr float QSCALE = 0.07216878364870323f * 1.4426950408889634f;

constexpr size_t MiB = 1u << 20;
constexpr size_t WS_CTL = 0, WS_WIN = 1 * MiB, WS_WOUT = 25 * MiB, WS_WUQ = 33 * MiB, WS_WUK = 35 * MiB, WS_WUV = 36 * MiB, WS_RS = 37 * MiB,
                 WS_SC2 = 38 * MiB, WS_COS = 42 * MiB, WS_SIN = 46 * MiB, WS_U = 50 * MiB, WS_MIX = 434 * MiB, WS_XB = 562 * MiB, WS_Q = 562 * MiB,
                 WS_KPE = 658 * MiB, WS_KN = 690 * MiB, WS_VT = 754 * MiB, WS_SCAN = 818 * MiB, WS_END = 1010 * MiB;

constexpr int LDS_BYTES = 131072 + 256, LDS_MISC = 131072;

struct Params {
    const float* x; const int* pos; const float* w_in; const float* conv_w; const float* q_norm_g; const float* w_uq; const float* kv_norm_g; const float* w_ukv;
    const float* mu; const float* w0; const float* w2; const float* a0; const float* a2; const float* k_k; const float* k_a; const float* r_k; const float* gn_g; const float* gn_b;
    const float* w_out; const float* ln_g; const float* ln_b;
    float* out; unsigned char* ws;
    float inv_freq[32];
};

typedef const __attribute__((address_space(4))) Params* KP;
#define KP_FENCE(p) asm volatile("" : "+s"(p))
__device__ __forceinline__ float bf2f(unsigned short v) { return __uint_as_float(((unsigned)v) << 16); }
__device__ __forceinline__ unsigned f2bf(float f) { unsigned u = __float_as_uint(f); return (u + 0x7fffu + ((u >> 16) & 1u)) >> 16; }
__device__ __forceinline__ unsigned pk2(float lo, float hi) { f32x2 v = {lo, hi}; bf16x2_t b = __builtin_convertvector(v, bf16x2_t); return __builtin_bit_cast(unsigned, b); }
__device__ __forceinline__ float silu_f(float x) { return x / (1.f + __expf(-x)); }
__device__ __forceinline__ float dppf(float v, int ctrl) { return v; }
template <int CTRL> __device__ __forceinline__ float dpp_mov(float v) { return __int_as_float(__builtin_amdgcn_update_dpp(__float_as_int(v), __float_as_int(v), CTRL, 0xf, 0xf, false)); }
__device__ __forceinline__ float row16_sum(float v) {
    v += dpp_mov<0xB1>(v);
    v += dpp_mov<0x4E>(v);
    v += dpp_mov<0x141>(v);
    v += dpp_mov<0x140>(v);
    return v;
}
__device__ __forceinline__ float wave_sum(float v) { v = row16_sum(v); v += __shfl_xor(v, 16); v += __shfl_xor(v, 32); return v; }

#ifndef PH
#define PH 0xffff
#endif
#ifndef DUP
#define DUP 0
#endif
namespace pg8 {
constexpr int BM = 256, BK = 64, HALF = 128, HTB = HALF * BK * 2, STAGE_BYTES = 8 * HTB, NXCD = 8, WGM = 8;
__host__ __device__ __forceinline__ int lds_byte(int r, int c) { const int st = (r >> 4) * 2 + (c >> 5), rr = r & 15, cc = c & 31, ob = rr * 64 + cc * 2; return st * 1024 + (ob ^ (((ob >> 9) & 1) << 5)); }
__host__ __device__ __forceinline__ void stage_rc(int b, int& R, int& C) { const int st = b / 1024, sb = b % 1024, swz = sb ^ (((sb >> 9) & 1) << 5); R = (st >> 1) * 16 + swz / 64; C = (st & 1) * 32 + (swz % 64) / 2; }
__host__ __device__ __forceinline__ int perm32(int rho) { const int n = rho >> 4, i = rho & 15; return 8 * (i >> 2) + 4 * n + (i & 3); }
struct Unit { int pm, pn; };
struct Gemm { const bf16_t* A; const bf16_t* Bt; int M, N, K, lda, ldb; };
struct StaticOrder {
    int nM, nN, nwg, G, c;
    __device__ void init(int M, int N, int G_, int c_) { nM = M / BM; nN = N / BM; nwg = nM * nN; G = G_; c = c_; }
    __device__ bool next(int i, Unit& u) const {
        const long L = (long)i * G + c; if (L >= nwg) return false;
        int wgid = (int)L; { const int q = nwg / NXCD, r = nwg % NXCD, xcd = wgid % NXCD, off = wgid / NXCD; wgid = (xcd < r ? xcd * (q + 1) : r * (q + 1) + (xcd - r) * q) + off; }
        const int nig = WGM * nN, gid = wgid / nig, fm = gid * WGM, gsz = (nM - fm) < WGM ? (nM - fm) : WGM;
        u.pm = fm + ((wgid % nig) % gsz); u.pn = (wgid % nig) / gsz; return true;
    }
};
template <class Epi>
__device__ __forceinline__ void gemm_phase(LAS unsigned char* lds, const Gemm g, const StaticOrder& S, const Epi& E) {
    int tid = threadIdx.x; asm volatile("" : "+v"(tid));
    const int wid = __builtin_amdgcn_readfirstlane(tid >> 6), lane = tid & 63, wr = wid >> 2, wc = wid & 3, fr = lane & 15, fq = lane >> 4;
    int K = g.K; asm volatile("" : "+s"(K));
    const int nt = K / BK;
    unsigned voffA[2], voffB[2];
#pragma unroll
    for (int i = 0; i < 2; ++i) { int R, C; stage_rc(tid * 16 + i * 8192, R, C); const int Rb = Epi::PERM ? ((R & ~31) + perm32(R & 31)) : R;
        voffA[i] = (unsigned)(R * g.lda + C) * 2u; voffB[i] = (unsigned)(Rb * g.ldb + C) * 2u; }
    const size_t kstep = (size_t)(BK * 2);
    const size_t hstepA = (size_t)HALF * g.lda * 2, hstepB = (size_t)HALF * g.ldb * 2;
    const size_t tstepA = 2 * hstepA, tstepB = 2 * hstepB;
    const unsigned ldsw = (unsigned)wid * 1024u;
    const int aoff = lds_byte(wr * 64 + fr, fq * 8), boff = lds_byte(wc * 32 + fr, fq * 8);
#define PG8_SA(b, h) (((b) * 2 + (h)) * HTB)
#define PG8_SB(b, h) ((4 + (b) * 2 + (h)) * HTB)
#define PG8_STAGE(bufoff, gbase, voff) do { _Pragma("unroll") for (int _i = 0; _i < 2; ++_i) \
        __builtin_amdgcn_global_load_lds((const unsigned*)((const char*)(gbase) + (voff)[_i]), (LAS unsigned*)(lds + (bufoff) + ldsw + _i * 8192), 16, 0, 0); } while (0)
#define PG8_LDA(dst, b, h) do { _Pragma("unroll") for (int m = 0; m < 4; ++m) _Pragma("unroll") for (int k = 0; k < 2; ++k) dst[m][k] = *(const LAS bf16x8*)(lds + PG8_SA(b, h) + aoff + m * 2048 + k * 1024); } while (0)
#define PG8_LDB(dst, b, h) do { _Pragma("unroll") for (int n = 0; n < 2; ++n) _Pragma("unroll") for (int k = 0; k < 2; ++k) dst[n][k] = *(const LAS bf16x8*)(lds + PG8_SB(b, h) + boff + n * 2048 + k * 1024); } while (0)
#define PG8_MMA(ai, bj, At, Bt) do { __builtin_amdgcn_s_setprio(1); _Pragma("unroll") for (int m = 0; m < 4; ++m) _Pragma("unroll") for (int n = 0; n < 2; ++n) _Pragma("unroll") for (int k = 0; k < 2; ++k) \
        acc[ai][bj][m][n] = __builtin_amdgcn_mfma_f32_16x16x32_bf16(Bt[n][k], At[m][k], acc[ai][bj][m][n], 0, 0, 0); __builtin_amdgcn_s_setprio(0); } while (0)
#define PG8_WAIT_V(n) asm volatile("s_waitcnt vmcnt(" #n ")" ::: "memory")
#define PG8_WAIT_L(n) asm volatile("s_waitcnt lgkmcnt(" #n ")" ::: "memory")
#define PG8_BAR __builtin_amdgcn_s_barrier()
#define PG8_SCHED __builtin_amdgcn_sched_barrier(0)
    Unit cur, nxt; int ui = 0;
    if (!S.next(0, cur)) return;
    f32x4 acc[2][2][4][2];
#pragma unroll
    for (int a = 0; a < 2; ++a)
#pragma unroll
        for (int b = 0; b < 2; ++b)
#pragma unroll
            for (int m = 0; m < 4; ++m)
#pragma unroll
                for (int n = 0; n < 2; ++n) acc[a][b][m][n] = (f32x4){0.f, 0.f, 0.f, 0.f};
    bf16x8 At[4][2], B0[2][2], B1[2][2];
    const char* cA = (const char*)g.A + (size_t)cur.pm * tstepA; const char* cB = (const char*)g.Bt + (size_t)cur.pn * tstepB;
    PG8_STAGE(PG8_SB(0, 0), cB, voffB); PG8_STAGE(PG8_SB(0, 1), cB + hstepB, voffB); PG8_STAGE(PG8_SA(0, 0), cA, voffA); PG8_STAGE(PG8_SA(0, 1), cA + hstepA, voffA);
    if (wr == 1) PG8_BAR;
    PG8_WAIT_V(2); PG8_BAR;
    PG8_STAGE(PG8_SB(1, 0), cB + kstep, voffB); PG8_STAGE(PG8_SA(1, 0), cA + kstep, voffA); PG8_STAGE(PG8_SB(1, 1), cB + hstepB + kstep, voffB);
    PG8_WAIT_V(6); PG8_BAR;
    for (;;) {
        const bool has_next = S.next(ui + 1, nxt);
        const char* nA = has_next ? (const char*)g.A + (size_t)nxt.pm * tstepA : cA; const char* nB = has_next ? (const char*)g.Bt + (size_t)nxt.pn * tstepB : cB;
        for (int t = 0; t < nt; t += 2) {
            const bool last = (t == nt - 2);
            const char* a1 = cA + (size_t)(t + 1) * kstep;
            const char* a2 = last ? nA : cA + (size_t)(t + 2) * kstep; const char* b2 = last ? nB : cB + (size_t)(t + 2) * kstep;
            const char* a3 = a2 + kstep; const char* b3 = b2 + kstep;
            PG8_LDB(B0, 0, 0); PG8_LDB(B1, 0, 1); PG8_SCHED; PG8_LDA(At, 0, 0); PG8_STAGE(PG8_SA(1, 1), a1 + hstepA, voffA);
            PG8_WAIT_V(8); PG8_WAIT_L(0); PG8_BAR; PG8_MMA(0, 0, At, B0); PG8_MMA(0, 1, At, B1); PG8_BAR; PG8_SCHED;
            PG8_LDA(At, 0, 1); PG8_STAGE(PG8_SB(0, 0), b2, voffB); PG8_STAGE(PG8_SB(0, 1), b2 + hstepB, voffB); PG8_STAGE(PG8_SA(0, 0), a2, voffA);
            PG8_WAIT_V(8); PG8_WAIT_L(0); PG8_BAR; PG8_MMA(1, 0, At, B0); PG8_MMA(1, 1, At, B1); PG8_BAR; PG8_SCHED;
            PG8_LDB(B0, 1, 0); PG8_LDB(B1, 1, 1); PG8_SCHED; PG8_LDA(At, 1, 0); PG8_STAGE(PG8_SA(0, 1), a2 + hstepA, voffA);
            PG8_WAIT_V(8); PG8_WAIT_L(0); PG8_BAR; PG8_MMA(0, 0, At, B0); PG8_MMA(0, 1, At, B1); PG8_BAR; PG8_SCHED;
            PG8_LDA(At, 1, 1); PG8_STAGE(PG8_SB(1, 0), b3, voffB); PG8_STAGE(PG8_SB(1, 1), b3 + hstepB, voffB); PG8_STAGE(PG8_SA(1, 0), a3, voffA);
            PG8_WAIT_V(8); PG8_WAIT_L(0); PG8_BAR; PG8_MMA(1, 0, At, B0); PG8_MMA(1, 1, At, B1); PG8_BAR; PG8_SCHED;
        }
        if (wr == 0) PG8_BAR;
        E(acc, cur, wr, wc, fr, fq);
        if (!has_next) break;
#pragma unroll
        for (int a = 0; a < 2; ++a)
#pragma unroll
            for (int b = 0; b < 2; ++b)
#pragma unroll
                for (int m = 0; m < 4; ++m)
#pragma unroll
                    for (int n = 0; n < 2; ++n) acc[a][b][m][n] = (f32x4){0.f, 0.f, 0.f, 0.f};
        cur = nxt; cA = nA; cB = nB; ++ui;
        if (wr == 1) PG8_BAR;
    }
    PG8_WAIT_V(0);
    PG8_BAR;
#undef PG8_SA
#undef PG8_SB
#undef PG8_STAGE
#undef PG8_LDA
#undef PG8_LDB
#undef PG8_MMA
#undef PG8_WAIT_V
#undef PG8_WAIT_L
#undef PG8_BAR
#undef PG8_SCHED
}

struct EpiU {
    static constexpr bool PERM = true;
    bf16_t* O; int ldc;
    __device__ __forceinline__ void operator()(const f32x4 (&acc)[2][2][4][2], const Unit& u, int wr, int wc, int fr, int fq) const {
        const int row0 = u.pm * BM + wr * 64 + fr, col0 = u.pn * BM + wc * 32 + 8 * fq;
#pragma unroll
        for (int ai = 0; ai < 2; ++ai)
#pragma unroll
            for (int m = 0; m < 4; ++m) { bf16_t* rowp = O + (size_t)(row0 + ai * HALF + m * 16) * ldc + col0;
#pragma unroll
                for (int bj = 0; bj < 2; ++bj) { const f32x4 v0 = acc[ai][bj][m][0], v1 = acc[ai][bj][m][1];
                    u32x4 w; w.x = pk2(v0[0], v0[1]); w.y = pk2(v0[2], v0[3]); w.z = pk2(v1[0], v1[1]); w.w = pk2(v1[2], v1[3]);
                    *(u32x4*)(rowp + bj * HALF) = w; }
                asm volatile("" ::: "memory"); }
    }
};
struct EpiRowScale {
    static constexpr bool PERM = true;
    bf16_t* O; int ldc; const float* rs; float sc;
    __device__ __forceinline__ void operator()(const f32x4 (&acc)[2][2][4][2], const Unit& u, int wr, int wc, int fr, int fq) const {
        const int row0 = u.pm * BM + wr * 64 + fr, col0 = u.pn * BM + wc * 32 + 8 * fq;
#pragma unroll
        for (int ai = 0; ai < 2; ++ai)
#pragma unroll
            for (int m = 0; m < 4; ++m) { const int row = row0 + ai * HALF + m * 16; const float s = rs[row] * sc; bf16_t* rowp = O + (size_t)row * ldc + col0;
#pragma unroll
                for (int bj = 0; bj < 2; ++bj) { const f32x4 v0 = acc[ai][bj][m][0] * s, v1 = acc[ai][bj][m][1] * s;
                    u32x4 w; w.x = pk2(v0[0], v0[1]); w.y = pk2(v0[2], v0[3]); w.z = pk2(v1[0], v1[1]); w.w = pk2(v1[2], v1[3]);
                    *(u32x4*)(rowp + bj * HALF) = w; }
                asm volatile("" ::: "memory"); }
    }
};
struct EpiQ {
    static constexpr bool PERM = true;
    bf16_t* O; const float* rs; const float* cosT; const float* sinT;
    __device__ __forceinline__ void operator()(const f32x4 (&acc)[2][2][4][2], const Unit& u, int wr, int wc, int fr, int fq) const {
        const int row0 = u.pm * BM + wr * 64 + fr, col0 = u.pn * BM + wc * 32 + 8 * fq;
#pragma unroll
        for (int ai = 0; ai < 2; ++ai)
#pragma unroll
            for (int m = 0; m < 4; ++m) { const int row = row0 + ai * HALF + m * 16; const float s = rs[row] * QSCALE; bf16_t* rowp = O + (size_t)row * 1536 + col0;
#pragma unroll
                for (int bj = 0; bj < 2; ++bj) { f32x4 v0 = acc[ai][bj][m][0] * s, v1 = acc[ai][bj][m][1] * s;
                    const int cin = (col0 + bj * HALF) % 192;
                    if (cin >= 128) { const int j0 = (cin - 128) >> 1;
                        const f32x4 c = *(const f32x4*)(cosT + (size_t)row * 32 + j0), sn = *(const f32x4*)(sinT + (size_t)row * 32 + j0);
                        f32x4 r0, r1;
                        r0[0] = v0[0] * c[0] - v0[1] * sn[0]; r0[1] = v0[1] * c[0] + v0[0] * sn[0];
                        r0[2] = v0[2] * c[1] - v0[3] * sn[1]; r0[3] = v0[3] * c[1] + v0[2] * sn[1];
                        r1[0] = v1[0] * c[2] - v1[1] * sn[2]; r1[1] = v1[1] * c[2] + v1[0] * sn[2];
                        r1[2] = v1[2] * c[3] - v1[3] * sn[3]; r1[3] = v1[3] * c[3] + v1[2] * sn[3];
                        v0 = r0; v1 = r1; }
                    u32x4 w; w.x = pk2(v0[0], v0[1]); w.y = pk2(v0[2], v0[3]); w.z = pk2(v1[0], v1[1]); w.w = pk2(v1[2], v1[3]);
                    *(u32x4*)(rowp + bj * HALF) = w; }
                asm volatile("" ::: "memory"); }
    }
};
struct EpiColScale {
    static constexpr bool PERM = true;
    bf16_t* O; int ldc; const float* cs;
    __device__ __forceinline__ void operator()(const f32x4 (&acc)[2][2][4][2], const Unit& u, int wr, int wc, int fr, int fq) const {
        const int row0 = u.pm * BM + wr * 64 + fr, col0 = u.pn * BM + wc * 32 + 8 * fq;
        f32x4 sv[2][2];
#pragma unroll
        for (int bj = 0; bj < 2; ++bj)
#pragma unroll
            for (int n = 0; n < 2; ++n) sv[bj][n] = *(const f32x4*)(cs + col0 + bj * HALF + 4 * n);
#pragma unroll
        for (int ai = 0; ai < 2; ++ai)
#pragma unroll
            for (int m = 0; m < 4; ++m) { bf16_t* rowp = O + (size_t)(row0 + ai * HALF + m * 16) * ldc + col0;
#pragma unroll
                for (int bj = 0; bj < 2; ++bj) { const f32x4 v0 = acc[ai][bj][m][0] * sv[bj][0], v1 = acc[ai][bj][m][1] * sv[bj][1];
                    u32x4 w; w.x = pk2(v0[0], v0[1]); w.y = pk2(v0[2], v0[3]); w.z = pk2(v1[0], v1[1]); w.w = pk2(v1[2], v1[3]);
                    *(u32x4*)(rowp + bj * HALF) = w; }
                asm volatile("" ::: "memory"); }
    }
};
struct EpiRes {
    static constexpr bool PERM = false;
    float* C; const float* res;
    __device__ __forceinline__ void operator()(const f32x4 (&acc)[2][2][4][2], const Unit& u, int wr, int wc, int fr, int fq) const {
        const int row0 = u.pm * BM + wr * 64 + fr, col0 = u.pn * BM + wc * 32 + 4 * fq;
#pragma unroll
        for (int ai = 0; ai < 2; ++ai)
#pragma unroll
            for (int m = 0; m < 4; ++m) { const size_t ro = (size_t)(row0 + ai * HALF + m * 16) * DM + col0;
#pragma unroll
                for (int bj = 0; bj < 2; ++bj)
#pragma unroll
                    for (int n = 0; n < 2; ++n) { const f32x4 r = *(const f32x4*)(res + ro + bj * HALF + n * 16);
                        *(f32x4*)(C + ro + bj * HALF + n * 16) = r * ALPHA + acc[ai][bj][m][n]; } }
    }
};
}

__device__ __forceinline__ int wmap_col(int kind, int n) {
    if (kind == 0) return n < NIN ? n : -1;
    if (kind == 1) return n;
    if (kind == 2) { const int h = n / 192, c = n % 192; if (c < 128) return n; const int j = (c - 128) >> 1, e = (c - 128) & 1; return h * 192 + 128 + j + 32 * e; }
    if (kind == 3) { const int h = n >> 7, c = n & 127; return h * 256 + c; }
    { const int h = n >> 7, c = n & 127; return h * 256 + 128 + c; }
}
__device__ __forceinline__ void convert_weights(KP p, int l, LAS unsigned char* lds) {
    KP_FENCE(p);
    int tid = threadIdx.x; asm volatile("" : "+v"(tid));
    const int tx = tid & 63, ty = tid >> 6;
    LAS float* tile = (LAS float*)lds;
    const int nK[5] = {32, 32, 8, 4, 4}, nN[5] = {96, 32, 24, 16, 16};
    const int start1 = nK[0] * nN[0], start2 = start1 + nK[1] * nN[1], start3 = start2 + nK[2] * nN[2], start4 = start3 + nK[3] * nN[3], total = start4 + nK[4] * nN[4];
    for (int it = blockIdx.x; it < total; it += gridDim.x) {
        int kind, loc;
        if (it < start1) { kind = 0; loc = it; } else if (it < start2) { kind = 1; loc = it - start1; } else if (it < start3) { kind = 2; loc = it - start2; }
        else if (it < start4) { kind = 3; loc = it - start3; } else { kind = 4; loc = it - start4; }
        const float* src; bf16_t* dst; const float* g = nullptr; int K, Nsrc, nnt;
        if (kind == 0) { src = p->w_in + (size_t)l * DM * NIN; dst = (bf16_t*)(p->ws + WS_WIN); K = 2048; Nsrc = NIN; nnt = 96; }
        else if (kind == 1) { src = p->w_out + (size_t)l * DM * DM; dst = (bf16_t*)(p->ws + WS_WOUT); K = 2048; Nsrc = DM; nnt = 32; }
        else if (kind == 2) { src = p->w_uq + (size_t)l * 512 * 1536; dst = (bf16_t*)(p->ws + WS_WUQ); K = 512; Nsrc = 1536; nnt = 24; g = p->q_norm_g + l * 512; }
        else if (kind == 3) { src = p->w_ukv + (size_t)l * 256 * 2048; dst = (bf16_t*)(p->ws + WS_WUK); K = 256; Nsrc = 2048; nnt = 16; g = p->kv_norm_g + l * 256; }
        else { src = p->w_ukv + (size_t)l * 256 * 2048; dst = (bf16_t*)(p->ws + WS_WUV); K = 256; Nsrc = 2048; nnt = 16; g = p->kv_norm_g + l * 256; }
        const int n0 = (loc % nnt) * 64, k0 = (loc / nnt) * 64;
        const int sc = wmap_col(kind, n0 + tx);
#pragma unroll
        for (int i = 0; i < 8; ++i) { const int k = k0 + ty * 8 + i; float v = 0.f; if (sc >= 0) v = src[(size_t)k * Nsrc + sc]; if (g) v *= g[k]; tile[(ty * 8 + i) * 65 + tx] = v; }
        __syncthreads();
#pragma unroll
        for (int i = 0; i < 8; ++i) { const int n = n0 + ty * 8 + i; dst[(size_t)n * K + k0 + tx] = (bf16_t)f2bf(tile[tx * 65 + ty * 8 + i]); }
        __syncthreads();
    }
}

__device__ __forceinline__ void phase_p0(KP p, LAS unsigned char* lds) {
    KP_FENCE(p);
    const int tid = threadIdx.x;
    if (blockIdx.x == 0 && tid < 64) ((unsigned*)(p->ws + WS_CTL))[tid] = 0u;
    convert_weights(p, 0, lds);
    bf16_t* xb = (bf16_t*)(p->ws + WS_XB);
    const size_t n4 = (size_t)T * DM / 4;
    for (size_t i = (size_t)blockIdx.x * 512 + tid; i < n4; i += (size_t)gridDim.x * 512) {
        const f32x4 v = *(const f32x4*)(p->x + i * 4); u32x2 w; w.x = pk2(v[0], v[1]); w.y = pk2(v[2], v[3]); *(u32x2*)(xb + i * 4) = w; }
    float* cosT = (float*)(p->ws + WS_COS); float* sinT = (float*)(p->ws + WS_SIN);
    for (int i = blockIdx.x * 512 + tid; i < T * 32; i += gridDim.x * 512) {
        const int t = i >> 5, j = i & 31;
        const float ang = (float)p->pos[t] * p->inv_freq[j];
        double rev = (double)ang * 0.15915494309189535; rev -= rint(rev);
        cosT[i] = __builtin_amdgcn_cosf((float)rev); sinT[i] = __builtin_amdgcn_sinf((float)rev);
    }
}

__device__ __forceinline__ void phase_prep(KP p, int l, LAS unsigned char* lds) {
    KP_FENCE(p);
    int tid = threadIdx.x; asm volatile("" : "+v"(tid));
    const int lane = tid & 63, wave = tid >> 6, c = tid;
    const bf16_t* U = (const bf16_t*)(p->ws + WS_U);
    bf16_t* MIX = (bf16_t*)(p->ws + WS_MIX); bf16_t* KPEB = (bf16_t*)(p->ws + WS_KPE); bf16_t* SCAN = (bf16_t*)(p->ws + WS_SCAN);
    float* SC2 = (float*)(p->ws + WS_SC2); float* RSQ = (float*)(p->ws + WS_RS); float* RSKV = RSQ + T;
    const float* cosT = (const float*)(p->ws + WS_COS); const float* sinT = (const float*)(p->ws + WS_SIN);
    LAS float* sth = (LAS float*)lds;
    LAS float* spart = (LAS float*)(lds + 4096);
    float w2r[64], a2r[64];
#pragma unroll
    for (int j = 0; j < 64; ++j) { w2r[j] = p->w2[(size_t)l * 64 * 512 + j * 512 + c]; a2r[j] = p->a2[(size_t)l * 64 * 512 + j * 512 + c]; }
    const float* mu = p->mu + l * 1664;
    const float mu_r = mu[c], mu_k = mu[576 + c], mu_v = mu[1088 + c];
    const float w0c = p->w0[l * 512 + c], a0c = p->a0[l * 512 + c], kkc = p->k_k[l * 512 + c], kac = p->k_a[l * 512 + c], rkc = p->r_k[l * 512 + c];
    const float cw0 = p->conv_w[(l * 3 + 0) * 512 + c], cw1 = p->conv_w[(l * 3 + 1) * 512 + c], cw2 = p->conv_w[(l * 3 + 2) * 512 + c];
    for (int tile = blockIdx.x; tile < T / 128; tile += gridDim.x) {
        const int t0 = tile * 128; const bool first = (t0 % SEQ) == 0;
        float pr = 0.f, pk = 0.f, pv = 0.f, pu1 = 0.f, pu2 = 0.f;
        if (!first) { const bf16_t* up = U + (size_t)(t0 - 1) * LDU; pr = bf2f(up[C_RC + c]); pk = bf2f(up[C_RC + 576 + c]); pv = bf2f(up[C_RC + 1088 + c]);
            pu1 = bf2f(up[C_CC + c]) * bf2f(up[C_CH + c]); const bf16_t* up2 = up - LDU; pu2 = bf2f(up2[C_CC + c]) * bf2f(up2[C_CH + c]); }
        for (int sb = 0; sb < 16; ++sb) {
            const int tb = t0 + sb * 8;
#pragma unroll
            for (int i = 0; i < 2; ++i) { const int idx = tid + 512 * i, tok = idx >> 7, jj = idx & 127; const int t = tb + tok;
                const int cr = (jj < 64) ? (512 + jj) : (1600 + jj - 64);
                const float cur = bf2f(U[(size_t)t * LDU + C_RC + cr]); const float prev = (t % SEQ) == 0 ? 0.f : bf2f(U[(size_t)(t - 1) * LDU + C_RC + cr]);
                float xv = cur + (prev - cur) * mu[cr];
                if (jj < 64) { const float e = __expf(2.f * xv); xv = 1.f - 2.f / (e + 1.f); }
                sth[tok * 128 + jj] = xv; }
            if (tid < 256) { const int tok = tid >> 5, j = tid & 31, t = tb + tok; const bf16_t* ur = U + (size_t)t * LDU + C_KPE;
                const float x1 = bf2f(ur[j]), x2 = bf2f(ur[32 + j]), cs = cosT[t * 32 + j], sn = sinT[t * 32 + j];
                *(unsigned*)(KPEB + (size_t)t * 64 + 2 * j) = pk2(x1 * cs - x2 * sn, x2 * cs + x1 * sn); }
            __syncthreads();
#pragma unroll 2
            for (int tok = 0; tok < 8; ++tok) {
                const int t = tb + tok; const bf16_t* ur = U + (size_t)t * LDU;
                const float ur_ = bf2f(ur[C_RC + c]), uk_ = bf2f(ur[C_RC + 576 + c]), uv_ = bf2f(ur[C_RC + 1088 + c]);
                const float cb = bf2f(ur[C_CB + c]), cc = bf2f(ur[C_CC + c]), ch = bf2f(ur[C_CH + c]), cgt = bf2f(ur[C_CG + c]);
                const float cq = bf2f(ur[C_CQ + c]); const float ckv = (c < 256) ? bf2f(ur[C_CKV + c]) : 0.f;
                const float uc = cc * ch; const float yc = cw0 * pu2 + cw1 * pu1 + cw2 * uc; pu2 = pu1; pu1 = uc;
                MIX[(size_t)t * DM + c] = (bf16_t)f2bf(cb * yc * silu_f(cgt));
                const float sq = wave_sum(cq * cq), skv = wave_sum(ckv * ckv);
                if (lane == 0) { spart[(sb * 8 + tok) * 12 + wave] = sq; if (wave < 4) spart[(sb * 8 + tok) * 12 + 8 + wave] = skv; }
                const float r = ur_ + (pr - ur_) * mu_r, k = uk_ + (pk - uk_) * mu_k, v = uv_ + (pv - uv_) * mu_v; pr = ur_; pk = uk_; pv = uv_;
                float zw = w0c, za = a0c;
#pragma unroll
                for (int j4 = 0; j4 < 16; ++j4) { const f32x4 th = *(const LAS f32x4*)(sth + tok * 128 + j4 * 4), ad = *(const LAS f32x4*)(sth + tok * 128 + 64 + j4 * 4);
                    zw += th[0] * w2r[j4 * 4] + th[1] * w2r[j4 * 4 + 1] + th[2] * w2r[j4 * 4 + 2] + th[3] * w2r[j4 * 4 + 3];
                    za += ad[0] * a2r[j4 * 4] + ad[1] * a2r[j4 * 4 + 1] + ad[2] * a2r[j4 * 4 + 2] + ad[3] * a2r[j4 * 4 + 3]; }
                const float sp = fmaxf(-zw, 0.f) + __logf(1.f + __expf(-fabsf(zw)));
                const float wlog = -sp - 0.5f; const float dec = __expf(-__expf(wlog));
                const float asig = 1.f / (1.f + __expf(-za));
                const float kkr = k * kkc; const float nrm = sqrtf(wave_sum(kkr * kkr)); const float kk = kkr / fmaxf(nrm, 1e-12f);
                const float k2 = k * (1.f + (asig - 1.f) * kac);
                const float av = -kk, bv = kk * asig;
                const float br = wave_sum(bv * r), kr = wave_sum(k2 * r), rkb = wave_sum(r * k2 * rkc);
                bf16_t* so = SCAN + ((size_t)t * 8 + wave) * 384 + lane;
                *(unsigned*)(so + lane) = pk2(av, dec * r);
                so[128] = (bf16_t)f2bf(dec); so[192] = (bf16_t)f2bf(bv); so[256] = (bf16_t)f2bf(k2); so[320] = (bf16_t)f2bf(v);
                if (lane == 0) { f32x4 o4 = {br, kr, rkb, 0.f}; *(f32x4*)(SC2 + ((size_t)t * 8 + wave) * 4) = o4; }
            }
            __syncthreads();
        }
        if (tid < 128) { float sq = 0.f, skv = 0.f;
#pragma unroll
            for (int w = 0; w < 8; ++w) sq += spart[tid * 12 + w];
#pragma unroll
            for (int w = 0; w < 4; ++w) skv += spart[tid * 12 + 8 + w];
            RSQ[t0 + tid] = rsqrtf(sq * (1.f / 512.f) + RMS_EPS); RSKV[t0 + tid] = rsqrtf(skv * (1.f / 256.f) + RMS_EPS); }
        __syncthreads();
    }
}

namespace att {
constexpr int KROW = 400, VROW = 136, KT_BYTES = 64 * KROW, VT_BYTES = 128 * VROW, BUF_BYTES = KT_BYTES + VT_BYTES;
__device__ __forceinline__ void unit(KP p, int bh, int qb, LAS unsigned char* lds) {
    KP_FENCE(p);
    int tid = threadIdx.x; asm volatile("" : "+v"(tid));
    const int lane = tid & 63, w = __builtin_amdgcn_readfirstlane(tid >> 6), ql = lane & 31, hi = lane >> 5;
    const int b = bh >> 3, h = bh & 7, q0 = qb * 256;
    const bf16_t* Q = (const bf16_t*)(p->ws + WS_Q); const bf16_t* KN = (const bf16_t*)(p->ws + WS_KN); const bf16_t* KPEB = (const bf16_t*)(p->ws + WS_KPE);
    const bf16_t* VT = (const bf16_t*)(p->ws + WS_VT); const bf16_t* U = (const bf16_t*)(p->ws + WS_U); bf16_t* MIX = (bf16_t*)(p->ws + WS_MIX);
    const int qpos = q0 + 32 * w + ql; const size_t tq = (size_t)b * SEQ + qpos;
    bf16x8 qf[12];
    { const bf16_t* qp = Q + tq * 1536 + h * 192 + 8 * hi;
#pragma unroll
      for (int ks = 0; ks < 12; ++ks) qf[ks] = *(const bf16x8*)(qp + 16 * ks); }
    f32x16 o[4];
#pragma unroll
    for (int d = 0; d < 4; ++d)
#pragma unroll
        for (int i = 0; i < 16; ++i) o[d][i] = 0.f;
    float mrow = -1e30f, lsum = 0.f;
    const int nj = 4 * (qb + 1);
    const bf16_t* ksrc[3]; int kdst[3];
#pragma unroll
    for (int i = 0; i < 3; ++i) { const int idx = tid + 512 * i, key = idx / 24, cc = idx % 24; const size_t tk = (size_t)b * SEQ + key;
        ksrc[i] = (cc < 16) ? (KN + tk * 1024 + h * 128 + 8 * cc) : (KPEB + tk * 64 + 8 * (cc - 16)); kdst[i] = key * KROW + 16 * cc; }
    const int kstride[3] = {(tid % 24 < 16) ? 1024 : 64, ((tid + 512) % 24 < 16) ? 1024 : 64, ((tid + 1024) % 24 < 16) ? 1024 : 64};
    const bf16_t* vsrc[2]; int vdst[2];
#pragma unroll
    for (int i = 0; i < 2; ++i) { const int idx = tid + 512 * i, dv = idx >> 3, chn = idx & 7; vsrc[i] = VT + (size_t)(h * 128 + dv) * T + (size_t)b * SEQ + 8 * chn; vdst[i] = KT_BYTES + dv * VROW + 16 * chn; }
    u32x4 kreg[3], vreg[2];
#define ATT_GLOAD(j) do { _Pragma("unroll") for (int i = 0; i < 3; ++i) kreg[i] = *(const u32x4*)(ksrc[i] + (size_t)(j) * 64 * kstride[i]); \
                          _Pragma("unroll") for (int i = 0; i < 2; ++i) vreg[i] = *(const u32x4*)(vsrc[i] + (size_t)(j) * 64); } while (0)
#define ATT_LSTORE(bufo) do { _Pragma("unroll") for (int i = 0; i < 3; ++i) *(LAS u32x4*)(lds + (bufo) + kdst[i]) = kreg[i]; \
                              _Pragma("unroll") for (int i = 0; i < 2; ++i) { u32x2 lo = {vreg[i].x, vreg[i].y}, hi2 = {vreg[i].z, vreg[i].w}; \
                                  *(LAS u32x2*)(lds + (bufo) + vdst[i]) = lo; *(LAS u32x2*)(lds + (bufo) + vdst[i] + 8) = hi2; } } while (0)
    ATT_GLOAD(0); ATT_LSTORE(0);
    __syncthreads();
    for (int j = 0; j < nj; ++j) {
        const int cur = (j & 1) * BUF_BYTES, nxt = BUF_BYTES - cur;
        if (j + 1 < nj) ATT_GLOAD(j + 1);
        const int kt0 = 64 * j;
        if (kt0 <= q0 + 32 * w + 31) {
            f32x16 st0, st1;
#pragma unroll
            for (int i = 0; i < 16; ++i) { st0[i] = 0.f; st1[i] = 0.f; }
            const LAS unsigned char* kb = lds + cur + ql * KROW + 16 * hi;
#pragma unroll
            for (int ks = 0; ks < 12; ++ks) {
                const bf16x8 k0 = *(const LAS bf16x8*)(kb + 32 * ks), k1 = *(const LAS bf16x8*)(kb + 32 * KROW + 32 * ks);
                st0 = __builtin_amdgcn_mfma_f32_32x32x16_bf16(k0, qf[ks], st0, 0, 0, 0);
                st1 = __builtin_amdgcn_mfma_f32_32x32x16_bf16(k1, qf[ks], st1, 0, 0, 0);
            }
            if (kt0 + 63 > q0 + 32 * w) {
#pragma unroll
                for (int i = 0; i < 16; ++i) { const int key = kt0 + 8 * (i >> 2) + 4 * hi + (i & 3); if (key > qpos) st0[i] = -1e30f; if (key + 32 > qpos) st1[i] = -1e30f; }
            }
            float mx = fmaxf(st0[0], st1[0]);
#pragma unroll
            for (int i = 1; i < 16; ++i) mx = fmaxf(mx, fmaxf(st0[i], st1[i]));
            mx = fmaxf(mx, __shfl_xor(mx, 32));
            const float mnew = fmaxf(mrow, mx); const float alpha = __builtin_amdgcn_exp2f(mrow - mnew); mrow = mnew;
            float ps = 0.f;
#pragma unroll
            for (int i = 0; i < 16; ++i) { st0[i] = __builtin_amdgcn_exp2f(st0[i] - mnew); st1[i] = __builtin_amdgcn_exp2f(st1[i] - mnew); ps += st0[i] + st1[i]; }
            lsum = lsum * alpha + ps;
#pragma unroll
            for (int d = 0; d < 4; ++d)
#pragma unroll
                for (int i = 0; i < 16; ++i) o[d][i] *= alpha;
            bf16x8 pf[4];
#pragma unroll
            for (int s2 = 0; s2 < 4; ++s2) { u32x4 pw;
                if (s2 < 2) { pw.x = pk2(st0[8 * s2 + 0], st0[8 * s2 + 1]); pw.y = pk2(st0[8 * s2 + 2], st0[8 * s2 + 3]); pw.z = pk2(st0[8 * s2 + 4], st0[8 * s2 + 5]); pw.w = pk2(st0[8 * s2 + 6], st0[8 * s2 + 7]); }
                else { const int s3 = s2 - 2; pw.x = pk2(st1[8 * s3 + 0], st1[8 * s3 + 1]); pw.y = pk2(st1[8 * s3 + 2], st1[8 * s3 + 3]); pw.z = pk2(st1[8 * s3 + 4], st1[8 * s3 + 5]); pw.w = pk2(st1[8 * s3 + 6], st1[8 * s3 + 7]); }
                pf[s2] = __builtin_bit_cast(bf16x8, pw); }
            const LAS unsigned char* vb = lds + cur + KT_BYTES + ql * VROW + 8 * hi;
#pragma unroll
            for (int d = 0; d < 4; ++d)
#pragma unroll
                for (int s2 = 0; s2 < 4; ++s2) {
                    const u32x2 lo = *(const LAS u32x2*)(vb + d * 32 * VROW + 32 * s2), hi2 = *(const LAS u32x2*)(vb + d * 32 * VROW + 32 * s2 + 16);
                    u32x4 vw = {lo.x, lo.y, hi2.x, hi2.y};
                    o[d] = __builtin_amdgcn_mfma_f32_32x32x16_bf16(__builtin_bit_cast(bf16x8, vw), pf[s2], o[d], 0, 0, 0);
                }
        }
        if (j + 1 < nj) ATT_LSTORE(nxt);
        __syncthreads();
    }
#undef ATT_GLOAD
#undef ATT_LSTORE
    const float ltot = lsum + __shfl_xor(lsum, 32); const float inv = 1.f / ltot;
    const bf16_t* gp = U + tq * LDU + C_MG + h * 128; bf16_t* op = MIX + tq * DM + 512 + h * 128;
#pragma unroll
    for (int d = 0; d < 4; ++d)
#pragma unroll
        for (int g4 = 0; g4 < 4; ++g4) { const int dv0 = 32 * d + 8 * g4 + 4 * hi;
            const u32x2 gw = *(const u32x2*)(gp + dv0);
            const float g0 = __uint_as_float(gw.x << 16), g1 = __uint_as_float(gw.x & 0xffff0000u), g2 = __uint_as_float(gw.y << 16), g3 = __uint_as_float(gw.y & 0xffff0000u);
            u32x2 ow; ow.x = pk2(o[d][4 * g4 + 0] * inv * silu_f(g0), o[d][4 * g4 + 1] * inv * silu_f(g1)); ow.y = pk2(o[d][4 * g4 + 2] * inv * silu_f(g2), o[d][4 * g4 + 3] * inv * silu_f(g3));
            *(u32x2*)(op + dv0) = ow; }
}
}

namespace scan {
constexpr int CT = 32;
constexpr int IN_BYTES = CT * 6 * 64 * 4;
constexpr int OFF_IN = 0, OFF_SC2 = 2 * IN_BYTES, OFF_Y = OFF_SC2 + 2 * CT * 8, Y_BYTES = CT * 32 * 4;
__device__ __forceinline__ void run(KP p, int wg, LAS unsigned char* lds) {
    KP_FENCE(p);
    int tid = threadIdx.x; asm volatile("" : "+v"(tid));
    const int lane = tid & 63, w = __builtin_amdgcn_readfirstlane(tid >> 6);
    const int bh = wg >> 1, half = wg & 1, b = bh >> 3, h = bh & 7;
    const bf16_t* SCAN = (const bf16_t*)(p->ws + WS_SCAN); const float* SC2 = (const float*)(p->ws + WS_SC2); bf16_t* MIX = (bf16_t*)(p->ws + WS_MIX);
    const int nch = SEQ / CT;
    const bool stager = (w >= 4); const int stid = tid - 256;
    const int rg = lane >> 4, kq = lane & 15; const int rl0 = 8 * (w & 3) + 2 * rg;
    f32x4 s0 = {0.f, 0.f, 0.f, 0.f}, s1 = {0.f, 0.f, 0.f, 0.f};
    u32x4 ld[6]; f32x2 ld2 = {0.f, 0.f};
#define SC_GLOAD(c) do { const size_t tb = (size_t)b * SEQ + (size_t)(c) * CT; \
        _Pragma("unroll") for (int i = 0; i < 6; ++i) { const int idx = stid + 256 * i, tok = idx / 48, part = idx % 48; ld[i] = *(const u32x4*)(SCAN + ((tb + tok) * 8 + h) * 384 + 8 * part); } \
        if (stid < CT) ld2 = *(const f32x2*)(SC2 + ((tb + stid) * 8 + h) * 4); } while (0)
#define SC_LSTORE(c) do { const int bo = OFF_IN + ((c) & 1) * IN_BYTES; \
        _Pragma("unroll") for (int i = 0; i < 6; ++i) { const int idx = stid + 256 * i, tok = idx / 48, part = idx % 48; \
            f32x4 lo = {__uint_as_float(ld[i].x << 16), __uint_as_float(ld[i].x & 0xffff0000u), __uint_as_float(ld[i].y << 16), __uint_as_float(ld[i].y & 0xffff0000u)}; \
            f32x4 hi4 = {__uint_as_float(ld[i].z << 16), __uint_as_float(ld[i].z & 0xffff0000u), __uint_as_float(ld[i].w << 16), __uint_as_float(ld[i].w & 0xffff0000u)}; \
            *(LAS f32x4*)(lds + bo + (tok * 384 + part * 8) * 4) = lo; *(LAS f32x4*)(lds + bo + (tok * 384 + part * 8 + 4) * 4) = hi4; } \
        if (stid < CT) *(LAS f32x2*)(lds + OFF_SC2 + ((c) & 1) * CT * 8 + stid * 8) = ld2; } while (0)
#define SC_YOUT(c) do { const size_t tb = (size_t)b * SEQ + (size_t)(c) * CT; const int tok = stid >> 3, r4 = (stid & 7) * 4; \
        const f32x4 y4 = *(const LAS f32x4*)(lds + OFF_Y + ((c) & 1) * Y_BYTES + (tok * 32 + r4) * 4); \
        u32x2 ow; ow.x = pk2(y4[0], y4[1]); ow.y = pk2(y4[2], y4[3]); *(u32x2*)(MIX + (tb + tok) * DM + 1536 + h * 64 + 32 * half + r4) = ow; } while (0)
    if (stager) { SC_GLOAD(0); SC_LSTORE(0); }
    __syncthreads();
    for (int c = 0; c < nch; ++c) {
        if (stager) {
            if (c + 1 < nch) SC_GLOAD(c + 1);
            if (c >= 1) SC_YOUT(c - 1);
            if (c + 1 < nch) SC_LSTORE(c + 1);
        } else {
            const LAS unsigned char* ib = lds + OFF_IN + (c & 1) * IN_BYTES;
            const LAS unsigned char* pa = ib + kq * 32;
            const LAS unsigned char* pw = ib + 512 + kq * 16;
            const LAS unsigned char* pv = ib + (320 + 32 * half + rl0) * 4;
            const LAS unsigned char* sb = lds + OFF_SC2 + (c & 1) * CT * 8;
            LAS unsigned char* yb = lds + OFF_Y + (c & 1) * Y_BYTES + rl0 * 4;
            f32x4 aw01 = *(const LAS f32x4*)(pa), aw23 = *(const LAS f32x4*)(pa + 16), w4 = *(const LAS f32x4*)(pw), b4 = *(const LAS f32x4*)(pw + 256), k4 = *(const LAS f32x4*)(pw + 512);
            f32x2 v2 = *(const LAS f32x2*)(pv), bk = *(const LAS f32x2*)(sb);
            for (int blk = 0; blk < CT / 16; ++blk) {
                float yk0 = 0.f, yk1 = 0.f;
#pragma unroll
                for (int j = 0; j < 16; ++j) {
                    const int tok = blk * 16 + j, tn = (tok + 1 < CT) ? tok + 1 : tok;
                    const f32x4 naw01 = *(const LAS f32x4*)(pa + tn * 1536), naw23 = *(const LAS f32x4*)(pa + tn * 1536 + 16), nw4 = *(const LAS f32x4*)(pw + tn * 1536),
                                nb4 = *(const LAS f32x4*)(pw + tn * 1536 + 256), nk4 = *(const LAS f32x4*)(pw + tn * 1536 + 512);
                    const f32x2 nv2 = *(const LAS f32x2*)(pv + tn * 1536), nbk = *(const LAS f32x2*)(sb + tn * 8);
                    const f32x2 a0 = {aw01[0], aw01[1]}, a1 = {aw01[2], aw01[3]}, a2 = {aw23[0], aw23[1]}, a3 = {aw23[2], aw23[3]};
                    f32x2 pq0 = a0 * s0[0] + a1 * s0[1] + a2 * s0[2] + a3 * s0[3];
                    f32x2 pq1 = a0 * s1[0] + a1 * s1[1] + a2 * s1[2] + a3 * s1[3];
                    const f32x4 e0 = s0 * w4 + k4 * v2[0], e1 = s1 * w4 + k4 * v2[1];
                    float p0 = pq0[0], q0 = pq0[1], p1 = pq1[0], q1 = pq1[1];
                    asm volatile("s_nop 1\n\t"
                        "v_add_f32_dpp %0, %0, %0 quad_perm:[1,0,3,2] row_mask:0xf bank_mask:0xf\n\t"
                        "v_add_f32_dpp %1, %1, %1 quad_perm:[1,0,3,2] row_mask:0xf bank_mask:0xf\n\t"
                        "v_add_f32_dpp %2, %2, %2 quad_perm:[1,0,3,2] row_mask:0xf bank_mask:0xf\n\t"
                        "v_add_f32_dpp %3, %3, %3 quad_perm:[1,0,3,2] row_mask:0xf bank_mask:0xf\n\t"
                        "v_add_f32_dpp %0, %0, %0 quad_perm:[2,3,0,1] row_mask:0xf bank_mask:0xf\n\t"
                        "v_add_f32_dpp %1, %1, %1 quad_perm:[2,3,0,1] row_mask:0xf bank_mask:0xf\n\t"
                        "v_add_f32_dpp %2, %2, %2 quad_perm:[2,3,0,1] row_mask:0xf bank_mask:0xf\n\t"
                        "v_add_f32_dpp %3, %3, %3 quad_perm:[2,3,0,1] row_mask:0xf bank_mask:0xf\n\t"
                        "v_add_f32_dpp %0, %0, %0 row_half_mirror row_mask:0xf bank_mask:0xf\n\t"
                        "v_add_f32_dpp %1, %1, %1 row_half_mirror row_mask:0xf bank_mask:0xf\n\t"
                        "v_add_f32_dpp %2, %2, %2 row_half_mirror row_mask:0xf bank_mask:0xf\n\t"
                        "v_add_f32_dpp %3, %3, %3 row_half_mirror row_mask:0xf bank_mask:0xf\n\t"
                        "v_add_f32_dpp %0, %0, %0 row_mirror row_mask:0xf bank_mask:0xf\n\t"
                        "v_add_f32_dpp %1, %1, %1 row_mirror row_mask:0xf bank_mask:0xf\n\t"
                        "v_add_f32_dpp %2, %2, %2 row_mirror row_mask:0xf bank_mask:0xf\n\t"
                        "v_add_f32_dpp %3, %3, %3 row_mirror row_mask:0xf bank_mask:0xf\n\t"
                        "s_nop 1"
                        : "+v"(p0), "+v"(q0), "+v"(p1), "+v"(q1));
                    s0 = e0 + b4 * p0; s1 = e1 + b4 * p1;
                    const float y0 = q0 + p0 * bk[0] + v2[0] * bk[1], y1 = q1 + p1 * bk[0] + v2[1] * bk[1];
                    const bool mine = (kq == j);
                    yk0 = mine ? y0 : yk0; yk1 = mine ? y1 : yk1;
                    aw01 = naw01; aw23 = naw23; w4 = nw4; b4 = nb4; k4 = nk4; v2 = nv2; bk = nbk;
                }
                { f32x2 yy = {yk0, yk1}; *(LAS f32x2*)(yb + (blk * 16 + kq) * 128) = yy; }
            }
        }
        __syncthreads();
    }
    if (stager) SC_YOUT(nch - 1);
#undef SC_GLOAD
#undef SC_LSTORE
#undef SC_YOUT
    __syncthreads();
}
}

constexpr int N_SCAN_WG = 32, N_ATT_UNITS = 1024;
__device__ __forceinline__ void phase_mix(KP p, int l, LAS unsigned char* lds) {
    KP_FENCE(p);
    if ((PH & 256) && (int)blockIdx.x < N_SCAN_WG) { scan::run(p, blockIdx.x, lds); if (DUP & 8) scan::run(p, blockIdx.x, lds); }
    LAS int* qword = (LAS int*)(lds + LDS_MISC);
    for (int rep = 0; rep < ((DUP & 16) ? 2 : 1); ++rep) {
    unsigned* ctr = (unsigned*)(p->ws + WS_CTL) + l + 2 * rep;
    for (;;) {
        if (threadIdx.x == 0) *qword = (int)atomicAdd(ctr, 1u);
        __syncthreads();
        const int n = *qword;
        __syncthreads();
        if (n >= N_ATT_UNITS) break;
        if (PH & 512) att::unit(p, n & 15, 63 - (n >> 4), lds);
    }
    }
}

__device__ __forceinline__ void phase_gn(KP p, int l) {
    KP_FENCE(p);
    int tid = threadIdx.x; asm volatile("" : "+v"(tid));
    const int lane = tid & 63, wave = tid >> 6, c = tid;
    bf16_t* MIX = (bf16_t*)(p->ws + WS_MIX); const bf16_t* U = (const bf16_t*)(p->ws + WS_U); const bf16_t* SCAN = (const bf16_t*)(p->ws + WS_SCAN); const float* SC2 = (const float*)(p->ws + WS_SC2);
    const float g = p->gn_g[l * 512 + c], bta = p->gn_b[l * 512 + c];
    for (int t = blockIdx.x; t < T; t += gridDim.x) {
        const float y = bf2f(MIX[(size_t)t * DM + 1536 + c]);
        const float v = bf2f(SCAN[((size_t)t * 8 + wave) * 384 + 320 + lane]);
        const float rkb = SC2[((size_t)t * 8 + wave) * 4 + 2];
        const float gate = bf2f(U[(size_t)t * LDU + C_RG + c]);
        const float mean = wave_sum(y) * (1.f / 64.f); const float d = y - mean; const float var = wave_sum(d * d) * (1.f / 64.f);
        const float yn = d * rsqrtf(var + GN_EPS) * g + bta + rkb * v;
        MIX[(size_t)t * DM + 1536 + c] = (bf16_t)f2bf(yn * silu_f(gate));
    }
}

__device__ __forceinline__ void phase_ln(KP p, int l, bool write_xb) {
    KP_FENCE(p);
    int tid = threadIdx.x; asm volatile("" : "+v"(tid));
    const int lane = tid & 63, wave = tid >> 6;
    bf16_t* xb = (bf16_t*)(p->ws + WS_XB);
    f32x4 g[8], bb[8];
#pragma unroll
    for (int i = 0; i < 8; ++i) { g[i] = *(const f32x4*)(p->ln_g + l * DM + (i * 64 + lane) * 4); bb[i] = *(const f32x4*)(p->ln_b + l * DM + (i * 64 + lane) * 4); }
    for (int row = blockIdx.x * 8 + wave; row < T; row += gridDim.x * 8) {
        float* rp = p->out + (size_t)row * DM;
        f32x4 v[8]; float s = 0.f;
#pragma unroll
        for (int i = 0; i < 8; ++i) { v[i] = *(const f32x4*)(rp + (i * 64 + lane) * 4); s += v[i][0] + v[i][1] + v[i][2] + v[i][3]; }
        const float mean = wave_sum(s) * (1.f / DM);
        float q = 0.f;
#pragma unroll
        for (int i = 0; i < 8; ++i) { v[i] = v[i] - mean; q += v[i][0] * v[i][0] + v[i][1] * v[i][1] + v[i][2] * v[i][2] + v[i][3] * v[i][3]; }
        const float rstd = rsqrtf(wave_sum(q) * (1.f / DM) + LN_EPS);
#pragma unroll
        for (int i = 0; i < 8; ++i) { const f32x4 y = v[i] * rstd * g[i] + bb[i]; *(f32x4*)(rp + (i * 64 + lane) * 4) = y;
            if (write_xb) { u32x2 wv; wv.x = pk2(y[0], y[1]); wv.y = pk2(y[2], y[3]); *(u32x2*)(xb + (size_t)row * DM + (i * 64 + lane) * 4) = wv; } }
    }
}

#define PHASE_FENCE() do { __builtin_amdgcn_sched_barrier(0); asm volatile("" ::: "memory"); __syncthreads(); __builtin_amdgcn_sched_barrier(0); } while (0)
__global__ void __launch_bounds__(512, 2) fwd_megakernel(Params p_in) {
    KP p = (KP)__builtin_amdgcn_kernarg_segment_ptr();
    extern __shared__ __attribute__((aligned(16))) unsigned char smem[];
    LAS unsigned char* lds = (LAS unsigned char*)smem;
    cg::grid_group grid = cg::this_grid();
    const int G = gridDim.x;
    bf16_t* U = (bf16_t*)(p->ws + WS_U); bf16_t* XB = (bf16_t*)(p->ws + WS_XB); bf16_t* MIX = (bf16_t*)(p->ws + WS_MIX);
    float* RSQ = (float*)(p->ws + WS_RS); float* RSKV = RSQ + T;

    if (PH & 1) phase_p0(p, lds);
    grid.sync();
    for (int l = 0; l < DEPTH; ++l) {
        for (int rep = 0; rep < ((DUP & 1) ? 2 : 1); ++rep)
        if (PH & 2) { pg8::Gemm g{XB, (const bf16_t*)(p->ws + WS_WIN), T, LDU, DM, DM, DM}; pg8::StaticOrder S; S.init(T, LDU, G, (int)blockIdx.x);
          pg8::EpiU E{U, LDU}; pg8::gemm_phase(lds, g, S, E); }
        grid.sync();
        for (int rep = 0; rep < ((DUP & 2) ? 2 : 1); ++rep)
        if (PH & 4) phase_prep(p, l, lds);
        grid.sync();
        PHASE_FENCE();
        if (PH & 8) { pg8::Gemm g{U + C_CQ, (const bf16_t*)(p->ws + WS_WUQ), T, 1536, 512, LDU, 512}; pg8::StaticOrder S; S.init(T, 1536, G, (int)blockIdx.x);
          pg8::EpiQ E{(bf16_t*)(p->ws + WS_Q), RSQ, (const float*)(p->ws + WS_COS), (const float*)(p->ws + WS_SIN)}; pg8::gemm_phase(lds, g, S, E); }
        PHASE_FENCE();
        if (PH & 1024) { pg8::Gemm g{U + C_CKV, (const bf16_t*)(p->ws + WS_WUK), T, 1024, 256, LDU, 256}; pg8::StaticOrder S; S.init(T, 1024, G, (int)blockIdx.x);
          pg8::EpiRowScale E{(bf16_t*)(p->ws + WS_KN), 1024, RSKV, 1.f}; pg8::gemm_phase(lds, g, S, E); }
        PHASE_FENCE();
        if (PH & 2048) { pg8::Gemm g{(const bf16_t*)(p->ws + WS_WUV), U + C_CKV, 1024, T, 256, 256, LDU}; pg8::StaticOrder S; S.init(1024, T, G, (int)blockIdx.x);
          pg8::EpiColScale E{(bf16_t*)(p->ws + WS_VT), T, RSKV}; pg8::gemm_phase(lds, g, S, E); }
        grid.sync();
        if (PH & 16) phase_mix(p, l, lds);
        grid.sync();
        if (PH & 32) phase_gn(p, l);
        grid.sync();
        if (PH & 64) { pg8::Gemm g{MIX, (const bf16_t*)(p->ws + WS_WOUT), T, DM, DM, DM, DM}; pg8::StaticOrder S; S.init(T, DM, G, (int)blockIdx.x);
          pg8::EpiRes E{p->out, l == 0 ? p->x : p->out}; pg8::gemm_phase(lds, g, S, E); }
        grid.sync();
        if (PH & 128) phase_ln(p, l, l + 1 < DEPTH);
        if (l + 1 < DEPTH) { if (PH & 1) convert_weights(p, l + 1, lds); grid.sync(); }
    }
}

extern "C" void kernel_launch(void* const* d_in, const int* in_sizes, int n_in, void* d_out, int out_size, void* d_ws, size_t ws_size, hipStream_t stream) {
    static int grid = 0;
    if (grid == 0) {
        if (n_in != 21 || ws_size < WS_END) { fprintf(stderr, "kernel_launch: unexpected n_in %d or ws_size %zu (need %zu)\n", n_in, ws_size, (size_t)WS_END); grid = -1; return; }
        int dev = 0, cus = 0, per_cu = 0;
        hipGetDevice(&dev); hipDeviceGetAttribute(&cus, hipDeviceAttributeMultiprocessorCount, dev);
        if (hipFuncSetAttribute((const void*)fwd_megakernel, hipFuncAttributeMaxDynamicSharedMemorySize, LDS_BYTES) != hipSuccess) { fprintf(stderr, "kernel_launch: hipFuncSetAttribute failed\n"); grid = -1; return; }
        if (hipOccupancyMaxActiveBlocksPerMultiprocessor(&per_cu, (const void*)fwd_megakernel, 512, LDS_BYTES) != hipSuccess || per_cu < 1) { fprintf(stderr, "kernel_launch: occupancy query gave %d\n", per_cu); per_cu = 1; }
        (void)hipGetLastError();
        grid = cus * per_cu;
    }
    if (grid < 0) return;
    Params p{};
    p.x = (const float*)d_in[0]; p.pos = (const int*)d_in[1]; p.w_in = (const float*)d_in[2]; p.conv_w = (const float*)d_in[3]; p.q_norm_g = (const float*)d_in[4];
    p.w_uq = (const float*)d_in[5]; p.kv_norm_g = (const float*)d_in[6]; p.w_ukv = (const float*)d_in[7]; p.mu = (const float*)d_in[8]; p.w0 = (const float*)d_in[9];
    p.w2 = (const float*)d_in[10]; p.a0 = (const float*)d_in[11]; p.a2 = (const float*)d_in[12]; p.k_k = (const float*)d_in[13]; p.k_a = (const float*)d_in[14];
    p.r_k = (const float*)d_in[15]; p.gn_g = (const float*)d_in[16]; p.gn_b = (const float*)d_in[17]; p.w_out = (const float*)d_in[18]; p.ln_g = (const float*)d_in[19]; p.ln_b = (const float*)d_in[20];
    p.out = (float*)d_out; p.ws = (unsigned char*)d_ws;
    for (int j = 0; j < 32; ++j) p.inv_freq[j] = (float)pow(10000.0, -(double)(2 * j) / 64.0);
    void* args[] = {&p};
    hipError_t e = hipLaunchCooperativeKernel((const void*)fwd_megakernel, dim3(grid), dim3(512), args, LDS_BYTES, stream);
    if (e != hipSuccess) fprintf(stderr, "cooperative launch failed: %s (grid %d)\n", hipGetErrorString(e), grid);
}
```

```cpp
#include <hip/hip_runtime.h>
#include <hip/hip_cooperative_groups.h>
#include <cstdio>
#include <cstdint>
#include <cmath>
namespace cg = cooperative_groups;

#define LAS __attribute__((address_space(3)))
typedef unsigned short bf16_t;
typedef short bf16x8 __attribute__((ext_vector_type(8)));
typedef short s16x4 __attribute__((ext_vector_type(4)));
typedef float f32x4 __attribute__((ext_vector_type(4)));
typedef float f32x2 __attribute__((ext_vector_type(2)));
typedef float f32x16 __attribute__((ext_vector_type(16)));
typedef unsigned u32x4 __attribute__((ext_vector_type(4)));
typedef unsigned u32x2 __attribute__((ext_vector_type(2)));
typedef __bf16 bf16x2_t __attribute__((ext_vector_type(2)));

constexpr int T = 32768, SEQ = 16384, DM = 2048, NIN = 6080, LDU = 6144, DEPTH = 2;
constexpr int C_CB = 0, C_CC = 512, C_CH = 1024, C_CG = 1536, C_CQ = 2048, C_CKV = 2560, C_KPE = 2816, C_MG = 2880, C_RC = 3904, C_RG = 5568;
constexpr int NHEAD = 8;
constexpr float LN_EPS = 1e-5f, RMS_EPS = 1e-6f, GN_EPS = 64e-5f;
constexpr float ALPHA = 1.4142135623730951f;
constexpr float QSCALE = 0.07216878364870323f * 1.4426950408889634f;

constexpr size_t MiB = 1u << 20;
constexpr size_t WS_CTL = 0, WS_WIN = 1 * MiB, WS_WOUT = 25 * MiB, WS_WUQ = 33 * MiB, WS_WUK = 35 * MiB, WS_WUV = 36 * MiB, WS_RS = 37 * MiB,
                 WS_SC2 = 38 * MiB, WS_COS = 42 * MiB, WS_SIN = 46 * MiB, WS_U = 50 * MiB, WS_MIX = 434 * MiB, WS_XB = 562 * MiB, WS_Q = 562 * MiB,
                 WS_KPE = 658 * MiB, WS_KN = 690 * MiB, WS_VT = 754 * MiB, WS_SCAN = 818 * MiB, WS_END = 1010 * MiB;

constexpr int LDS_BYTES = 131072 + 256, LDS_MISC = 131072;

struct Params {
    const float* x; const int* pos; const float* w_in; const float* conv_w; const float* q_norm_g; const float* w_uq; const float* kv_norm_g; const float* w_ukv;
    const float* mu; const float* w0; const float* w2; const float* a0; const float* a2; const float* k_k; const float* k_a; const float* r_k; const float* gn_g; const float* gn_b;
    const float* w_out; const float* ln_g; const float* ln_b;
    float* out; unsigned char* ws;
    float inv_freq[32];
};

typedef const __attribute__((address_space(4))) Params* KP;
#define KP_FENCE(p) asm volatile("" : "+s"(p))
__device__ __forceinline__ float bf2f(unsigned short v) { return __uint_as_float(((unsigned)v) << 16); }
__device__ __forceinline__ unsigned f2bf(float f) { unsigned u = __float_as_uint(f); return (u + 0x7fffu + ((u >> 16) & 1u)) >> 16; }
__device__ __forceinline__ unsigned pk2(float lo, float hi) { f32x2 v = {lo, hi}; bf16x2_t b = __builtin_convertvector(v, bf16x2_t); return __builtin_bit_cast(unsigned, b); }
__device__ __forceinline__ float silu_f(float x) { return x / (1.f + __expf(-x)); }
__device__ __forceinline__ float dppf(float v, int ctrl) { return v; }
template <int CTRL> __device__ __forceinline__ float dpp_mov(float v) { return __int_as_float(__builtin_amdgcn_update_dpp(__float_as_int(v), __float_as_int(v), CTRL, 0xf, 0xf, false)); }
__device__ __forceinline__ float row16_sum(float v) {
    v += dpp_mov<0xB1>(v);
    v += dpp_mov<0x4E>(v);
    v += dpp_mov<0x141>(v);
    v += dpp_mov<0x140>(v);
    return v;
}
__device__ __forceinline__ float wave_sum(float v) { v = row16_sum(v); v += __shfl_xor(v, 16); v += __shfl_xor(v, 32); return v; }

#ifndef PH
#define PH 0xffff
#endif
#ifndef DUP
#define DUP 0
#endif
namespace pg8 {
constexpr int BM = 256, BK = 64, HALF = 128, HTB = HALF * BK * 2, STAGE_BYTES = 8 * HTB, NXCD = 8, WGM = 8;
__host__ __device__ __forceinline__ int lds_byte(int r, int c) { const int st = (r >> 4) * 2 + (c >> 5), rr = r & 15, cc = c & 31, ob = rr * 64 + cc * 2; return st * 1024 + (ob ^ (((ob >> 9) & 1) << 5)); }
__host__ __device__ __forceinline__ void stage_rc(int b, int& R, int& C) { const int st = b / 1024, sb = b % 1024, swz = sb ^ (((sb >> 9) & 1) << 5); R = (st >> 1) * 16 + swz / 64; C = (st & 1) * 32 + (swz % 64) / 2; }
__host__ __device__ __forceinline__ int perm32(int rho) { const int n = rho >> 4, i = rho & 15; return 8 * (i >> 2) + 4 * n + (i & 3); }
struct Unit { int pm, pn; };
struct Gemm { const bf16_t* A; const bf16_t* Bt; int M, N, K, lda, ldb; };
struct StaticOrder {
    int nM, nN, nwg, G, c;
    __device__ void init(int M, int N, int G_, int c_) { nM = M / BM; nN = N / BM; nwg = nM * nN; G = G_; c = c_; }
    __device__ bool next(int i, Unit& u) const {
        const long L = (long)i * G + c; if (L >= nwg) return false;
        int wgid = (int)L; { const int q = nwg / NXCD, r = nwg % NXCD, xcd = wgid % NXCD, off = wgid / NXCD; wgid = (xcd < r ? xcd * (q + 1) : r * (q + 1) + (xcd - r) * q) + off; }
        const int nig = WGM * nN, gid = wgid / nig, fm = gid * WGM, gsz = (nM - fm) < WGM ? (nM - fm) : WGM;
        u.pm = fm + ((wgid % nig) % gsz); u.pn = (wgid % nig) / gsz; return true;
    }
};
template <class Epi>
__device__ __forceinline__ void gemm_phase(LAS unsigned char* lds, const Gemm g, const StaticOrder& S, const Epi& E) {
    int tid = threadIdx.x; asm volatile("" : "+v"(tid));
    const int wid = __builtin_amdgcn_readfirstlane(tid >> 6), lane = tid & 63, wr = wid >> 2, wc = wid & 3, fr = lane & 15, fq = lane >> 4;
    int K = g.K; asm volatile("" : "+s"(K));
    const int nt = K / BK;
    unsigned voffA[2], voffB[2];
#pragma unroll
    for (int i = 0; i < 2; ++i) { int R, C; stage_rc(tid * 16 + i * 8192, R, C); const int Rb = Epi::PERM ? ((R & ~31) + perm32(R & 31)) : R;
        voffA[i] = (unsigned)(R * g.lda + C) * 2u; voffB[i] = (unsigned)(Rb * g.ldb + C) * 2u; }
    const size_t kstep = (size_t)(BK * 2);
    const size_t hstepA = (size_t)HALF * g.lda * 2, hstepB = (size_t)HALF * g.ldb * 2;
    const size_t tstepA = 2 * hstepA, tstepB = 2 * hstepB;
    const unsigned ldsw = (unsigned)wid * 1024u;
    const int aoff = lds_byte(wr * 64 + fr, fq * 8), boff = lds_byte(wc * 32 + fr, fq * 8);
#define PG8_SA(b, h) (((b) * 2 + (h)) * HTB)
#define PG8_SB(b, h) ((4 + (b) * 2 + (h)) * HTB)
#define PG8_STAGE(bufoff, gbase, voff) do { _Pragma("unroll") for (int _i = 0; _i < 2; ++_i) \
        __builtin_amdgcn_global_load_lds((const unsigned*)((const char*)(gbase) + (voff)[_i]), (LAS unsigned*)(lds + (bufoff) + ldsw + _i * 8192), 16, 0, 0); } while (0)
#define PG8_LDA(dst, b, h) do { _Pragma("unroll") for (int m = 0; m < 4; ++m) _Pragma("unroll") for (int k = 0; k < 2; ++k) dst[m][k] = *(const LAS bf16x8*)(lds + PG8_SA(b, h) + aoff + m * 2048 + k * 1024); } while (0)
#define PG8_LDB(dst, b, h) do { _Pragma("unroll") for (int n = 0; n < 2; ++n) _Pragma("unroll") for (int k = 0; k < 2; ++k) dst[n][k] = *(const LAS bf16x8*)(lds + PG8_SB(b, h) + boff + n * 2048 + k * 1024); } while (0)
#define PG8_MMA(ai, bj, At, Bt) do { __builtin_amdgcn_s_setprio(1); _Pragma("unroll") for (int m = 0; m < 4; ++m) _Pragma("unroll") for (int n = 0; n < 2; ++n) _Pragma("unroll") for (int k = 0; k < 2; ++k) \
        acc[ai][bj][m][n] = __builtin_amdgcn_mfma_f32_16x16x32_bf16(Bt[n][k], At[m][k], acc[ai][bj][m][n], 0, 0, 0); __builtin_amdgcn_s_setprio(0); } while (0)
#define PG8_WAIT_V(n) asm volatile("s_waitcnt vmcnt(" #n ")" ::: "memory")
#define PG8_WAIT_L(n) asm volatile("s_waitcnt lgkmcnt(" #n ")" ::: "memory")
#define PG8_BAR __builtin_amdgcn_s_barrier()
#define PG8_SCHED __builtin_amdgcn_sched_barrier(0)
    Unit cur, nxt; int ui = 0;
    if (!S.next(0, cur)) return;
    f32x4 acc[2][2][4][2];
#pragma unroll
    for (int a = 0; a < 2; ++a)
#pragma unroll
        for (int b = 0; b < 2; ++b)
#pragma unroll
            for (int m = 0; m < 4; ++m)
#pragma unroll
                for (int n = 0; n < 2; ++n) acc[a][b][m][n] = (f32x4){0.f, 0.f, 0.f, 0.f};
    bf16x8 At[4][2], B0[2][2], B1[2][2];
    const char* cA = (const char*)g.A + (size_t)cur.pm * tstepA; const char* cB = (const char*)g.Bt + (size_t)cur.pn * tstepB;
    PG8_STAGE(PG8_SB(0, 0), cB, voffB); PG8_STAGE(PG8_SB(0, 1), cB + hstepB, voffB); PG8_STAGE(PG8_SA(0, 0), cA, voffA); PG8_STAGE(PG8_SA(0, 1), cA + hstepA, voffA);
    if (wr == 1) PG8_BAR;
    PG8_WAIT_V(2); PG8_BAR;
    PG8_STAGE(PG8_SB(1, 0), cB + kstep, voffB); PG8_STAGE(PG8_SA(1, 0), cA + kstep, voffA); PG8_STAGE(PG8_SB(1, 1), cB + hstepB + kstep, voffB);
    PG8_WAIT_V(6); PG8_BAR;
    for (;;) {
        const bool has_next = S.next(ui + 1, nxt);
        const char* nA = has_next ? (const char*)g.A + (size_t)nxt.pm * tstepA : cA; const char* nB = has_next ? (const char*)g.Bt + (size_t)nxt.pn * tstepB : cB;
        for (int t = 0; t < nt; t += 2) {
            const bool last = (t == nt - 2);
            const char* a1 = cA + (size_t)(t + 1) * kstep;
            const char* a2 = last ? nA : cA + (size_t)(t + 2) * kstep; const char* b2 = last ? nB : cB + (size_t)(t + 2) * kstep;
            const char* a3 = a2 + kstep; const char* b3 = b2 + kstep;
            PG8_LDB(B0, 0, 0); PG8_LDB(B1, 0, 1); PG8_SCHED; PG8_LDA(At, 0, 0); PG8_STAGE(PG8_SA(1, 1), a1 + hstepA, voffA);
            PG8_WAIT_V(8); PG8_WAIT_L(0); PG8_BAR; PG8_MMA(0, 0, At, B0); PG8_MMA(0, 1, At, B1); PG8_BAR; PG8_SCHED;
            PG8_LDA(At, 0, 1); PG8_STAGE(PG8_SB(0, 0), b2, voffB); PG8_STAGE(PG8_SB(0, 1), b2 + hstepB, voffB); PG8_STAGE(PG8_SA(0, 0), a2, voffA);
            PG8_WAIT_V(8); PG8_WAIT_L(0); PG8_BAR; PG8_MMA(1, 0, At, B0); PG8_MMA(1, 1, At, B1); PG8_BAR; PG8_SCHED;
            PG8_LDB(B0, 1, 0); PG8_LDB(B1, 1, 1); PG8_SCHED; PG8_LDA(At, 1, 0); PG8_STAGE(PG8_SA(0, 1), a2 + hstepA, voffA);
            PG8_WAIT_V(8); PG8_WAIT_L(0); PG8_BAR; PG8_MMA(0, 0, At, B0); PG8_MMA(0, 1, At, B1); PG8_BAR; PG8_SCHED;
            PG8_LDA(At, 1, 1); PG8_STAGE(PG8_SB(1, 0), b3, voffB); PG8_STAGE(PG8_SB(1, 1), b3 + hstepB, voffB); PG8_STAGE(PG8_SA(1, 0), a3, voffA);
            PG8_WAIT_V(8); PG8_WAIT_L(0); PG8_BAR; PG8_MMA(1, 0, At, B0); PG8_MMA(1, 1, At, B1); PG8_BAR; PG8_SCHED;
        }
        if (wr == 0) PG8_BAR;
        E(acc, cur, wr, wc, fr, fq);
        if (!has_next) break;
#pragma unroll
        for (int a = 0; a < 2; ++a)
#pragma unroll
            for (int b = 0; b < 2; ++b)
#pragma unroll
                for (int m = 0; m < 4; ++m)
#pragma unroll
                    for (int n = 0; n < 2; ++n) acc[a][b][m][n] = (f32x4){0.f, 0.f, 0.f, 0.f};
        cur = nxt; cA = nA; cB = nB; ++ui;
        if (wr == 1) PG8_BAR;
    }
    PG8_WAIT_V(0);
    PG8_BAR;
#undef PG8_SA
#undef PG8_SB
#undef PG8_STAGE
#undef PG8_LDA
#undef PG8_LDB
#undef PG8_MMA
#undef PG8_WAIT_V
#undef PG8_WAIT_L
#undef PG8_BAR
#undef PG8_SCHED
}

struct EpiU {
    static constexpr bool PERM = true;
    bf16_t* O; int ldc;
    __device__ __forceinline__ void operator()(const f32x4 (&acc)[2][2][4][2], const Unit& u, int wr, int wc, int fr, int fq) const {
        const int row0 = u.pm * BM + wr * 64 + fr, col0 = u.pn * BM + wc * 32 + 8 * fq;
#pragma unroll
        for (int ai = 0; ai < 2; ++ai)
#pragma unroll
            for (int m = 0; m < 4; ++m) { bf16_t* rowp = O + (size_t)(row0 + ai * HALF + m * 16) * ldc + col0;
#pragma unroll
                for (int bj = 0; bj < 2; ++bj) { const f32x4 v0 = acc[ai][bj][m][0], v1 = acc[ai][bj][m][1];
                    u32x4 w; w.x = pk2(v0[0], v0[1]); w.y = pk2(v0[2], v0[3]); w.z = pk2(v1[0], v1[1]); w.w = pk2(v1[2], v1[3]);
                    *(u32x4*)(rowp + bj * HALF) = w; }
                asm volatile("" ::: "memory"); }
    }
};
struct EpiRowScale {
    static constexpr bool PERM = true;
    bf16_t* O; int ldc; const float* rs; float sc;
    __device__ __forceinline__ void operator()(const f32x4 (&acc)[2][2][4][2], const Unit& u, int wr, int wc, int fr, int fq) const {
        const int row0 = u.pm * BM + wr * 64 + fr, col0 = u.pn * BM + wc * 32 + 8 * fq;
#pragma unroll
        for (int ai = 0; ai < 2; ++ai)
#pragma unroll
            for (int m = 0; m < 4; ++m) { const int row = row0 + ai * HALF + m * 16; const float s = rs[row] * sc; bf16_t* rowp = O + (size_t)row * ldc + col0;
#pragma unroll
                for (int bj = 0; bj < 2; ++bj) { const f32x4 v0 = acc[ai][bj][m][0] * s, v1 = acc[ai][bj][m][1] * s;
                    u32x4 w; w.x = pk2(v0[0], v0[1]); w.y = pk2(v0[2], v0[3]); w.z = pk2(v1[0], v1[1]); w.w = pk2(v1[2], v1[3]);
                    *(u32x4*)(rowp + bj * HALF) = w; }
                asm volatile("" ::: "memory"); }
    }
};
struct EpiQ {
    static constexpr bool PERM = true;
    bf16_t* O; const float* rs; const float* cosT; const float* sinT;
    __device__ __forceinline__ void operator()(const f32x4 (&acc)[2][2][4][2], const Unit& u, int wr, int wc, int fr, int fq) const {
        const int row0 = u.pm * BM + wr * 64 + fr, col0 = u.pn * BM + wc * 32 + 8 * fq;
#pragma unroll
        for (int ai = 0; ai < 2; ++ai)
#pragma unroll
            for (int m = 0; m < 4; ++m) { const int row = row0 + ai * HALF + m * 16; const float s = rs[row] * QSCALE; bf16_t* rowp = O + (size_t)row * 1536 + col0;
#pragma unroll
                for (int bj = 0; bj < 2; ++bj) { f32x4 v0 = acc[ai][bj][m][0] * s, v1 = acc[ai][bj][m][1] * s;
                    const int cin = (col0 + bj * HALF) % 192;
                    if (cin >= 128) { const int j0 = (cin - 128) >> 1;
                        const f32x4 c = *(const f32x4*)(cosT + (size_t)row * 32 + j0), sn = *(const f32x4*)(sinT + (size_t)row * 32 + j0);
                        f32x4 r0, r1;
                        r0[0] = v0[0] * c[0] - v0[1] * sn[0]; r0[1] = v0[1] * c[0] + v0[0] * sn[0];
                        r0[2] = v0[2] * c[1] - v0[3] * sn[1]; r0[3] = v0[3] * c[1] + v0[2] * sn[1];
                        r1[0] = v1[0] * c[2] - v1[1] * sn[2]; r1[1] = v1[1] * c[2] + v1[0] * sn[2];
                        r1[2] = v1[2] * c[3] - v1[3] * sn[3]; r1[3] = v1[3] * c[3] + v1[2] * sn[3];
                        v0 = r0; v1 = r1; }
                    u32x4 w; w.x = pk2(v0[0], v0[1]); w.y = pk2(v0[2], v0[3]); w.z = pk2(v1[0], v1[1]); w.w = pk2(v1[2], v1[3]);
                    *(u32x4*)(rowp + bj * HALF) = w; }
                asm volatile("" ::: "memory"); }
    }
};
struct EpiColScale {
    static constexpr bool PERM = true;
    bf16_t* O; int ldc; const float* cs;
    __device__ __forceinline__ void operator()(const f32x4 (&acc)[2][2][4][2], const Unit& u, int wr, int wc, int fr, int fq) const {
        const int row0 = u.pm * BM + wr * 64 + fr, col0 = u.pn * BM + wc * 32 + 8 * fq;
        f32x4 sv[2][2];
#pragma unroll
        for (int bj = 0; bj < 2; ++bj)
#pragma unroll
            for (int n = 0; n < 2; ++n) sv[bj][n] = *(const f32x4*)(cs + col0 + bj * HALF + 4 * n);
#pragma unroll
        for (int ai = 0; ai < 2; ++ai)
#pragma unroll
            for (int m = 0; m < 4; ++m) { bf16_t* rowp = O + (size_t)(row0 + ai * HALF + m * 16) * ldc + col0;
#pragma unroll
                for (int bj = 0; bj < 2; ++bj) { const f32x4 v0 = acc[ai][bj][m][0] * sv[bj][0], v1 = acc[ai][bj][m][1] * sv[bj][1];
                    u32x4 w; w.x = pk2(v0[0], v0[1]); w.y = pk2(v0[2], v0[3]); w.z = pk2(v1[0], v1[1]); w.w = pk2(v1[2], v1[3]);
                    *(u32x4*)(rowp + bj * HALF) = w; }
                asm volatile("" ::: "memory"); }
    }
};
struct EpiRes {
    static constexpr bool PERM = false;
    float* C; const float* res;
    __device__ __forceinline__ void operator()(const f32x4 (&acc)[2][2][4][2], const Unit& u, int wr, int wc, int fr, int fq) const {
        const int row0 = u.pm * BM + wr * 64 + fr, col0 = u.pn * BM + wc * 32 + 4 * fq;
#pragma unroll
        for (int ai = 0; ai < 2; ++ai)
#pragma unroll
            for (int m = 0; m < 4; ++m) { const size_t ro = (size_t)(row0 + ai * HALF + m * 16) * DM + col0;
#pragma unroll
                for (int bj = 0; bj < 2; ++bj)
#pragma unroll
                    for (int n = 0; n < 2; ++n) { const f32x4 r = *(const f32x4*)(res + ro + bj * HALF + n * 16);
                        *(f32x4*)(C + ro + bj * HALF + n * 16) = r * ALPHA + acc[ai][bj][m][n]; } }
    }
};
}

__device__ __forceinline__ int wmap_col(int kind, int n) {
    if (kind == 0) return n < NIN ? n : -1;
    if (kind == 1) return n;
    if (kind == 2) { const int h = n / 192, c = n % 192; if (c < 128) return n; const int j = (c - 128) >> 1, e = (c - 128) & 1; return h * 192 + 128 + j + 32 * e; }
    if (kind == 3) { const int h = n >> 7, c = n & 127; return h * 256 + c; }
    { const int h = n >> 7, c = n & 127; return h * 256 + 128 + c; }
}
__device__ __forceinline__ void convert_weights(KP p, int l, LAS unsigned char* lds) {
    KP_FENCE(p);
    int tid = threadIdx.x; asm volatile("" : "+v"(tid));
    const int tx = tid & 63, ty = tid >> 6;
    LAS float* tile = (LAS float*)lds;
    const int nK[5] = {32, 32, 8, 4, 4}, nN[5] = {96, 32, 24, 16, 16};
    const int start1 = nK[0] * nN[0], start2 = start1 + nK[1] * nN[1], start3 = start2 + nK[2] * nN[2], start4 = start3 + nK[3] * nN[3], total = start4 + nK[4] * nN[4];
    for (int it = blockIdx.x; it < total; it += gridDim.x) {
        int kind, loc;
        if (it < start1) { kind = 0; loc = it; } else if (it < start2) { kind = 1; loc = it - start1; } else if (it < start3) { kind = 2; loc = it - start2; }
        else if (it < start4) { kind = 3; loc = it - start3; } else { kind = 4; loc = it - start4; }
        const float* src; bf16_t* dst; const float* g = nullptr; int K, Nsrc, nnt;
        if (kind == 0) { src = p->w_in + (size_t)l * DM * NIN; dst = (bf16_t*)(p->ws + WS_WIN); K = 2048; Nsrc = NIN; nnt = 96; }
        else if (kind == 1) { src = p->w_out + (size_t)l * DM * DM; dst = (bf16_t*)(p->ws + WS_WOUT); K = 2048; Nsrc = DM; nnt = 32; }
        else if (kind == 2) { src = p->w_uq + (size_t)l * 512 * 1536; dst = (bf16_t*)(p->ws + WS_WUQ); K = 512; Nsrc = 1536; nnt = 24; g = p->q_norm_g + l * 512; }
        else if (kind == 3) { src = p->w_ukv + (size_t)l * 256 * 2048; dst = (bf16_t*)(p->ws + WS_WUK); K = 256; Nsrc = 2048; nnt = 16; g = p->kv_norm_g + l * 256; }
        else { src = p->w_ukv + (size_t)l * 256 * 2048; dst = (bf16_t*)(p->ws + WS_WUV); K = 256; Nsrc = 2048; nnt = 16; g = p->kv_norm_g + l * 256; }
        const int n0 = (loc % nnt) * 64, k0 = (loc / nnt) * 64;
        const int sc = wmap_col(kind, n0 + tx);
#pragma unroll
        for (int i = 0; i < 8; ++i) { const int k = k0 + ty * 8 + i; float v = 0.f; if (sc >= 0) v = src[(size_t)k * Nsrc + sc]; if (g) v *= g[k]; tile[(ty * 8 + i) * 65 + tx] = v; }
        __syncthreads();
#pragma unroll
        for (int i = 0; i < 8; ++i) { const int n = n0 + ty * 8 + i; dst[(size_t)n * K + k0 + tx] = (bf16_t)f2bf(tile[tx * 65 + ty * 8 + i]); }
        __syncthreads();
    }
}

__device__ __forceinline__ void phase_p0(KP p, LAS unsigned char* lds) {
    KP_FENCE(p);
    const int tid = threadIdx.x;
    if (blockIdx.x == 0 && tid < 64) ((unsigned*)(p->ws + WS_CTL))[tid] = 0u;
    convert_weights(p, 0, lds);
    bf16_t* xb = (bf16_t*)(p->ws + WS_XB);
    const size_t n4 = (size_t)T * DM / 4;
    const size_t xstr = (size_t)gridDim.x * 512;
    for (size_t i0 = (size_t)blockIdx.x * 512 + tid; i0 < n4; i0 += xstr * 8) {
        f32x4 v[8];
#pragma unroll
        for (int k = 0; k < 8; ++k) v[k] = *(const f32x4*)(p->x + (i0 + k * xstr) * 4);
#pragma unroll
        for (int k = 0; k < 8; ++k) { u32x2 w; w.x = pk2(v[k][0], v[k][1]); w.y = pk2(v[k][2], v[k][3]); *(u32x2*)(xb + (i0 + k * xstr) * 4) = w; } }
    float* cosT = (float*)(p->ws + WS_COS); float* sinT = (float*)(p->ws + WS_SIN);
    for (int i = blockIdx.x * 512 + tid; i < T * 32; i += gridDim.x * 512) {
        const int t = i >> 5, j = i & 31;
        const float ang = (float)p->pos[t] * p->inv_freq[j];
        double rev = (double)ang * 0.15915494309189535; rev -= rint(rev);
        cosT[i] = __builtin_amdgcn_cosf((float)rev); sinT[i] = __builtin_amdgcn_sinf((float)rev);
    }
}

__device__ __forceinline__ void phase_prep(KP p, int l, LAS unsigned char* lds) {
    KP_FENCE(p);
    int tid = threadIdx.x; asm volatile("" : "+v"(tid));
    const int lane = tid & 63, wave = tid >> 6, c = tid;
    const bf16_t* U = (const bf16_t*)(p->ws + WS_U);
    bf16_t* MIX = (bf16_t*)(p->ws + WS_MIX); bf16_t* KPEB = (bf16_t*)(p->ws + WS_KPE); bf16_t* SCAN = (bf16_t*)(p->ws + WS_SCAN);
    float* SC2 = (float*)(p->ws + WS_SC2); float* RSQ = (float*)(p->ws + WS_RS); float* RSKV = RSQ + T;
    const float* cosT = (const float*)(p->ws + WS_COS); const float* sinT = (const float*)(p->ws + WS_SIN);
    LAS float* sth = (LAS float*)lds;
    LAS float* spart = (LAS float*)(lds + 8192);
    float w2r[64], a2r[64];
#pragma unroll
    for (int j = 0; j < 64; ++j) { w2r[j] = p->w2[(size_t)l * 64 * 512 + j * 512 + c]; a2r[j] = p->a2[(size_t)l * 64 * 512 + j * 512 + c]; }
    const float* mu = p->mu + l * 1664;
    const float mu_r = mu[c], mu_k = mu[576 + c], mu_v = mu[1088 + c];
    const float w0c = p->w0[l * 512 + c], a0c = p->a0[l * 512 + c], kkc = p->k_k[l * 512 + c], kac = p->k_a[l * 512 + c], rkc = p->r_k[l * 512 + c];
    const float cw0 = p->conv_w[(l * 3 + 0) * 512 + c], cw1 = p->conv_w[(l * 3 + 1) * 512 + c], cw2 = p->conv_w[(l * 3 + 2) * 512 + c];
    for (int tile = blockIdx.x; tile < T / 128; tile += gridDim.x) {
        const int t0 = tile * 128; const bool first = (t0 % SEQ) == 0;
        float pr = 0.f, pk = 0.f, pv = 0.f, pu1 = 0.f, pu2 = 0.f;
        if (!first) { const bf16_t* up = U + (size_t)(t0 - 1) * LDU; pr = bf2f(up[C_RC + c]); pk = bf2f(up[C_RC + 576 + c]); pv = bf2f(up[C_RC + 1088 + c]);
            pu1 = bf2f(up[C_CC + c]) * bf2f(up[C_CH + c]); const bf16_t* up2 = up - LDU; pu2 = bf2f(up2[C_CC + c]) * bf2f(up2[C_CH + c]); }
        const int s_tok0 = tid >> 7, s_jj = tid & 127, s_cr = (s_jj < 64) ? (512 + s_jj) : (1600 + s_jj - 64); const float s_mu = mu[s_cr];
        unsigned short sc_[2], sp_[2];
#define PREP_STAGE_LOAD(tb_) do { _Pragma("unroll") for (int i = 0; i < 2; ++i) { const int t = (tb_) + s_tok0 + 4 * i; \
            sc_[i] = U[(size_t)t * LDU + C_RC + s_cr]; sp_[i] = (t % SEQ) == 0 ? (unsigned short)0 : U[(size_t)(t - 1) * LDU + C_RC + s_cr]; } } while (0)
#define PREP_STAGE_STORE(buf_) do { _Pragma("unroll") for (int i = 0; i < 2; ++i) { const float cur = bf2f(sc_[i]), prev = bf2f(sp_[i]); float xv = cur + (prev - cur) * s_mu; \
            if (s_jj < 64) { const float e = __expf(2.f * xv); xv = 1.f - 2.f / (e + 1.f); } sth[(buf_) * 1024 + (s_tok0 + 4 * i) * 128 + s_jj] = xv; } } while (0)
        PREP_STAGE_LOAD(t0); PREP_STAGE_STORE(0);
        __syncthreads();
        for (int sb = 0; sb < 16; ++sb) {
            const int tb = t0 + sb * 8; const LAS float* sthb = sth + (sb & 1) * 1024;
            if (sb + 1 < 16) PREP_STAGE_LOAD(tb + 8);
            unsigned short kx1 = 0, kx2 = 0; float kcs = 0.f, ksn = 0.f;
            if (tid < 256) { const int tok = tid >> 5, j = tid & 31, t = tb + tok; const bf16_t* ur = U + (size_t)t * LDU + C_KPE; kx1 = ur[j]; kx2 = ur[32 + j]; kcs = cosT[t * 32 + j]; ksn = sinT[t * 32 + j]; }
            for (int g4 = 0; g4 < 2; ++g4) {
                unsigned short raw[4][9];
#pragma unroll
                for (int i = 0; i < 4; ++i) { const bf16_t* ur = U + (size_t)(tb + g4 * 4 + i) * LDU;
                    raw[i][0] = ur[C_RC + c]; raw[i][1] = ur[C_RC + 576 + c]; raw[i][2] = ur[C_RC + 1088 + c]; raw[i][3] = ur[C_CB + c]; raw[i][4] = ur[C_CC + c]; raw[i][5] = ur[C_CH + c];
                    raw[i][6] = ur[C_CG + c]; raw[i][7] = ur[C_CQ + c]; raw[i][8] = (c < 256) ? ur[C_CKV + c] : (unsigned short)0; }
#pragma unroll
                for (int i = 0; i < 4; ++i) {
                    const int tok = g4 * 4 + i, t = tb + tok;
                    const float ur_ = bf2f(raw[i][0]), uk_ = bf2f(raw[i][1]), uv_ = bf2f(raw[i][2]);
                    const float cb = bf2f(raw[i][3]), cc = bf2f(raw[i][4]), ch = bf2f(raw[i][5]), cgt = bf2f(raw[i][6]);
                    const float cq = bf2f(raw[i][7]); const float ckv = bf2f(raw[i][8]);
                    const float uc = cc * ch; const float yc = cw0 * pu2 + cw1 * pu1 + cw2 * uc; pu2 = pu1; pu1 = uc;
                    MIX[(size_t)t * DM + c] = (bf16_t)f2bf(cb * yc * silu_f(cgt));
                    const float sq = wave_sum(cq * cq), skv = wave_sum(ckv * ckv);
                    if (lane == 0) { spart[(sb * 8 + tok) * 12 + wave] = sq; if (wave < 4) spart[(sb * 8 + tok) * 12 + 8 + wave] = skv; }
                    const float r = ur_ + (pr - ur_) * mu_r, k = uk_ + (pk - uk_) * mu_k, v = uv_ + (pv - uv_) * mu_v; pr = ur_; pk = uk_; pv = uv_;
                    float zw = w0c, za = a0c;
#pragma unroll
                    for (int j4 = 0; j4 < 16; ++j4) { const f32x4 th = *(const LAS f32x4*)(sthb + tok * 128 + j4 * 4), ad = *(const LAS f32x4*)(sthb + tok * 128 + 64 + j4 * 4);
                        zw += th[0] * w2r[j4 * 4] + th[1] * w2r[j4 * 4 + 1] + th[2] * w2r[j4 * 4 + 2] + th[3] * w2r[j4 * 4 + 3];
                        za += ad[0] * a2r[j4 * 4] + ad[1] * a2r[j4 * 4 + 1] + ad[2] * a2r[j4 * 4 + 2] + ad[3] * a2r[j4 * 4 + 3]; }
                    const float sp = fmaxf(-zw, 0.f) + __logf(1.f + __expf(-fabsf(zw)));
                    const float wlog = -sp - 0.5f; const float dec = __expf(-__expf(wlog));
                    const float asig = 1.f / (1.f + __expf(-za));
                    const float kkr = k * kkc; const float nrm = sqrtf(wave_sum(kkr * kkr)); const float kk = kkr / fmaxf(nrm, 1e-12f);
                    const float k2 = k * (1.f + (asig - 1.f) * kac);
                    const float av = -kk, bv = kk * asig;
                    const float br = wave_sum(bv * r), kr = wave_sum(k2 * r), rkb = wave_sum(r * k2 * rkc);
                    bf16_t* so = SCAN + ((size_t)t * 8 + wave) * 384 + lane;
                    *(unsigned*)(so + lane) = pk2(av, dec * r);
                    so[128] = (bf16_t)f2bf(dec); so[192] = (bf16_t)f2bf(bv); so[256] = (bf16_t)f2bf(k2); so[320] = (bf16_t)f2bf(v);
                    if (lane == 0) { f32x4 o4 = {br, kr, rkb, 0.f}; *(f32x4*)(SC2 + ((size_t)t * 8 + wave) * 4) = o4; }
                }
            }
            if (tid < 256) { const int tok = tid >> 5, j = tid & 31, t = tb + tok; const float x1 = bf2f(kx1), x2 = bf2f(kx2);
                *(unsigned*)(KPEB + (size_t)t * 64 + 2 * j) = pk2(x1 * kcs - x2 * ksn, x2 * kcs + x1 * ksn); }
            if (sb + 1 < 16) PREP_STAGE_STORE((sb + 1) & 1);
            __syncthreads();
        }
#undef PREP_STAGE_LOAD
#undef PREP_STAGE_STORE
        if (tid < 128) { float sq = 0.f, skv = 0.f;
#pragma unroll
            for (int w = 0; w < 8; ++w) sq += spart[tid * 12 + w];
#pragma unroll
            for (int w = 0; w < 4; ++w) skv += spart[tid * 12 + 8 + w];
            RSQ[t0 + tid] = rsqrtf(sq * (1.f / 512.f) + RMS_EPS); RSKV[t0 + tid] = rsqrtf(skv * (1.f / 256.f) + RMS_EPS); }
        __syncthreads();
    }
}

namespace att {
constexpr int KROW = 400, VROW = 136, KT_BYTES = 64 * KROW, VT_BYTES = 128 * VROW, BUF_BYTES = KT_BYTES + VT_BYTES;
__device__ __forceinline__ void unit(KP p, int bh, int qb, LAS unsigned char* lds) {
    KP_FENCE(p);
    int tid = threadIdx.x; asm volatile("" : "+v"(tid));
    const int lane = tid & 63, w = __builtin_amdgcn_readfirstlane(tid >> 6), ql = lane & 31, hi = lane >> 5;
    const int b = bh >> 3, h = bh & 7, q0 = qb * 256;
    const bf16_t* Q = (const bf16_t*)(p->ws + WS_Q); const bf16_t* KN = (const bf16_t*)(p->ws + WS_KN); const bf16_t* KPEB = (const bf16_t*)(p->ws + WS_KPE);
    const bf16_t* VT = (const bf16_t*)(p->ws + WS_VT); const bf16_t* U = (const bf16_t*)(p->ws + WS_U); bf16_t* MIX = (bf16_t*)(p->ws + WS_MIX);
    const int qpos = q0 + 32 * w + ql; const size_t tq = (size_t)b * SEQ + qpos;
    bf16x8 qf[12];
    { const bf16_t* qp = Q + tq * 1536 + h * 192 + 8 * hi;
#pragma unroll
      for (int ks = 0; ks < 12; ++ks) qf[ks] = *(const bf16x8*)(qp + 16 * ks); }
    f32x16 o[4];
#pragma unroll
    for (int d = 0; d < 4; ++d)
#pragma unroll
        for (int i = 0; i < 16; ++i) o[d][i] = 0.f;
    float mrow = -1e30f, lsum = 0.f;
    const int nj = 4 * (qb + 1);
    const bf16_t* ksrc[3]; int kdst[3];
#pragma unroll
    for (int i = 0; i < 3; ++i) { const int idx = tid + 512 * i, key = idx / 24, cc = idx % 24; const size_t tk = (size_t)b * SEQ + key;
        ksrc[i] = (cc < 16) ? (KN + tk * 1024 + h * 128 + 8 * cc) : (KPEB + tk * 64 + 8 * (cc - 16)); kdst[i] = key * KROW + 16 * cc; }
    const int kstride[3] = {(tid % 24 < 16) ? 1024 : 64, ((tid + 512) % 24 < 16) ? 1024 : 64, ((tid + 1024) % 24 < 16) ? 1024 : 64};
    const bf16_t* vsrc[2]; int vdst[2];
#pragma unroll
    for (int i = 0; i < 2; ++i) { const int idx = tid + 512 * i, dv = idx >> 3, chn = idx & 7; vsrc[i] = VT + (size_t)(h * 128 + dv) * T + (size_t)b * SEQ + 8 * chn; vdst[i] = KT_BYTES + dv * VROW + 16 * chn; }
    u32x4 kreg[3], vreg[2];
#define ATT_GLOAD(j) do { _Pragma("unroll") for (int i = 0; i < 3; ++i) kreg[i] = *(const u32x4*)(ksrc[i] + (size_t)(j) * 64 * kstride[i]); \
                          _Pragma("unroll") for (int i = 0; i < 2; ++i) vreg[i] = *(const u32x4*)(vsrc[i] + (size_t)(j) * 64); } while (0)
#define ATT_LSTORE(bufo) do { _Pragma("unroll") for (int i = 0; i < 3; ++i) *(LAS u32x4*)(lds + (bufo) + kdst[i]) = kreg[i]; \
                              _Pragma("unroll") for (int i = 0; i < 2; ++i) { u32x2 lo = {vreg[i].x, vreg[i].y}, hi2 = {vreg[i].z, vreg[i].w}; \
                                  *(LAS u32x2*)(lds + (bufo) + vdst[i]) = lo; *(LAS u32x2*)(lds + (bufo) + vdst[i] + 8) = hi2; } } while (0)
    ATT_GLOAD(0); ATT_LSTORE(0);
    __syncthreads();
    for (int j = 0; j < nj; ++j) {
        const int cur = (j & 1) * BUF_BYTES, nxt = BUF_BYTES - cur;
        if (j + 1 < nj) ATT_GLOAD(j + 1);
        const int kt0 = 64 * j;
        if (kt0 <= q0 + 32 * w + 31) {
            f32x16 st0, st1;
#pragma unroll
            for (int i = 0; i < 16; ++i) { st0[i] = 0.f; st1[i] = 0.f; }
            const LAS unsigned char* kb = lds + cur + ql * KROW + 16 * hi;
#pragma unroll
            for (int ks = 0; ks < 12; ++ks) {
                const bf16x8 k0 = *(const LAS bf16x8*)(kb + 32 * ks), k1 = *(const LAS bf16x8*)(kb + 32 * KROW + 32 * ks);
                st0 = __builtin_amdgcn_mfma_f32_32x32x16_bf16(k0, qf[ks], st0, 0, 0, 0);
                st1 = __builtin_amdgcn_mfma_f32_32x32x16_bf16(k1, qf[ks], st1, 0, 0, 0);
            }
            if (kt0 + 63 > q0 + 32 * w) {
#pragma unroll
                for (int i = 0; i < 16; ++i) { const int key = kt0 + 8 * (i >> 2) + 4 * hi + (i & 3); if (key > qpos) st0[i] = -1e30f; if (key + 32 > qpos) st1[i] = -1e30f; }
            }
            float mx = fmaxf(st0[0], st1[0]);
#pragma unroll
            for (int i = 1; i < 16; ++i) mx = fmaxf(mx, fmaxf(st0[i], st1[i]));
            mx = fmaxf(mx, __shfl_xor(mx, 32));
            const float mnew = fmaxf(mrow, mx); const float alpha = __builtin_amdgcn_exp2f(mrow - mnew); mrow = mnew;
            float ps = 0.f;
#pragma unroll
            for (int i = 0; i < 16; ++i) { st0[i] = __builtin_amdgcn_exp2f(st0[i] - mnew); st1[i] = __builtin_amdgcn_exp2f(st1[i] - mnew); ps += st0[i] + st1[i]; }
            lsum = lsum * alpha + ps;
#pragma unroll
            for (int d = 0; d < 4; ++d)
#pragma unroll
                for (int i = 0; i < 16; ++i) o[d][i] *= alpha;
            bf16x8 pf[4];
#pragma unroll
            for (int s2 = 0; s2 < 4; ++s2) { u32x4 pw;
                if (s2 < 2) { pw.x = pk2(st0[8 * s2 + 0], st0[8 * s2 + 1]); pw.y = pk2(st0[8 * s2 + 2], st0[8 * s2 + 3]); pw.z = pk2(st0[8 * s2 + 4], st0[8 * s2 + 5]); pw.w = pk2(st0[8 * s2 + 6], st0[8 * s2 + 7]); }
                else { const int s3 = s2 - 2; pw.x = pk2(st1[8 * s3 + 0], st1[8 * s3 + 1]); pw.y = pk2(st1[8 * s3 + 2], st1[8 * s3 + 3]); pw.z = pk2(st1[8 * s3 + 4], st1[8 * s3 + 5]); pw.w = pk2(st1[8 * s3 + 6], st1[8 * s3 + 7]); }
                pf[s2] = __builtin_bit_cast(bf16x8, pw); }
            const LAS unsigned char* vb = lds + cur + KT_BYTES + ql * VROW + 8 * hi;
#pragma unroll
            for (int d = 0; d < 4; ++d)
#pragma unroll
                for (int s2 = 0; s2 < 4; ++s2) {
                    const u32x2 lo = *(const LAS u32x2*)(vb + d * 32 * VROW + 32 * s2), hi2 = *(const LAS u32x2*)(vb + d * 32 * VROW + 32 * s2 + 16);
                    u32x4 vw = {lo.x, lo.y, hi2.x, hi2.y};
                    o[d] = __builtin_amdgcn_mfma_f32_32x32x16_bf16(__builtin_bit_cast(bf16x8, vw), pf[s2], o[d], 0, 0, 0);
                }
        }
        if (j + 1 < nj) ATT_LSTORE(nxt);
        __syncthreads();
    }
#undef ATT_GLOAD
#undef ATT_LSTORE
    const float ltot = lsum + __shfl_xor(lsum, 32); const float inv = 1.f / ltot;
    const bf16_t* gp = U + tq * LDU + C_MG + h * 128; bf16_t* op = MIX + tq * DM + 512 + h * 128;
#pragma unroll
    for (int d = 0; d < 4; ++d)
#pragma unroll
        for (int g4 = 0; g4 < 4; ++g4) { const int dv0 = 32 * d + 8 * g4 + 4 * hi;
            const u32x2 gw = *(const u32x2*)(gp + dv0);
            const float g0 = __uint_as_float(gw.x << 16), g1 = __uint_as_float(gw.x & 0xffff0000u), g2 = __uint_as_float(gw.y << 16), g3 = __uint_as_float(gw.y & 0xffff0000u);
            u32x2 ow; ow.x = pk2(o[d][4 * g4 + 0] * inv * silu_f(g0), o[d][4 * g4 + 1] * inv * silu_f(g1)); ow.y = pk2(o[d][4 * g4 + 2] * inv * silu_f(g2), o[d][4 * g4 + 3] * inv * silu_f(g3));
            *(u32x2*)(op + dv0) = ow; }
}
}

namespace scan {
constexpr int CT = 32;
constexpr int IN_BYTES = CT * 6 * 64 * 4;
constexpr int OFF_IN = 0, OFF_SC2 = 2 * IN_BYTES, OFF_Y = OFF_SC2 + 2 * CT * 8, Y_BYTES = CT * 32 * 4;
__device__ __forceinline__ void run(KP p, int wg, LAS unsigned char* lds) {
    KP_FENCE(p);
    int tid = threadIdx.x; asm volatile("" : "+v"(tid));
    const int lane = tid & 63, w = __builtin_amdgcn_readfirstlane(tid >> 6);
    const int bh = wg >> 1, half = wg & 1, b = bh >> 3, h = bh & 7;
    const bf16_t* SCAN = (const bf16_t*)(p->ws + WS_SCAN); const float* SC2 = (const float*)(p->ws + WS_SC2); bf16_t* MIX = (bf16_t*)(p->ws + WS_MIX);
    const int nch = SEQ / CT;
    const bool stager = (w >= 4); const int stid = tid - 256;
    const int rg = lane >> 4, kq = lane & 15; const int rl0 = 8 * (w & 3) + 2 * rg;
    f32x4 s0 = {0.f, 0.f, 0.f, 0.f}, s1 = {0.f, 0.f, 0.f, 0.f};
    u32x4 ld[6]; f32x2 ld2 = {0.f, 0.f};
#define SC_GLOAD(c) do { const size_t tb = (size_t)b * SEQ + (size_t)(c) * CT; \
        _Pragma("unroll") for (int i = 0; i < 6; ++i) { const int idx = stid + 256 * i, tok = idx / 48, part = idx % 48; ld[i] = *(const u32x4*)(SCAN + ((tb + tok) * 8 + h) * 384 + 8 * part); } \
        if (stid < CT) ld2 = *(const f32x2*)(SC2 + ((tb + stid) * 8 + h) * 4); } while (0)
#define SC_LSTORE(c) do { const int bo = OFF_IN + ((c) & 1) * IN_BYTES; \
        _Pragma("unroll") for (int i = 0; i < 6; ++i) { const int idx = stid + 256 * i, tok = idx / 48, part = idx % 48; \
            f32x4 lo = {__uint_as_float(ld[i].x << 16), __uint_as_float(ld[i].x & 0xffff0000u), __uint_as_float(ld[i].y << 16), __uint_as_float(ld[i].y & 0xffff0000u)}; \
            f32x4 hi4 = {__uint_as_float(ld[i].z << 16), __uint_as_float(ld[i].z & 0xffff0000u), __uint_as_float(ld[i].w << 16), __uint_as_float(ld[i].w & 0xffff0000u)}; \
            *(LAS f32x4*)(lds + bo + (tok * 384 + part * 8) * 4) = lo; *(LAS f32x4*)(lds + bo + (tok * 384 + part * 8 + 4) * 4) = hi4; } \
        if (stid < CT) *(LAS f32x2*)(lds + OFF_SC2 + ((c) & 1) * CT * 8 + stid * 8) = ld2; } while (0)
#define SC_YOUT(c) do { const size_t tb = (size_t)b * SEQ + (size_t)(c) * CT; const int tok = stid >> 3, r4 = (stid & 7) * 4; \
        const f32x4 y4 = *(const LAS f32x4*)(lds + OFF_Y + ((c) & 1) * Y_BYTES + (tok * 32 + r4) * 4); \
        u32x2 ow; ow.x = pk2(y4[0], y4[1]); ow.y = pk2(y4[2], y4[3]); *(u32x2*)(MIX + (tb + tok) * DM + 1536 + h * 64 + 32 * half + r4) = ow; } while (0)
    if (stager) { SC_GLOAD(0); SC_LSTORE(0); }
    __syncthreads();
    for (int c = 0; c < nch; ++c) {
        if (stager) {
            if (c + 1 < nch) SC_GLOAD(c + 1);
            if (c >= 1) SC_YOUT(c - 1);
            if (c + 1 < nch) SC_LSTORE(c + 1);
        } else {
            const LAS unsigned char* ib = lds + OFF_IN + (c & 1) * IN_BYTES;
            const LAS unsigned char* pa = ib + kq * 32;
            const LAS unsigned char* pw = ib + 512 + kq * 16;
            const LAS unsigned char* pv = ib + (320 + 32 * half + rl0) * 4;
            const LAS unsigned char* sb = lds + OFF_SC2 + (c & 1) * CT * 8;
            LAS unsigned char* yb = lds + OFF_Y + (c & 1) * Y_BYTES + rl0 * 4;
            f32x4 aw01 = *(const LAS f32x4*)(pa), aw23 = *(const LAS f32x4*)(pa + 16), w4 = *(const LAS f32x4*)(pw), b4 = *(const LAS f32x4*)(pw + 256), k4 = *(const LAS f32x4*)(pw + 512);
            f32x2 v2 = *(const LAS f32x2*)(pv), bk = *(const LAS f32x2*)(sb);
            for (int blk = 0; blk < CT / 16; ++blk) {
                float yk0 = 0.f, yk1 = 0.f;
#pragma unroll
                for (int j = 0; j < 16; ++j) {
                    const int tok = blk * 16 + j, tn = (tok + 1 < CT) ? tok + 1 : tok;
                    const f32x4 naw01 = *(const LAS f32x4*)(pa + tn * 1536), naw23 = *(const LAS f32x4*)(pa + tn * 1536 + 16), nw4 = *(const LAS f32x4*)(pw + tn * 1536),
                                nb4 = *(const LAS f32x4*)(pw + tn * 1536 + 256), nk4 = *(const LAS f32x4*)(pw + tn * 1536 + 512);
                    const f32x2 nv2 = *(const LAS f32x2*)(pv + tn * 1536), nbk = *(const LAS f32x2*)(sb + tn * 8);
                    const f32x2 a0 = {aw01[0], aw01[1]}, a1 = {aw01[2], aw01[3]}, a2 = {aw23[0], aw23[1]}, a3 = {aw23[2], aw23[3]};
                    f32x2 pq0 = a0 * s0[0] + a1 * s0[1] + a2 * s0[2] + a3 * s0[3];
                    f32x2 pq1 = a0 * s1[0] + a1 * s1[1] + a2 * s1[2] + a3 * s1[3];
                    const f32x4 e0 = s0 * w4 + k4 * v2[0], e1 = s1 * w4 + k4 * v2[1];
                    float p0 = pq0[0], q0 = pq0[1], p1 = pq1[0], q1 = pq1[1];
                    asm volatile("s_nop 1\n\t"
                        "v_add_f32_dpp %0, %0, %0 quad_perm:[1,0,3,2] row_mask:0xf bank_mask:0xf\n\t"
                        "v_add_f32_dpp %1, %1, %1 quad_perm:[1,0,3,2] row_mask:0xf bank_mask:0xf\n\t"
                        "v_add_f32_dpp %2, %2, %2 quad_perm:[1,0,3,2] row_mask:0xf bank_mask:0xf\n\t"
                        "v_add_f32_dpp %3, %3, %3 quad_perm:[1,0,3,2] row_mask:0xf bank_mask:0xf\n\t"
                        "v_add_f32_dpp %0, %0, %0 quad_perm:[2,3,0,1] row_mask:0xf bank_mask:0xf\n\t"
                        "v_add_f32_dpp %1, %1, %1 quad_perm:[2,3,0,1] row_mask:0xf bank_mask:0xf\n\t"
                        "v_add_f32_dpp %2, %2, %2 quad_perm:[2,3,0,1] row_mask:0xf bank_mask:0xf\n\t"
                        "v_add_f32_dpp %3, %3, %3 quad_perm:[2,3,0,1] row_mask:0xf bank_mask:0xf\n\t"
                        "v_add_f32_dpp %0, %0, %0 row_half_mirror row_mask:0xf bank_mask:0xf\n\t"
                        "v_add_f32_dpp %1, %1, %1 row_half_mirror row_mask:0xf bank_mask:0xf\n\t"
                        "v_add_f32_dpp %2, %2, %2 row_half_mirror row_mask:0xf bank_mask:0xf\n\t"
                        "v_add_f32_dpp %3, %3, %3 row_half_mirror row_mask:0xf bank_mask:0xf\n\t"
                        "v_add_f32_dpp %0, %0, %0 row_mirror row_mask:0xf bank_mask:0xf\n\t"
                        "v_add_f32_dpp %1, %1, %1 row_mirror row_mask:0xf bank_mask:0xf\n\t"
                        "v_add_f32_dpp %2, %2, %2 row_mirror row_mask:0xf bank_mask:0xf\n\t"
                        "v_add_f32_dpp %3, %3, %3 row_mirror row_mask:0xf bank_mask:0xf\n\t"
                        "s_nop 1"
                        : "+v"(p0), "+v"(q0), "+v"(p1), "+v"(q1));
                    s0 = e0 + b4 * p0; s1 = e1 + b4 * p1;
                    const float y0 = q0 + p0 * bk[0] + v2[0] * bk[1], y1 = q1 + p1 * bk[0] + v2[1] * bk[1];
                    const bool mine = (kq == j);
                    yk0 = mine ? y0 : yk0; yk1 = mine ? y1 : yk1;
                    aw01 = naw01; aw23 = naw23; w4 = nw4; b4 = nb4; k4 = nk4; v2 = nv2; bk = nbk;
                }
                { f32x2 yy = {yk0, yk1}; *(LAS f32x2*)(yb + (blk * 16 + kq) * 128) = yy; }
            }
        }
        __syncthreads();
    }
    if (stager) SC_YOUT(nch - 1);
#undef SC_GLOAD
#undef SC_LSTORE
#undef SC_YOUT
    __syncthreads();
}
}

constexpr int N_SCAN_WG = 32, N_ATT_UNITS = 1024;
__device__ __forceinline__ void phase_mix(KP p, int l, LAS unsigned char* lds) {
    KP_FENCE(p);
    if ((PH & 256) && (int)blockIdx.x < N_SCAN_WG) { scan::run(p, blockIdx.x, lds); if (DUP & 8) scan::run(p, blockIdx.x, lds); }
    LAS int* qword = (LAS int*)(lds + LDS_MISC);
    for (int rep = 0; rep < ((DUP & 16) ? 2 : 1); ++rep) {
    unsigned* ctr = (unsigned*)(p->ws + WS_CTL) + l + 2 * rep;
    for (;;) {
        if (threadIdx.x == 0) *qword = (int)atomicAdd(ctr, 1u);
        __syncthreads();
        const int n = *qword;
        __syncthreads();
        if (n >= N_ATT_UNITS) break;
        if (PH & 512) att::unit(p, n & 15, 63 - (n >> 4), lds);
    }
    }
}

__device__ __forceinline__ void phase_gn(KP p, int l) {
    KP_FENCE(p);
    int tid = threadIdx.x; asm volatile("" : "+v"(tid));
    const int lane = tid & 63, wave = tid >> 6, c = tid;
    bf16_t* MIX = (bf16_t*)(p->ws + WS_MIX); const bf16_t* U = (const bf16_t*)(p->ws + WS_U); const bf16_t* SCAN = (const bf16_t*)(p->ws + WS_SCAN); const float* SC2 = (const float*)(p->ws + WS_SC2);
    const float g = p->gn_g[l * 512 + c], bta = p->gn_b[l * 512 + c];
    for (int t0 = blockIdx.x * 8; t0 < T; t0 += gridDim.x * 8) {
        unsigned short yr[8], vr[8], gr[8]; float rk[8];
#pragma unroll
        for (int i = 0; i < 8; ++i) { const size_t t = t0 + i; yr[i] = MIX[t * DM + 1536 + c]; vr[i] = SCAN[(t * 8 + wave) * 384 + 320 + lane]; rk[i] = SC2[(t * 8 + wave) * 4 + 2]; gr[i] = U[t * LDU + C_RG + c]; }
#pragma unroll
        for (int i = 0; i < 8; ++i) { const size_t t = t0 + i; const float y = bf2f(yr[i]);
            const float mean = wave_sum(y) * (1.f / 64.f); const float d = y - mean; const float var = wave_sum(d * d) * (1.f / 64.f);
            const float yn = d * rsqrtf(var + GN_EPS) * g + bta + rk[i] * bf2f(vr[i]);
            MIX[t * DM + 1536 + c] = (bf16_t)f2bf(yn * silu_f(bf2f(gr[i]))); }
    }
}

__device__ __forceinline__ void phase_ln(KP p, int l, bool write_xb) {
    KP_FENCE(p);
    int tid = threadIdx.x; asm volatile("" : "+v"(tid));
    const int lane = tid & 63, wave = tid >> 6;
    bf16_t* xb = (bf16_t*)(p->ws + WS_XB);
    f32x4 g[8], bb[8];
#pragma unroll
    for (int i = 0; i < 8; ++i) { g[i] = *(const f32x4*)(p->ln_g + l * DM + (i * 64 + lane) * 4); bb[i] = *(const f32x4*)(p->ln_b + l * DM + (i * 64 + lane) * 4); }
    const int rstr = gridDim.x * 8;
    int row = blockIdx.x * 8 + wave;
    f32x4 vn[8];
#pragma unroll
    for (int i = 0; i < 8; ++i) vn[i] = *(const f32x4*)(p->out + (size_t)row * DM + (i * 64 + lane) * 4);
    for (; row < T; row += rstr) {
        float* rp = p->out + (size_t)row * DM;
        f32x4 v[8]; float s = 0.f;
#pragma unroll
        for (int i = 0; i < 8; ++i) { v[i] = vn[i]; s += v[i][0] + v[i][1] + v[i][2] + v[i][3]; }
        if (row + rstr < T) {
#pragma unroll
            for (int i = 0; i < 8; ++i) vn[i] = *(const f32x4*)(rp + (size_t)rstr * DM + (i * 64 + lane) * 4);
        }
        const float mean = wave_sum(s) * (1.f / DM);
        float q = 0.f;
#pragma unroll
        for (int i = 0; i < 8; ++i) { v[i] = v[i] - mean; q += v[i][0] * v[i][0] + v[i][1] * v[i][1] + v[i][2] * v[i][2] + v[i][3] * v[i][3]; }
        const float rstd = rsqrtf(wave_sum(q) * (1.f / DM) + LN_EPS);
#pragma unroll
        for (int i = 0; i < 8; ++i) { const f32x4 y = v[i] * rstd * g[i] + bb[i]; *(f32x4*)(rp + (i * 64 + lane) * 4) = y;
            if (write_xb) { u32x2 wv; wv.x = pk2(y[0], y[1]); wv.y = pk2(y[2], y[3]); *(u32x2*)(xb + (size_t)row * DM + (i * 64 + lane) * 4) = wv; } }
    }
}

#define PHASE_FENCE() do { __builtin_amdgcn_sched_barrier(0); asm volatile("" ::: "memory"); __syncthreads(); __builtin_amdgcn_sched_barrier(0); } while (0)
__global__ void __launch_bounds__(512, 2) fwd_megakernel(Params p_in) {
    KP p = (KP)__builtin_amdgcn_kernarg_segment_ptr();
    extern __shared__ __attribute__((aligned(16))) unsigned char smem[];
    LAS unsigned char* lds = (LAS unsigned char*)smem;
    cg::grid_group grid = cg::this_grid();
    const int G = gridDim.x;
    bf16_t* U = (bf16_t*)(p->ws + WS_U); bf16_t* XB = (bf16_t*)(p->ws + WS_XB); bf16_t* MIX = (bf16_t*)(p->ws + WS_MIX);
    float* RSQ = (float*)(p->ws + WS_RS); float* RSKV = RSQ + T;

    if (PH & 1) phase_p0(p, lds);
    grid.sync();
    for (int l = 0; l < DEPTH; ++l) {
        for (int rep = 0; rep < ((DUP & 1) ? 2 : 1); ++rep)
        if (PH & 2) { pg8::Gemm g{XB, (const bf16_t*)(p->ws + WS_WIN), T, LDU, DM, DM, DM}; pg8::StaticOrder S; S.init(T, LDU, G, (int)blockIdx.x);
          pg8::EpiU E{U, LDU}; pg8::gemm_phase(lds, g, S, E); }
        grid.sync();
        for (int rep = 0; rep < ((DUP & 2) ? 2 : 1); ++rep)
        if (PH & 4) phase_prep(p, l, lds);
        grid.sync();
        PHASE_FENCE();
        if (PH & 8) { pg8::Gemm g{U + C_CQ, (const bf16_t*)(p->ws + WS_WUQ), T, 1536, 512, LDU, 512}; pg8::StaticOrder S; S.init(T, 1536, G, (int)blockIdx.x);
          pg8::EpiQ E{(bf16_t*)(p->ws + WS_Q), RSQ, (const float*)(p->ws + WS_COS), (const float*)(p->ws + WS_SIN)}; pg8::gemm_phase(lds, g, S, E); }
        PHASE_FENCE();
        if (PH & 1024) { pg8::Gemm g{U + C_CKV, (const bf16_t*)(p->ws + WS_WUK), T, 1024, 256, LDU, 256}; pg8::StaticOrder S; S.init(T, 1024, G, (int)blockIdx.x);
          pg8::EpiRowScale E{(bf16_t*)(p->ws + WS_KN), 1024, RSKV, 1.f}; pg8::gemm_phase(lds, g, S, E); }
        PHASE_FENCE();
        if (PH & 2048) { pg8::Gemm g{(const bf16_t*)(p->ws + WS_WUV), U + C_CKV, 1024, T, 256, 256, LDU}; pg8::StaticOrder S; S.init(1024, T, G, (int)blockIdx.x);
          pg8::EpiColScale E{(bf16_t*)(p->ws + WS_VT), T, RSKV}; pg8::gemm_phase(lds, g, S, E); }
        grid.sync();
        if (PH & 16) phase_mix(p, l, lds);
        grid.sync();
        if (PH & 32) phase_gn(p, l);
        grid.sync();
        if (PH & 64) { pg8::Gemm g{MIX, (const bf16_t*)(p->ws + WS_WOUT), T, DM, DM, DM, DM}; pg8::StaticOrder S; S.init(T, DM, G, (int)blockIdx.x);
          pg8::EpiRes E{p->out, l == 0 ? p->x : p->out}; pg8::gemm_phase(lds, g, S, E); }
        grid.sync();
        if (PH & 128) phase_ln(p, l, l + 1 < DEPTH);
        if (l + 1 < DEPTH) { if (PH & 1) convert_weights(p, l + 1, lds); grid.sync(); }
    }
}

extern "C" void kernel_launch(void* const* d_in, const int* in_sizes, int n_in, void* d_out, int out_size, void* d_ws, size_t ws_size, hipStream_t stream) {
    static int grid = 0;
    if (grid == 0) {
        if (n_in != 21 || ws_size < WS_END) { fprintf(stderr, "kernel_launch: unexpected n_in %d or ws_size %zu (need %zu)\n", n_in, ws_size, (size_t)WS_END); grid = -1; return; }
        int dev = 0, cus = 0, per_cu = 0;
        hipGetDevice(&dev); hipDeviceGetAttribute(&cus, hipDeviceAttributeMultiprocessorCount, dev);
        if (hipFuncSetAttribute((const void*)fwd_megakernel, hipFuncAttributeMaxDynamicSharedMemorySize, LDS_BYTES) != hipSuccess) { fprintf(stderr, "kernel_launch: hipFuncSetAttribute failed\n"); grid = -1; return; }
        if (hipOccupancyMaxActiveBlocksPerMultiprocessor(&per_cu, (const void*)fwd_megakernel, 512, LDS_BYTES) != hipSuccess || per_cu < 1) { fprintf(stderr, "kernel_launch: occupancy query gave %d\n", per_cu); per_cu = 1; }
        (void)hipGetLastError();
        grid = cus * per_cu;
    }
    if (grid < 0) return;
    Params p{};
    p.x = (const float*)d_in[0]; p.pos = (const int*)d_in[1]; p.w_in = (const float*)d_in[2]; p.conv_w = (const float*)d_in[3]; p.q_norm_g = (const float*)d_in[4];
    p.w_uq = (const float*)d_in[5]; p.kv_norm_g = (const float*)d_in[6]; p.w_ukv = (const float*)d_in[7]; p.mu = (const float*)d_in[8]; p.w0 = (const float*)d_in[9];
    p.w2 = (const float*)d_in[10]; p.a0 = (const float*)d_in[11]; p.a2 = (const float*)d_in[12]; p.k_k = (const float*)d_in[13]; p.k_a = (const float*)d_in[14];
    p.r_k = (const float*)d_in[15]; p.gn_g = (const float*)d_in[16]; p.gn_b = (const float*)d_in[17]; p.w_out = (const float*)d_in[18]; p.ln_g = (const float*)d_in[19]; p.ln_b = (const float*)d_in[20];
    p.out = (float*)d_out; p.ws = (unsigned char*)d_ws;
    for (int j = 0; j < 32; ++j) p.inv_freq[j] = (float)pow(10000.0, -(double)(2 * j) / 64.0);
    void* args[] = {&p};
    hipError_t e = hipLaunchCooperativeKernel((const void*)fwd_megakernel, dim3(grid), dim3(512), args, LDS_BYTES, stream);
    if (e != hipSuccess) fprintf(stderr, "cooperative launch failed: %s (grid %d)\n", hipGetErrorString(e), grid);
}
```

```cpp
#include <hip/hip_runtime.h>
#include <hip/hip_cooperative_groups.h>
#include <cstdio>
#include <cstdint>
#include <cmath>
namespace cg = cooperative_groups;

#define LAS __attribute__((address_space(3)))
typedef unsigned short bf16_t;
typedef short bf16x8 __attribute__((ext_vector_type(8)));
typedef short s16x4 __attribute__((ext_vector_type(4)));
typedef float f32x4 __attribute__((ext_vector_type(4)));
typedef float f32x2 __attribute__((ext_vector_type(2)));
typedef float f32x16 __attribute__((ext_vector_type(16)));
typedef unsigned u32x4 __attribute__((ext_vector_type(4)));
typedef unsigned u32x2 __attribute__((ext_vector_type(2)));
typedef __bf16 bf16x2_t __attribute__((ext_vector_type(2)));

constexpr int T = 32768, SEQ = 16384, DM = 2048, NIN = 6080, LDU = 6144, DEPTH = 2;
constexpr int C_CB = 0, C_CC = 512, C_CH = 1024, C_CG = 1536, C_CQ = 2048, C_CKV = 2560, C_KPE = 2816, C_MG = 2880, C_RC = 3904, C_RG = 5568;
constexpr int NHEAD = 8;
constexpr float LN_EPS = 1e-5f, RMS_EPS = 1e-6f, GN_EPS = 64e-5f;
constexpr float ALPHA = 1.4142135623730951f;
constexpr float QSCALE = 0.07216878364870323f * 1.4426950408889634f;

constexpr size_t MiB = 1u << 20;
constexpr size_t WS_CTL = 0, WS_WIN = 1 * MiB, WS_WOUT = 25 * MiB, WS_WUQ = 33 * MiB, WS_WUK = 35 * MiB, WS_WUV = 36 * MiB, WS_RS = 37 * MiB,
                 WS_SC2 = 38 * MiB, WS_COS = 42 * MiB, WS_SIN = 46 * MiB, WS_U = 50 * MiB, WS_MIX = 434 * MiB, WS_XB = 562 * MiB, WS_Q = 562 * MiB,
                 WS_KPE = 658 * MiB, WS_KN = 690 * MiB, WS_VT = 754 * MiB, WS_SCAN = 818 * MiB, WS_END = 1010 * MiB;

constexpr int LDS_BYTES = 131072 + 256, LDS_MISC = 131072;

struct Params {
    const float* x; const int* pos; const float* w_in; const float* conv_w; const float* q_norm_g; const float* w_uq; const float* kv_norm_g; const float* w_ukv;
    const float* mu; const float* w0; const float* w2; const float* a0; const float* a2; const float* k_k; const float* k_a; const float* r_k; const float* gn_g; const float* gn_b;
    const float* w_out; const float* ln_g; const float* ln_b;
    float* out; unsigned char* ws;
    float inv_freq[32];
};

typedef const __attribute__((address_space(4))) Params* KP;
#define KP_FENCE(p) asm volatile("" : "+s"(p))
__device__ __forceinline__ float bf2f(unsigned short v) { return __uint_as_float(((unsigned)v) << 16); }
__device__ __forceinline__ unsigned f2bf(float f) { unsigned u = __float_as_uint(f); return (u + 0x7fffu + ((u >> 16) & 1u)) >> 16; }
__device__ __forceinline__ unsigned pk2(float lo, float hi) { f32x2 v = {lo, hi}; bf16x2_t b = __builtin_convertvector(v, bf16x2_t); return __builtin_bit_cast(unsigned, b); }
__device__ __forceinline__ float max3f(float a, float b, float c) { float r; asm("v_max3_f32 %0, %1, %2, %3" : "=v"(r) : "v"(a), "v"(b), "v"(c)); return r; }
__device__ __forceinline__ float silu_f(float x) { return x * __builtin_amdgcn_rcpf(1.f + __expf(-x)); }
__device__ __forceinline__ float dppf(float v, int ctrl) { return v; }
template <int CTRL> __device__ __forceinline__ float dpp_mov(float v) { return __int_as_float(__builtin_amdgcn_update_dpp(__float_as_int(v), __float_as_int(v), CTRL, 0xf, 0xf, false)); }
__device__ __forceinline__ float row16_sum(float v) {
    v += dpp_mov<0xB1>(v);
    v += dpp_mov<0x4E>(v);
    v += dpp_mov<0x141>(v);
    v += dpp_mov<0x140>(v);
    return v;
}
__device__ __forceinline__ float wave_sum(float v) { v = row16_sum(v); v += __shfl_xor(v, 16); v += __shfl_xor(v, 32); return v; }

#ifndef PH
#define PH 0xffff
#endif
#ifndef TPROBE
#define TPROBE -1
#endif
#ifndef DUP
#define DUP 0
#endif
namespace pg8 {
constexpr int BM = 256, BK = 64, HALF = 128, HTB = HALF * BK * 2, STAGE_BYTES = 8 * HTB, NXCD = 8, WGM = 8;
__host__ __device__ __forceinline__ int lds_byte(int r, int c) { const int st = (r >> 4) * 2 + (c >> 5), rr = r & 15, cc = c & 31, ob = rr * 64 + cc * 2; return st * 1024 + (ob ^ (((ob >> 9) & 1) << 5)); }
__host__ __device__ __forceinline__ void stage_rc(int b, int& R, int& C) { const int st = b / 1024, sb = b % 1024, swz = sb ^ (((sb >> 9) & 1) << 5); R = (st >> 1) * 16 + swz / 64; C = (st & 1) * 32 + (swz % 64) / 2; }
__host__ __device__ __forceinline__ int perm32(int rho) { const int n = rho >> 4, i = rho & 15; return 8 * (i >> 2) + 4 * n + (i & 3); }
struct Unit { int pm, pn; };
struct Gemm { const bf16_t* A; const bf16_t* Bt; int M, N, K, lda, ldb; };
struct StaticOrder {
    int nM, nN, nwg, G, c;
    __device__ void init(int M, int N, int G_, int c_) { nM = M / BM; nN = N / BM; nwg = nM * nN; G = G_; c = c_; }
    __device__ bool next(int i, Unit& u) const {
        const long L = (long)i * G + c; if (L >= nwg) return false;
        int wgid = (int)L; { const int q = nwg / NXCD, r = nwg % NXCD, xcd = wgid % NXCD, off = wgid / NXCD; wgid = (xcd < r ? xcd * (q + 1) : r * (q + 1) + (xcd - r) * q) + off; }
        const int nig = WGM * nN, gid = wgid / nig, fm = gid * WGM, gsz = (nM - fm) < WGM ? (nM - fm) : WGM;
        u.pm = fm + ((wgid % nig) % gsz); u.pn = (wgid % nig) / gsz; return true;
    }
};
template <class Epi>
__device__ __forceinline__ void gemm_phase(LAS unsigned char* lds, const Gemm g, const StaticOrder& S, const Epi& E) {
    int tid = threadIdx.x; asm volatile("" : "+v"(tid));
    const int wid = __builtin_amdgcn_readfirstlane(tid >> 6), lane = tid & 63, wr = wid >> 2, wc = wid & 3, fr = lane & 15, fq = lane >> 4;
    int K = g.K; asm volatile("" : "+s"(K));
    const int nt = K / BK;
    unsigned voffA[2], voffB[2];
#pragma unroll
    for (int i = 0; i < 2; ++i) { int R, C; stage_rc(tid * 16 + i * 8192, R, C); const int Rb = Epi::PERM ? ((R & ~31) + perm32(R & 31)) : R;
        voffA[i] = (unsigned)(R * g.lda + C) * 2u; voffB[i] = (unsigned)(Rb * g.ldb + C) * 2u; }
    const size_t kstep = (size_t)(BK * 2);
    const size_t hstepA = (size_t)HALF * g.lda * 2, hstepB = (size_t)HALF * g.ldb * 2;
    const size_t tstepA = 2 * hstepA, tstepB = 2 * hstepB;
    const unsigned ldsw = (unsigned)wid * 1024u;
    const int aoff = lds_byte(wr * 64 + fr, fq * 8), boff = lds_byte(wc * 32 + fr, fq * 8);
#define PG8_SA(b, h) (((b) * 2 + (h)) * HTB)
#define PG8_SB(b, h) ((4 + (b) * 2 + (h)) * HTB)
#define PG8_STAGE(bufoff, gbase, voff) do { _Pragma("unroll") for (int _i = 0; _i < 2; ++_i) \
        __builtin_amdgcn_global_load_lds((const unsigned*)((const char*)(gbase) + (voff)[_i]), (LAS unsigned*)(lds + (bufoff) + ldsw + _i * 8192), 16, 0, 0); } while (0)
#define PG8_LDA(dst, b, h) do { _Pragma("unroll") for (int m = 0; m < 4; ++m) _Pragma("unroll") for (int k = 0; k < 2; ++k) dst[m][k] = *(const LAS bf16x8*)(lds + PG8_SA(b, h) + aoff + m * 2048 + k * 1024); } while (0)
#define PG8_LDB(dst, b, h) do { _Pragma("unroll") for (int n = 0; n < 2; ++n) _Pragma("unroll") for (int k = 0; k < 2; ++k) dst[n][k] = *(const LAS bf16x8*)(lds + PG8_SB(b, h) + boff + n * 2048 + k * 1024); } while (0)
#define PG8_MMA(ai, bj, At, Bt) do { __builtin_amdgcn_s_setprio(1); _Pragma("unroll") for (int m = 0; m < 4; ++m) _Pragma("unroll") for (int n = 0; n < 2; ++n) _Pragma("unroll") for (int k = 0; k < 2; ++k) \
        acc[ai][bj][m][n] = __builtin_amdgcn_mfma_f32_16x16x32_bf16(Bt[n][k], At[m][k], acc[ai][bj][m][n], 0, 0, 0); __builtin_amdgcn_s_setprio(0); } while (0)
#define PG8_WAIT_V(n) asm volatile("s_waitcnt vmcnt(" #n ")" ::: "memory")
#define PG8_WAIT_L(n) asm volatile("s_waitcnt lgkmcnt(" #n ")" ::: "memory")
#define PG8_BAR __builtin_amdgcn_s_barrier()
#define PG8_SCHED __builtin_amdgcn_sched_barrier(0)
    Unit cur, nxt; int ui = 0;
    if (!S.next(0, cur)) return;
    f32x4 acc[2][2][4][2];
#pragma unroll
    for (int a = 0; a < 2; ++a)
#pragma unroll
        for (int b = 0; b < 2; ++b)
#pragma unroll
            for (int m = 0; m < 4; ++m)
#pragma unroll
                for (int n = 0; n < 2; ++n) acc[a][b][m][n] = (f32x4){0.f, 0.f, 0.f, 0.f};
    bf16x8 At[4][2], B0[2][2], B1[2][2];
    const char* cA = (const char*)g.A + (size_t)cur.pm * tstepA; const char* cB = (const char*)g.Bt + (size_t)cur.pn * tstepB;
    PG8_STAGE(PG8_SB(0, 0), cB, voffB); PG8_STAGE(PG8_SB(0, 1), cB + hstepB, voffB); PG8_STAGE(PG8_SA(0, 0), cA, voffA); PG8_STAGE(PG8_SA(0, 1), cA + hstepA, voffA);
    if (wr == 1) PG8_BAR;
    PG8_WAIT_V(2); PG8_BAR;
    PG8_STAGE(PG8_SB(1, 0), cB + kstep, voffB); PG8_STAGE(PG8_SA(1, 0), cA + kstep, voffA); PG8_STAGE(PG8_SB(1, 1), cB + hstepB + kstep, voffB);
    PG8_WAIT_V(6); PG8_BAR;
    for (;;) {
        const bool has_next = S.next(ui + 1, nxt);
        const char* nA = has_next ? (const char*)g.A + (size_t)nxt.pm * tstepA : cA; const char* nB = has_next ? (const char*)g.Bt + (size_t)nxt.pn * tstepB : cB;
        for (int t = 0; t < nt; t += 2) {
            const bool last = (t == nt - 2);
            const char* a1 = cA + (size_t)(t + 1) * kstep;
            const char* a2 = last ? nA : cA + (size_t)(t + 2) * kstep; const char* b2 = last ? nB : cB + (size_t)(t + 2) * kstep;
            const char* a3 = a2 + kstep; const char* b3 = b2 + kstep;
            PG8_LDB(B0, 0, 0); PG8_LDB(B1, 0, 1); PG8_SCHED; PG8_LDA(At, 0, 0); PG8_STAGE(PG8_SA(1, 1), a1 + hstepA, voffA);
            PG8_WAIT_V(8); PG8_WAIT_L(0); PG8_BAR; PG8_MMA(0, 0, At, B0); PG8_MMA(0, 1, At, B1); PG8_BAR; PG8_SCHED;
            PG8_LDA(At, 0, 1); PG8_STAGE(PG8_SB(0, 0), b2, voffB); PG8_STAGE(PG8_SB(0, 1), b2 + hstepB, voffB); PG8_STAGE(PG8_SA(0, 0), a2, voffA);
            PG8_WAIT_V(8); PG8_WAIT_L(0); PG8_BAR; PG8_MMA(1, 0, At, B0); PG8_MMA(1, 1, At, B1); PG8_BAR; PG8_SCHED;
            PG8_LDB(B0, 1, 0); PG8_LDB(B1, 1, 1); PG8_SCHED; PG8_LDA(At, 1, 0); PG8_STAGE(PG8_SA(0, 1), a2 + hstepA, voffA);
            PG8_WAIT_V(8); PG8_WAIT_L(0); PG8_BAR; PG8_MMA(0, 0, At, B0); PG8_MMA(0, 1, At, B1); PG8_BAR; PG8_SCHED;
            PG8_LDA(At, 1, 1); PG8_STAGE(PG8_SB(1, 0), b3, voffB); PG8_STAGE(PG8_SB(1, 1), b3 + hstepB, voffB); PG8_STAGE(PG8_SA(1, 0), a3, voffA);
            PG8_WAIT_V(8); PG8_WAIT_L(0); PG8_BAR; PG8_MMA(1, 0, At, B0); PG8_MMA(1, 1, At, B1); PG8_BAR; PG8_SCHED;
        }
        if (wr == 0) PG8_BAR;
        E(acc, cur, wr, wc, fr, fq);
        if (!has_next) break;
#pragma unroll
        for (int a = 0; a < 2; ++a)
#pragma unroll
            for (int b = 0; b < 2; ++b)
#pragma unroll
                for (int m = 0; m < 4; ++m)
#pragma unroll
                    for (int n = 0; n < 2; ++n) acc[a][b][m][n] = (f32x4){0.f, 0.f, 0.f, 0.f};
        cur = nxt; cA = nA; cB = nB; ++ui;
        if (wr == 1) PG8_BAR;
    }
    PG8_WAIT_V(0);
    PG8_BAR;
#undef PG8_SA
#undef PG8_SB
#undef PG8_STAGE
#undef PG8_LDA
#undef PG8_LDB
#undef PG8_MMA
#undef PG8_WAIT_V
#undef PG8_WAIT_L
#undef PG8_BAR
#undef PG8_SCHED
}

struct EpiU {
    static constexpr bool PERM = true;
    bf16_t* O; int ldc;
    __device__ __forceinline__ void operator()(const f32x4 (&acc)[2][2][4][2], const Unit& u, int wr, int wc, int fr, int fq) const {
        const int row0 = u.pm * BM + wr * 64 + fr, col0 = u.pn * BM + wc * 32 + 8 * fq;
#pragma unroll
        for (int ai = 0; ai < 2; ++ai)
#pragma unroll
            for (int m = 0; m < 4; ++m) { bf16_t* rowp = O + (size_t)(row0 + ai * HALF + m * 16) * ldc + col0;
#pragma unroll
                for (int bj = 0; bj < 2; ++bj) { const f32x4 v0 = acc[ai][bj][m][0], v1 = acc[ai][bj][m][1];
                    u32x4 w; w.x = pk2(v0[0], v0[1]); w.y = pk2(v0[2], v0[3]); w.z = pk2(v1[0], v1[1]); w.w = pk2(v1[2], v1[3]);
                    *(u32x4*)(rowp + bj * HALF) = w; }
                asm volatile("" ::: "memory"); }
    }
};
struct EpiRowScale {
    static constexpr bool PERM = true;
    bf16_t* O; int ldc; const float* rs; float sc;
    __device__ __forceinline__ void operator()(const f32x4 (&acc)[2][2][4][2], const Unit& u, int wr, int wc, int fr, int fq) const {
        const int row0 = u.pm * BM + wr * 64 + fr, col0 = u.pn * BM + wc * 32 + 8 * fq;
#pragma unroll
        for (int ai = 0; ai < 2; ++ai)
#pragma unroll
            for (int m = 0; m < 4; ++m) { const int row = row0 + ai * HALF + m * 16; const float s = rs[row] * sc; bf16_t* rowp = O + (size_t)row * ldc + col0;
#pragma unroll
                for (int bj = 0; bj < 2; ++bj) { const f32x4 v0 = acc[ai][bj][m][0] * s, v1 = acc[ai][bj][m][1] * s;
                    u32x4 w; w.x = pk2(v0[0], v0[1]); w.y = pk2(v0[2], v0[3]); w.z = pk2(v1[0], v1[1]); w.w = pk2(v1[2], v1[3]);
                    *(u32x4*)(rowp + bj * HALF) = w; }
                asm volatile("" ::: "memory"); }
    }
};
struct EpiQ {
    static constexpr bool PERM = true;
    bf16_t* O; const float* rs; const float* cosT; const float* sinT;
    __device__ __forceinline__ void operator()(const f32x4 (&acc)[2][2][4][2], const Unit& u, int wr, int wc, int fr, int fq) const {
        const int row0 = u.pm * BM + wr * 64 + fr, col0 = u.pn * BM + wc * 32 + 8 * fq;
#pragma unroll
        for (int ai = 0; ai < 2; ++ai)
#pragma unroll
            for (int m = 0; m < 4; ++m) { const int row = row0 + ai * HALF + m * 16; const float s = rs[row] * QSCALE; bf16_t* rowp = O + (size_t)row * 1536 + col0;
#pragma unroll
                for (int bj = 0; bj < 2; ++bj) { f32x4 v0 = acc[ai][bj][m][0] * s, v1 = acc[ai][bj][m][1] * s;
                    const int cin = (col0 + bj * HALF) % 192;
                    if (cin >= 128) { const int j0 = (cin - 128) >> 1;
                        const f32x4 c = *(const f32x4*)(cosT + (size_t)row * 32 + j0), sn = *(const f32x4*)(sinT + (size_t)row * 32 + j0);
                        f32x4 r0, r1;
                        r0[0] = v0[0] * c[0] - v0[1] * sn[0]; r0[1] = v0[1] * c[0] + v0[0] * sn[0];
                        r0[2] = v0[2] * c[1] - v0[3] * sn[1]; r0[3] = v0[3] * c[1] + v0[2] * sn[1];
                        r1[0] = v1[0] * c[2] - v1[1] * sn[2]; r1[1] = v1[1] * c[2] + v1[0] * sn[2];
                        r1[2] = v1[2] * c[3] - v1[3] * sn[3]; r1[3] = v1[3] * c[3] + v1[2] * sn[3];
                        v0 = r0; v1 = r1; }
                    u32x4 w; w.x = pk2(v0[0], v0[1]); w.y = pk2(v0[2], v0[3]); w.z = pk2(v1[0], v1[1]); w.w = pk2(v1[2], v1[3]);
                    *(u32x4*)(rowp + bj * HALF) = w; }
                asm volatile("" ::: "memory"); }
    }
};
struct EpiColScale {
    static constexpr bool PERM = true;
    bf16_t* O; int ldc; const float* cs;
    __device__ __forceinline__ void operator()(const f32x4 (&acc)[2][2][4][2], const Unit& u, int wr, int wc, int fr, int fq) const {
        const int row0 = u.pm * BM + wr * 64 + fr, col0 = u.pn * BM + wc * 32 + 8 * fq;
        const int pos0 = (col0 & ~15) + 4 * ((col0 >> 3) & 1);
        f32x4 sv[2][2];
#pragma unroll
        for (int bj = 0; bj < 2; ++bj)
#pragma unroll
            for (int n = 0; n < 2; ++n) sv[bj][n] = *(const f32x4*)(cs + col0 + bj * HALF + 4 * n);
#pragma unroll
        for (int ai = 0; ai < 2; ++ai)
#pragma unroll
            for (int m = 0; m < 4; ++m) { bf16_t* rowp = O + (size_t)(row0 + ai * HALF + m * 16) * ldc + pos0;
#pragma unroll
                for (int bj = 0; bj < 2; ++bj) { const f32x4 v0 = acc[ai][bj][m][0] * sv[bj][0], v1 = acc[ai][bj][m][1] * sv[bj][1];
                    u32x2 w0, w1; w0.x = pk2(v0[0], v0[1]); w0.y = pk2(v0[2], v0[3]); w1.x = pk2(v1[0], v1[1]); w1.y = pk2(v1[2], v1[3]);
                    *(u32x2*)(rowp + bj * HALF) = w0; *(u32x2*)(rowp + bj * HALF + 8) = w1; }
                asm volatile("" ::: "memory"); }
    }
};
struct EpiResB16 {
    static constexpr bool PERM = true;
    bf16_t* O; const float* res;
    __device__ __forceinline__ void operator()(const f32x4 (&acc)[2][2][4][2], const Unit& u, int wr, int wc, int fr, int fq) const {
        const int row0 = u.pm * BM + wr * 64 + fr, col0 = u.pn * BM + wc * 32 + 8 * fq;
#pragma unroll
        for (int ai = 0; ai < 2; ++ai)
#pragma unroll
            for (int m = 0; m < 4; ++m) { const size_t ro = (size_t)(row0 + ai * HALF + m * 16) * DM + col0;
#pragma unroll
                for (int bj = 0; bj < 2; ++bj) { const f32x4 r0 = *(const f32x4*)(res + ro + bj * HALF), r1 = *(const f32x4*)(res + ro + bj * HALF + 4);
                    const f32x4 v0 = r0 * ALPHA + acc[ai][bj][m][0], v1 = r1 * ALPHA + acc[ai][bj][m][1];
                    u32x4 w; w.x = pk2(v0[0], v0[1]); w.y = pk2(v0[2], v0[3]); w.z = pk2(v1[0], v1[1]); w.w = pk2(v1[2], v1[3]);
                    *(u32x4*)(O + ro + bj * HALF) = w; }
                asm volatile("" ::: "memory"); }
    }
};
struct EpiRes {
    static constexpr bool PERM = false;
    float* C; const float* res;
    __device__ __forceinline__ void operator()(const f32x4 (&acc)[2][2][4][2], const Unit& u, int wr, int wc, int fr, int fq) const {
        const int row0 = u.pm * BM + wr * 64 + fr, col0 = u.pn * BM + wc * 32 + 4 * fq;
#pragma unroll
        for (int ai = 0; ai < 2; ++ai)
#pragma unroll
            for (int m = 0; m < 4; ++m) { const size_t ro = (size_t)(row0 + ai * HALF + m * 16) * DM + col0;
#pragma unroll
                for (int bj = 0; bj < 2; ++bj)
#pragma unroll
                    for (int n = 0; n < 2; ++n) { const f32x4 r = *(const f32x4*)(res + ro + bj * HALF + n * 16);
                        *(f32x4*)(C + ro + bj * HALF + n * 16) = r * ALPHA + acc[ai][bj][m][n]; } }
    }
};
}

__device__ __forceinline__ int wmap_col(int kind, int n) {
    if (kind == 0) return n < NIN ? n : -1;
    if (kind == 1) return n;
    if (kind == 2) { const int h = n / 192, c = n % 192; if (c < 128) return n; const int j = (c - 128) >> 1, e = (c - 128) & 1; return h * 192 + 128 + j + 32 * e; }
    if (kind == 3) { const int h = n >> 7, c = n & 127; return h * 256 + c; }
    { const int h = n >> 7, c = n & 127; return h * 256 + 128 + c; }
}
__device__ __forceinline__ void convert_weights(KP p, int l, LAS unsigned char* lds) {
    KP_FENCE(p);
    int tid = threadIdx.x; asm volatile("" : "+v"(tid));
    const int tx = tid & 63, ty = tid >> 6;
    LAS float* tile = (LAS float*)lds;
    const int nK[5] = {32, 32, 8, 4, 4}, nN[5] = {96, 32, 24, 16, 16};
    const int start1 = nK[0] * nN[0], start2 = start1 + nK[1] * nN[1], start3 = start2 + nK[2] * nN[2], start4 = start3 + nK[3] * nN[3], total = start4 + nK[4] * nN[4];
    for (int it = blockIdx.x; it < total; it += gridDim.x) {
        int kind, loc;
        if (it < start1) { kind = 0; loc = it; } else if (it < start2) { kind = 1; loc = it - start1; } else if (it < start3) { kind = 2; loc = it - start2; }
        else if (it < start4) { kind = 3; loc = it - start3; } else { kind = 4; loc = it - start4; }
        const float* src; bf16_t* dst; const float* g = nullptr; int K, Nsrc, nnt;
        if (kind == 0) { src = p->w_in + (size_t)l * DM * NIN; dst = (bf16_t*)(p->ws + WS_WIN); K = 2048; Nsrc = NIN; nnt = 96; }
        else if (kind == 1) { src = p->w_out + (size_t)l * DM * DM; dst = (bf16_t*)(p->ws + WS_WOUT); K = 2048; Nsrc = DM; nnt = 32; }
        else if (kind == 2) { src = p->w_uq + (size_t)l * 512 * 1536; dst = (bf16_t*)(p->ws + WS_WUQ); K = 512; Nsrc = 1536; nnt = 24; g = p->q_norm_g + l * 512; }
        else if (kind == 3) { src = p->w_ukv + (size_t)l * 256 * 2048; dst = (bf16_t*)(p->ws + WS_WUK); K = 256; Nsrc = 2048; nnt = 16; g = p->kv_norm_g + l * 256; }
        else { src = p->w_ukv + (size_t)l * 256 * 2048; dst = (bf16_t*)(p->ws + WS_WUV); K = 256; Nsrc = 2048; nnt = 16; g = p->kv_norm_g + l * 256; }
        const int n0 = (loc % nnt) * 64, k0 = (loc / nnt) * 64;
        if (kind != 2) {
            const int n4 = 4 * (tid & 15), sc4 = wmap_col(kind, n0 + n4);
#pragma unroll
            for (int i = 0; i < 2; ++i) { const int kr = (tid >> 4) + 32 * i, k = k0 + kr; f32x4 v = {0.f, 0.f, 0.f, 0.f};
                if (sc4 >= 0) v = *(const f32x4*)(src + (size_t)k * Nsrc + sc4); if (g) v = v * g[k];
                tile[kr * 65 + n4] = v[0]; tile[kr * 65 + n4 + 1] = v[1]; tile[kr * 65 + n4 + 2] = v[2]; tile[kr * 65 + n4 + 3] = v[3]; }
        } else {
            const int sc = wmap_col(kind, n0 + tx);
#pragma unroll
            for (int i = 0; i < 8; ++i) { const int k = k0 + ty * 8 + i; float v = src[(size_t)k * Nsrc + sc]; if (g) v *= g[k]; tile[(ty * 8 + i) * 65 + tx] = v; }
        }
        __syncthreads();
        {
            const int kp = tid & 31;
#pragma unroll
            for (int i = 0; i < 4; ++i) { const int nl = (tid >> 5) + 16 * i;
                *(unsigned*)(dst + (size_t)(n0 + nl) * K + k0 + 2 * kp) = pk2(tile[(2 * kp) * 65 + nl], tile[(2 * kp + 1) * 65 + nl]); }
        }
        __syncthreads();
    }
}

__device__ __forceinline__ void phase_p0(KP p, LAS unsigned char* lds) {
    KP_FENCE(p);
    const int tid = threadIdx.x;
    if (blockIdx.x == 0) { unsigned* ctl = (unsigned*)(p->ws + WS_CTL); for (int i = tid; i < 16384; i += 512) ctl[i] = 0u; }
    convert_weights(p, 0, lds);
    bf16_t* xb = (bf16_t*)(p->ws + WS_XB);
    const size_t n4 = (size_t)T * DM / 4;
    const size_t xstr = (size_t)gridDim.x * 512;
    for (size_t i0 = (size_t)blockIdx.x * 512 + tid; i0 < n4; i0 += xstr * 8) {
        f32x4 v[8];
#pragma unroll
        for (int k = 0; k < 8; ++k) v[k] = *(const f32x4*)(p->x + (i0 + k * xstr) * 4);
#pragma unroll
        for (int k = 0; k < 8; ++k) { u32x2 w; w.x = pk2(v[k][0], v[k][1]); w.y = pk2(v[k][2], v[k][3]); *(u32x2*)(xb + (i0 + k * xstr) * 4) = w; } }
    float* cosT = (float*)(p->ws + WS_COS); float* sinT = (float*)(p->ws + WS_SIN);
    for (int i = blockIdx.x * 512 + tid; i < T * 32; i += gridDim.x * 512) {
        const int t = i >> 5, j = i & 31;
        const float ang = (float)p->pos[t] * p->inv_freq[j];
        double rev = (double)ang * 0.15915494309189535; rev -= rint(rev);
        cosT[i] = __builtin_amdgcn_cosf((float)rev); sinT[i] = __builtin_amdgcn_sinf((float)rev);
    }
}

__device__ __forceinline__ void phase_prep(KP p, int l, LAS unsigned char* lds) {
    KP_FENCE(p);
    int tid = threadIdx.x; asm volatile("" : "+v"(tid));
    const int lane = tid & 63, wave = tid >> 6, c = tid;
    const bf16_t* U = (const bf16_t*)(p->ws + WS_U);
    bf16_t* MIX = (bf16_t*)(p->ws + WS_MIX); bf16_t* KPEB = (bf16_t*)(p->ws + WS_KPE); bf16_t* SCAN = (bf16_t*)(p->ws + WS_SCAN);
    float* SC2 = (float*)(p->ws + WS_SC2); float* RSQ = (float*)(p->ws + WS_RS); float* RSKV = RSQ + T;
    const float* cosT = (const float*)(p->ws + WS_COS); const float* sinT = (const float*)(p->ws + WS_SIN);
    LAS float* sth = (LAS float*)lds;
    LAS float* spart = (LAS float*)(lds + 8192);
    f32x2 war[64];
#pragma unroll
    for (int j = 0; j < 64; ++j) { war[j][0] = p->w2[(size_t)l * 64 * 512 + j * 512 + c]; war[j][1] = p->a2[(size_t)l * 64 * 512 + j * 512 + c]; }
    const float* mu = p->mu + l * 1664;
    const float mu_r = mu[c], mu_k = mu[576 + c], mu_v = mu[1088 + c];
    const float w0c = p->w0[l * 512 + c], a0c = p->a0[l * 512 + c], kkc = p->k_k[l * 512 + c], kac = p->k_a[l * 512 + c], rkc = p->r_k[l * 512 + c];
    const float cw0 = p->conv_w[(l * 3 + 0) * 512 + c], cw1 = p->conv_w[(l * 3 + 1) * 512 + c], cw2 = p->conv_w[(l * 3 + 2) * 512 + c];
    for (int tile = blockIdx.x; tile < T / 128; tile += gridDim.x) {
        const int t0 = tile * 128; const bool first = (t0 % SEQ) == 0;
        float pr = 0.f, pk = 0.f, pv = 0.f, pu1 = 0.f, pu2 = 0.f, Gc = 1.f;
        if (!first) { const bf16_t* up = U + (size_t)(t0 - 1) * LDU; pr = bf2f(up[C_RC + c]); pk = bf2f(up[C_RC + 576 + c]); pv = bf2f(up[C_RC + 1088 + c]);
            pu1 = bf2f(up[C_CC + c]) * bf2f(up[C_CH + c]); const bf16_t* up2 = up - LDU; pu2 = bf2f(up2[C_CC + c]) * bf2f(up2[C_CH + c]); }
        const int s_tok0 = tid >> 7, s_jj = tid & 127, s_cr = (s_jj < 64) ? (512 + s_jj) : (1600 + s_jj - 64); const float s_mu = mu[s_cr];
        unsigned short sc_[2], sp_[2];
#define PREP_STAGE_LOAD(tb_) do { _Pragma("unroll") for (int i = 0; i < 2; ++i) { const int t = (tb_) + s_tok0 + 4 * i; \
            sc_[i] = U[(size_t)t * LDU + C_RC + s_cr]; sp_[i] = (t % SEQ) == 0 ? (unsigned short)0 : U[(size_t)(t - 1) * LDU + C_RC + s_cr]; } } while (0)
#define PREP_STAGE_STORE(buf_) do { _Pragma("unroll") for (int i = 0; i < 2; ++i) { const float cur = bf2f(sc_[i]), prev = bf2f(sp_[i]); float xv = cur + (prev - cur) * s_mu; \
            if (s_jj < 64) { const float e = __expf(2.f * xv); xv = 1.f - 2.f * __builtin_amdgcn_rcpf(e + 1.f); } sth[(buf_) * 1024 + (s_tok0 + 4 * i) * 128 + 2 * (s_jj & 63) + (s_jj >> 6)] = xv; } } while (0)
        PREP_STAGE_LOAD(t0); PREP_STAGE_STORE(0);
        __syncthreads();
        for (int sb = 0; sb < 16; ++sb) {
            const int tb = t0 + sb * 8; const LAS float* sthb = sth + (sb & 1) * 1024;
            if (sb + 1 < 16) PREP_STAGE_LOAD(tb + 8);
            unsigned short kx1 = 0, kx2 = 0; float kcs = 0.f, ksn = 0.f;
            if (tid < 256) { const int tok = tid >> 5, j = tid & 31, t = tb + tok; const bf16_t* ur = U + (size_t)t * LDU + C_KPE; kx1 = ur[j]; kx2 = ur[32 + j]; kcs = cosT[t * 32 + j]; ksn = sinT[t * 32 + j]; }
            for (int g4 = 0; g4 < 2; ++g4) {
                unsigned short raw[4][9];
#pragma unroll
                for (int i = 0; i < 4; ++i) { const bf16_t* ur = U + (size_t)(tb + g4 * 4 + i) * LDU;
                    raw[i][0] = ur[C_RC + c]; raw[i][1] = ur[C_RC + 576 + c]; raw[i][2] = ur[C_RC + 1088 + c]; raw[i][3] = ur[C_CB + c]; raw[i][4] = ur[C_CC + c]; raw[i][5] = ur[C_CH + c];
                    raw[i][6] = ur[C_CG + c]; raw[i][7] = ur[C_CQ + c]; raw[i][8] = (c < 256) ? ur[C_CKV + c] : (unsigned short)0; }
#pragma unroll
                for (int i = 0; i < 4; ++i) {
                    const int tok = g4 * 4 + i, t = tb + tok;
                    const float ur_ = bf2f(raw[i][0]), uk_ = bf2f(raw[i][1]), uv_ = bf2f(raw[i][2]);
                    const float cb = bf2f(raw[i][3]), cc = bf2f(raw[i][4]), ch = bf2f(raw[i][5]), cgt = bf2f(raw[i][6]);
                    const float cq = bf2f(raw[i][7]); const float ckv = bf2f(raw[i][8]);
                    const float uc = cc * ch; const float yc = cw0 * pu2 + cw1 * pu1 + cw2 * uc; pu2 = pu1; pu1 = uc;
                    MIX[(size_t)t * DM + c] = (bf16_t)f2bf(cb * yc * silu_f(cgt));
                    const float sq = wave_sum(cq * cq), skv = wave_sum(ckv * ckv);
                    if (lane == 0) { spart[(sb * 8 + tok) * 12 + wave] = sq; if (wave < 4) spart[(sb * 8 + tok) * 12 + 8 + wave] = skv; }
                    const float r = ur_ + (pr - ur_) * mu_r, k = uk_ + (pk - uk_) * mu_k, v = uv_ + (pv - uv_) * mu_v; pr = ur_; pk = uk_; pv = uv_;
                    f32x2 zz0 = {w0c, a0c}, zz1 = {0.f, 0.f};
#pragma unroll
                    for (int j2 = 0; j2 < 32; ++j2) { const f32x4 ta = *(const LAS f32x4*)(sthb + tok * 128 + j2 * 4);
                        const f32x2 x0 = {ta[0], ta[1]}, x1 = {ta[2], ta[3]};
                        zz0 += x0 * war[2 * j2]; zz1 += x1 * war[2 * j2 + 1]; }
                    const float zw = zz0[0] + zz1[0], za = zz0[1] + zz1[1];
                    const float sp = fmaxf(-zw, 0.f) + __logf(1.f + __expf(-fabsf(zw)));
                    const float wlog = -sp - 0.5f; const float dec = __expf(-__expf(wlog));
                    const float asig = 1.f / (1.f + __expf(-za));
                    const float kkr = k * kkc; const float nrm = sqrtf(wave_sum(kkr * kkr)); const float kk = kkr / fmaxf(nrm, 1e-12f);
                    const float k2 = k * (1.f + (asig - 1.f) * kac);
                    const float av = -kk, bv = kk * asig;
                    const float br = wave_sum(bv * r), kr = wave_sum(k2 * r), rkb = wave_sum(r * k2 * rkc);
                    const float Gprev = ((t & 31) == 0) ? 1.f : Gc; Gc = Gprev * dec; const float Ginv = 1.f / Gc;
                    bf16_t* so = SCAN + ((size_t)t * 8 + wave) * 384 + lane;
                    *(unsigned*)(so + lane) = pk2(av * Gprev, r * Gc);
                    so[128] = (bf16_t)f2bf(Gc); so[192] = (bf16_t)f2bf(bv * Ginv); so[256] = (bf16_t)f2bf(k2 * Ginv); so[320] = (bf16_t)f2bf(v);
                    if (lane == 0) { f32x4 o4 = {br, kr, rkb, 0.f}; *(f32x4*)(SC2 + ((size_t)t * 8 + wave) * 4) = o4; }
                }
            }
            if (tid < 256) { const int tok = tid >> 5, j = tid & 31, t = tb + tok; const float x1 = bf2f(kx1), x2 = bf2f(kx2);
                *(unsigned*)(KPEB + (size_t)t * 64 + 2 * j) = pk2(x1 * kcs - x2 * ksn, x2 * kcs + x1 * ksn); }
            if (sb + 1 < 16) PREP_STAGE_STORE((sb + 1) & 1);
            __syncthreads();
        }
#undef PREP_STAGE_LOAD
#undef PREP_STAGE_STORE
        if (tid < 128) { float sq = 0.f, skv = 0.f;
#pragma unroll
            for (int w = 0; w < 8; ++w) sq += spart[tid * 12 + w];
#pragma unroll
            for (int w = 0; w < 4; ++w) skv += spart[tid * 12 + 8 + w];
            RSQ[t0 + tid] = rsqrtf(sq * (1.f / 512.f) + RMS_EPS); RSKV[t0 + tid] = rsqrtf(skv * (1.f / 256.f) + RMS_EPS); }
        __syncthreads();
    }
}

namespace att {
constexpr int KNROW = 272, KPROW = 144, VROW = 144, KN_BYTES = 64 * KNROW, KP_BYTES = 64 * KPROW, V_BYTES = 128 * VROW;
constexpr int OFF_KN = 0, OFF_KP = 2 * KN_BYTES, OFF_V = OFF_KP + 2 * KP_BYTES;
constexpr int NI_KN = 17, NI_KP = 9, NI_V = 18, NI_K = NI_KN + NI_KP, NI_ALL = NI_K + NI_V;
__device__ __forceinline__ void unit(KP p, int bh, int qb, LAS unsigned char* lds) {
    KP_FENCE(p);
    int tid = threadIdx.x; asm volatile("" : "+v"(tid));
    const int lane = tid & 63, w = __builtin_amdgcn_readfirstlane(tid >> 6), ql = lane & 31, hi = lane >> 5, grp = w >> 2;
    const int b = bh >> 3, h = bh & 7, q0 = qb * 256;
    const bf16_t* Q = (const bf16_t*)(p->ws + WS_Q); const bf16_t* KN = (const bf16_t*)(p->ws + WS_KN); const bf16_t* KPEB = (const bf16_t*)(p->ws + WS_KPE);
    const bf16_t* VT = (const bf16_t*)(p->ws + WS_VT); const bf16_t* U = (const bf16_t*)(p->ws + WS_U); bf16_t* MIX = (bf16_t*)(p->ws + WS_MIX);
    const int qpos = q0 + 32 * w + ql; const size_t tq = (size_t)b * SEQ + qpos;
    const int wqmin = q0 + 32 * w, wqmax = wqmin + 31;
    bf16x8 qf[12];
    { const bf16_t* qp = Q + tq * 1536 + h * 192 + 8 * hi;
#pragma unroll
      for (int ks = 0; ks < 12; ++ks) qf[ks] = *(const bf16x8*)(qp + 16 * ks); }
    f32x16 o[4];
#pragma unroll
    for (int d = 0; d < 4; ++d)
#pragma unroll
        for (int i = 0; i < 16; ++i) o[d][i] = 0.f;
    f32x16 st0, st1;
#pragma unroll
    for (int i = 0; i < 16; ++i) { st0[i] = 0.f; st1[i] = 0.f; }
    bf16x8 pf[4];
#pragma unroll
    for (int i = 0; i < 4; ++i) pf[i] = (bf16x8){0, 0, 0, 0, 0, 0, 0, 0};
    float mrow = -1e30f, lsum = 0.f;
    const int nj = 4 * (qb + 1);
    int doff[11];
    const bf16_t* kn0 = KN + (size_t)b * SEQ * 1024 + h * 128; const bf16_t* kp0 = KPEB + (size_t)b * SEQ * 64; const bf16_t* vt0 = VT + (size_t)h * 128 * T + (size_t)b * SEQ;
#pragma unroll
    for (int i = 0; i < 11; ++i) { const int n = (w & 3) + 4 * i;
        if (n < NI_KN) { const int ci = 64 * n + lane, row = ci / 17, col = ci % 17; doff[i] = row * 1024 + 8 * (col < 15 ? col : 15); }
        else if (n < NI_K) { const int ci = 64 * (n - NI_KN) + lane, row = ci / 9, col = ci % 9; doff[i] = row * 64 + 8 * (col < 7 ? col : 7); }
        else { const int ci = 64 * (n - NI_K) + lane, row = ci / 9, col = ci % 9; doff[i] = row * T + 8 * (col < 7 ? col : 7); } }
#define ATT_DMA(tk, tv) do { if (grp) { _Pragma("unroll") for (int i = 0; i < 11; ++i) { const int n = (w & 3) + 4 * i; \
        if (n < NI_KN) { if ((tk) >= 0 && (tk) < nj) __builtin_amdgcn_global_load_lds((const unsigned*)(kn0 + (size_t)(tk) * 65536 + doff[i]), (LAS unsigned*)(lds + OFF_KN + ((tk) & 1) * KN_BYTES + n * 1024), 16, 0, 0); } \
        else if (n < NI_K) { if ((tk) >= 0 && (tk) < nj) __builtin_amdgcn_global_load_lds((const unsigned*)(kp0 + (size_t)(tk) * 4096 + doff[i]), (LAS unsigned*)(lds + OFF_KP + ((tk) & 1) * KP_BYTES + (n - NI_KN) * 1024), 16, 0, 0); } \
        else if (n < NI_ALL) { if ((tv) >= 0 && (tv) < nj) __builtin_amdgcn_global_load_lds((const unsigned*)(vt0 + (size_t)(tv) * 64 + doff[i]), (LAS unsigned*)(lds + OFF_V + ((tv) & 1) * V_BYTES + (n - NI_K) * 1024), 16, 0, 0); } } } } while (0)
#define ATT_BAR() do { asm volatile("s_waitcnt lgkmcnt(0)" ::: "memory"); __builtin_amdgcn_s_barrier(); } while (0)
#define ATT_WAITV() asm volatile("s_waitcnt vmcnt(0)" ::: "memory")
#define ATT_SOFTMAX(j_) do { const int kt0 = 64 * (j_); \
        if (kt0 <= wqmax) { \
            if (kt0 + 63 > wqmin) { \
                _Pragma("unroll") for (int i = 0; i < 16; ++i) { const int key = kt0 + 8 * (i >> 2) + 4 * hi + (i & 3); if (key > qpos) st0[i] = -1e30f; if (key + 32 > qpos) st1[i] = -1e30f; } } \
            float mx = max3f(st0[0], st1[0], st0[1]), mx2 = max3f(st1[1], st0[2], st1[2]);     \
            _Pragma("unroll") for (int i = 3; i < 15; i += 2) { mx = max3f(mx, st0[i], st1[i]); mx2 = max3f(mx2, st0[i + 1], st1[i + 1]); } \
            mx = max3f(mx, st0[15], st1[15]); mx = fmaxf(mx, mx2); \
            { const auto sw = __builtin_amdgcn_permlane32_swap(__float_as_uint(mx), __float_as_uint(mx), false, false); mx = fmaxf(__uint_as_float(sw[0]), __uint_as_float(sw[1])); }     \
            const float mnew = fmaxf(mrow, mx); const float alpha = __builtin_amdgcn_exp2f(mrow - mnew); mrow = mnew; \
            float ps = 0.f; \
            _Pragma("unroll") for (int i = 0; i < 16; ++i) { st0[i] = __builtin_amdgcn_exp2f(st0[i] - mnew); st1[i] = __builtin_amdgcn_exp2f(st1[i] - mnew); ps += st0[i] + st1[i]; } \
            lsum = lsum * alpha + ps; \
            if (__builtin_amdgcn_ballot_w64(alpha != 1.f) != 0ull) {     \
                _Pragma("unroll") for (int d = 0; d < 4; ++d) _Pragma("unroll") for (int i = 0; i < 16; ++i) o[d][i] *= alpha; } \
            _Pragma("unroll") for (int s2 = 0; s2 < 2; ++s2) { u32x4 pw; \
                pw.x = pk2(st0[8 * s2 + 0], st0[8 * s2 + 1]); pw.y = pk2(st0[8 * s2 + 2], st0[8 * s2 + 3]); pw.z = pk2(st0[8 * s2 + 4], st0[8 * s2 + 5]); pw.w = pk2(st0[8 * s2 + 6], st0[8 * s2 + 7]); \
                pf[s2] = __builtin_bit_cast(bf16x8, pw); \
                pw.x = pk2(st1[8 * s2 + 0], st1[8 * s2 + 1]); pw.y = pk2(st1[8 * s2 + 2], st1[8 * s2 + 3]); pw.z = pk2(st1[8 * s2 + 4], st1[8 * s2 + 5]); pw.w = pk2(st1[8 * s2 + 6], st1[8 * s2 + 7]); \
                pf[2 + s2] = __builtin_bit_cast(bf16x8, pw); } \
        } } while (0)
#define ATT_PV(j_) do { if (64 * (j_) <= wqmax) { \
            const LAS unsigned char* vb = lds + OFF_V + ((j_) & 1) * V_BYTES + ql * VROW + 16 * hi; \
            bf16x8 vf[5]; \
            _Pragma("unroll") for (int it = 0; it < 4; ++it) vf[it] = *(const LAS bf16x8*)(vb + (it & 3) * 32 * VROW + 32 * (it >> 2)); \
            _Pragma("unroll") for (int it = 0; it < 16; ++it) { const int d = it & 3, s2 = it >> 2;     \
                if (it + 4 < 16) { const int d2 = (it + 4) & 3, s22 = (it + 4) >> 2; vf[(it + 4) % 5] = *(const LAS bf16x8*)(vb + d2 * 32 * VROW + 32 * s22); } \
                o[d] = __builtin_amdgcn_mfma_f32_32x32x16_bf16(vf[it % 5], pf[s2], o[d], 0, 0, 0); \
                __builtin_amdgcn_sched_barrier(0); } \
        } } while (0)
#define ATT_KADDR(ks_) (((ks_) < 8) ? (kb + 32 * (ks_)) : (kpb + 32 * ((ks_) - 8)))
#define ATT_KROWB(ks_) (((ks_) < 8) ? 32 * KNROW : 32 * KPROW)
#define ATT_QK(j_) do { if (64 * (j_) <= wqmax) { \
            const f32x16 zero16 = {0.f, 0.f, 0.f, 0.f, 0.f, 0.f, 0.f, 0.f, 0.f, 0.f, 0.f, 0.f, 0.f, 0.f, 0.f, 0.f}; \
            const LAS unsigned char* kb = lds + OFF_KN + ((j_) & 1) * KN_BYTES + ql * KNROW + 16 * hi; \
            const LAS unsigned char* kpb = lds + OFF_KP + ((j_) & 1) * KP_BYTES + ql * KPROW + 16 * hi; \
            bf16x8 kf0[3], kf1[3]; \
            kf0[0] = *(const LAS bf16x8*)(ATT_KADDR(0)); kf1[0] = *(const LAS bf16x8*)(ATT_KADDR(0) + ATT_KROWB(0)); \
            kf0[1] = *(const LAS bf16x8*)(ATT_KADDR(1)); kf1[1] = *(const LAS bf16x8*)(ATT_KADDR(1) + ATT_KROWB(1)); \
            _Pragma("unroll") for (int ks = 0; ks < 12; ++ks) { \
                if (ks + 2 < 12) { kf0[(ks + 2) % 3] = *(const LAS bf16x8*)(ATT_KADDR(ks + 2)); kf1[(ks + 2) % 3] = *(const LAS bf16x8*)(ATT_KADDR(ks + 2) + ATT_KROWB(ks + 2)); } \
                st0 = __builtin_amdgcn_mfma_f32_32x32x16_bf16(kf0[ks % 3], qf[ks], ks == 0 ? zero16 : st0, 0, 0, 0);     \
                st1 = __builtin_amdgcn_mfma_f32_32x32x16_bf16(kf1[ks % 3], qf[ks], ks == 0 ? zero16 : st1, 0, 0, 0); \
                __builtin_amdgcn_sched_barrier(0); } \
        } } while (0)
    ATT_DMA(0, -1);
    ATT_WAITV();
    __builtin_amdgcn_s_barrier();
    if (grp == 0) {
        ATT_DMA(1, 0); ATT_QK(0); ATT_BAR();
        for (int j = 0; j < nj; ++j) {
            ATT_SOFTMAX(j); ATT_WAITV(); ATT_BAR();
            ATT_DMA(j + 2, j + 1); ATT_PV(j); if (j + 1 < nj) ATT_QK(j + 1); ATT_BAR();
        }
        ATT_WAITV(); ATT_BAR();
    } else {
        ATT_DMA(1, 0); ATT_BAR();
        for (int j = 0; j < nj; ++j) {
            if (j >= 1) ATT_PV(j - 1); ATT_QK(j); ATT_WAITV(); ATT_BAR();
            ATT_DMA(j + 2, j + 1); ATT_SOFTMAX(j); ATT_BAR();
        }
        ATT_PV(nj - 1); ATT_WAITV(); ATT_BAR();
    }
#undef ATT_SOFTMAX
#undef ATT_PV
#undef ATT_QK
#undef ATT_KADDR
#undef ATT_KROWB
#undef ATT_BAR
#undef ATT_WAITV
#undef ATT_DMA
    const float ltot = lsum + __shfl_xor(lsum, 32); const float inv = 1.f / ltot;
    const bf16_t* gp = U + tq * LDU + C_MG + h * 128; bf16_t* op = MIX + tq * DM + 512 + h * 128;
    u32x2 gwv[16];
#pragma unroll
    for (int d = 0; d < 4; ++d)
#pragma unroll
        for (int g4 = 0; g4 < 4; ++g4) gwv[d * 4 + g4] = *(const u32x2*)(gp + 32 * d + 8 * g4 + 4 * hi);
#pragma unroll
    for (int d = 0; d < 4; ++d)
#pragma unroll
        for (int g4 = 0; g4 < 4; ++g4) { const int dv0 = 32 * d + 8 * g4 + 4 * hi;
            const u32x2 gw = gwv[d * 4 + g4];
            const float g0 = __uint_as_float(gw.x << 16), g1 = __uint_as_float(gw.x & 0xffff0000u), g2 = __uint_as_float(gw.y << 16), g3 = __uint_as_float(gw.y & 0xffff0000u);
            u32x2 ow; ow.x = pk2(o[d][4 * g4 + 0] * inv * silu_f(g0), o[d][4 * g4 + 1] * inv * silu_f(g1)); ow.y = pk2(o[d][4 * g4 + 2] * inv * silu_f(g2), o[d][4 * g4 + 3] * inv * silu_f(g3));
            *(u32x2*)(op + dv0) = ow; }
}
}

namespace scan {
constexpr int CT = 32;
constexpr int RW = 16;
constexpr int IN_BYTES = CT * 6 * 64 * 4;
constexpr int OFF_IN = 0, OFF_SC2 = 2 * IN_BYTES, OFF_Y = OFF_SC2 + 2 * CT * 8, Y_BYTES = CT * RW * 4;
__device__ __forceinline__ void run(KP p, int wg, LAS unsigned char* lds) {
    KP_FENCE(p);
    int tid = threadIdx.x; asm volatile("" : "+v"(tid));
    const int lane = tid & 63, w = __builtin_amdgcn_readfirstlane(tid >> 6);
    const int bh = wg >> 2, part = wg & 3, b = bh >> 3, h = bh & 7;
    const bf16_t* SCAN = (const bf16_t*)(p->ws + WS_SCAN); const float* SC2 = (const float*)(p->ws + WS_SC2); bf16_t* MIX = (bf16_t*)(p->ws + WS_MIX);
    const int nch = SEQ / CT;
    const bool stager = (w >= 4); const int stid = tid - 256;
    const int rg = lane >> 4, kq = lane & 15; const int rl = 4 * (w & 3) + rg;
    f32x4 s0 = {0.f, 0.f, 0.f, 0.f};
    u32x4 ld[6]; f32x2 ld2 = {0.f, 0.f};
#define SC_GLOAD(c) do { const size_t tb = (size_t)b * SEQ + (size_t)(c) * CT; \
        _Pragma("unroll") for (int i = 0; i < 6; ++i) { const int idx = stid + 256 * i, tok = idx / 48, pt = idx % 48; ld[i] = *(const u32x4*)(SCAN + ((tb + tok) * 8 + h) * 384 + 8 * pt); } \
        if (stid < CT) ld2 = *(const f32x2*)(SC2 + ((tb + stid) * 8 + h) * 4); } while (0)
#define SC_LSTORE(c) do { const int bo = OFF_IN + ((c) & 1) * IN_BYTES; \
        _Pragma("unroll") for (int i = 0; i < 6; ++i) { const int idx = stid + 256 * i, tok = idx / 48, pt = idx % 48; \
            f32x4 lo = {__uint_as_float(ld[i].x << 16), __uint_as_float(ld[i].x & 0xffff0000u), __uint_as_float(ld[i].y << 16), __uint_as_float(ld[i].y & 0xffff0000u)}; \
            f32x4 hi4 = {__uint_as_float(ld[i].z << 16), __uint_as_float(ld[i].z & 0xffff0000u), __uint_as_float(ld[i].w << 16), __uint_as_float(ld[i].w & 0xffff0000u)}; \
            const int o_lo = (pt < 16) ? pt * 4 : pt * 8, o_hi = (pt < 16) ? 64 + pt * 4 : pt * 8 + 4;     \
            *(LAS f32x4*)(lds + bo + (tok * 384 + o_lo) * 4) = lo; *(LAS f32x4*)(lds + bo + (tok * 384 + o_hi) * 4) = hi4; } \
        if (stid < CT) *(LAS f32x2*)(lds + OFF_SC2 + ((c) & 1) * CT * 8 + stid * 8) = ld2; } while (0)
#define SC_YOUT(c) do { const size_t tb = (size_t)b * SEQ + (size_t)(c) * CT; const int tok = stid >> 3, r2 = (stid & 7) * 2; \
        const f32x2 y2 = *(const LAS f32x2*)(lds + OFF_Y + ((c) & 1) * Y_BYTES + (tok * RW + r2) * 4); \
        *(unsigned*)(MIX + (tb + tok) * DM + 1536 + h * 64 + RW * part + r2) = pk2(y2[0], y2[1]); } while (0)
    if (stager) { SC_GLOAD(0); SC_LSTORE(0); }
    __syncthreads();
    for (int c = 0; c < nch; ++c) {
        if (stager) {
            if (c + 1 < nch) SC_GLOAD(c + 1);
            if (c >= 1) SC_YOUT(c - 1);
            if (c + 1 < nch) SC_LSTORE(c + 1);
        } else {
            const LAS unsigned char* ib = lds + OFF_IN + (c & 1) * IN_BYTES;
            const LAS unsigned char* pa = ib + kq * 16;
            const LAS unsigned char* pw = ib + 512 + kq * 16;
            const LAS unsigned char* pv = ib + (320 + RW * part + rl) * 4;
            const LAS unsigned char* sb = lds + OFF_SC2 + (c & 1) * CT * 8;
            LAS unsigned char* yb = lds + OFF_Y + (c & 1) * Y_BYTES + rl * 4;
            f32x4 aw01 = *(const LAS f32x4*)(pa), aw23 = *(const LAS f32x4*)(pa + 256), b4 = *(const LAS f32x4*)(pw + 256), k4 = *(const LAS f32x4*)(pw + 512);
            float v1 = *(const LAS float*)(pv); f32x2 bk = *(const LAS f32x2*)(sb);
            for (int blk = 0; blk < CT / 16; ++blk) {
                float yk0 = 0.f;
#pragma unroll
                for (int j = 0; j < 16; ++j) {
                    const int tok = blk * 16 + j, tn = (tok + 1 < CT) ? tok + 1 : tok;
                    const f32x4 naw01 = *(const LAS f32x4*)(pa + tn * 1536), naw23 = *(const LAS f32x4*)(pa + tn * 1536 + 256),
                                nb4 = *(const LAS f32x4*)(pw + tn * 1536 + 256), nk4 = *(const LAS f32x4*)(pw + tn * 1536 + 512);
                    const float nv1 = *(const LAS float*)(pv + tn * 1536); const f32x2 nbk = *(const LAS f32x2*)(sb + tn * 8);
                    const f32x2 a0 = {aw01[0], aw01[1]}, a1 = {aw01[2], aw01[3]}, a2 = {aw23[0], aw23[1]}, a3 = {aw23[2], aw23[3]};
                    const f32x2 pqa = a0 * s0[0] + a1 * s0[1], pqb = a2 * s0[2] + a3 * s0[3];
                    const f32x2 pq0 = pqa + pqb;
                    const f32x4 e0 = s0 + k4 * v1;
                    float p0 = pq0[0], q0 = pq0[1];
                    asm volatile("s_nop 1\n\t"
                        "v_add_f32_dpp %0, %0, %0 quad_perm:[1,0,3,2] row_mask:0xf bank_mask:0xf\n\t"
                        "v_add_f32_dpp %1, %1, %1 quad_perm:[1,0,3,2] row_mask:0xf bank_mask:0xf\n\t"
                        "s_nop 0\n\t"
                        "v_add_f32_dpp %0, %0, %0 quad_perm:[2,3,0,1] row_mask:0xf bank_mask:0xf\n\t"
                        "v_add_f32_dpp %1, %1, %1 quad_perm:[2,3,0,1] row_mask:0xf bank_mask:0xf\n\t"
                        "s_nop 0\n\t"
                        "v_add_f32_dpp %0, %0, %0 row_half_mirror row_mask:0xf bank_mask:0xf\n\t"
                        "v_add_f32_dpp %1, %1, %1 row_half_mirror row_mask:0xf bank_mask:0xf\n\t"
                        "s_nop 0\n\t"
                        "v_add_f32_dpp %0, %0, %0 row_mirror row_mask:0xf bank_mask:0xf\n\t"
                        "v_add_f32_dpp %1, %1, %1 row_mirror row_mask:0xf bank_mask:0xf\n\t"
                        "s_nop 1"
                        : "+v"(p0), "+v"(q0));
                    s0 = e0 + b4 * p0;
                    const float y0 = q0 + p0 * bk[0] + v1 * bk[1];
                    yk0 = (kq == j) ? y0 : yk0;
                    aw01 = naw01; aw23 = naw23; b4 = nb4; k4 = nk4; v1 = nv1; bk = nbk;
                }
                *(LAS float*)(yb + (blk * 16 + kq) * (RW * 4)) = yk0;
            }
            s0 = s0 * *(const LAS f32x4*)(pw + (CT - 1) * 1536);
        }
        __syncthreads();
    }
    if (stager) SC_YOUT(nch - 1);
#undef SC_GLOAD
#undef SC_LSTORE
#undef SC_YOUT
    __syncthreads();
}
}

constexpr int N_SCAN_WG = 64, N_ATT_UNITS = 1024;
__device__ __forceinline__ void phase_mix(KP p, int l, LAS unsigned char* lds) {
    KP_FENCE(p);
    if ((PH & 256) && (int)blockIdx.x < N_SCAN_WG) { scan::run(p, blockIdx.x, lds); if (DUP & 8) scan::run(p, blockIdx.x, lds); }
    LAS int* qword = (LAS int*)(lds + LDS_MISC);
    for (int rep = 0; rep < ((DUP & 16) ? 2 : 1); ++rep) {
    unsigned* ctr = (unsigned*)(p->ws + WS_CTL) + l + 2 * rep;
    for (;;) {
        if (threadIdx.x == 0) *qword = (int)atomicAdd(ctr, 1u);
        __syncthreads();
        const int n = *qword;
        __syncthreads();
        if (n >= N_ATT_UNITS) break;
        if (PH & 512) att::unit(p, n & 15, 63 - (n >> 4), lds);
    }
    }
}

__device__ __forceinline__ void phase_gn(KP p, int l) {
    KP_FENCE(p);
    int tid = threadIdx.x; asm volatile("" : "+v"(tid));
    const int lane = tid & 63, wave = tid >> 6, c = tid;
    bf16_t* MIX = (bf16_t*)(p->ws + WS_MIX); const bf16_t* U = (const bf16_t*)(p->ws + WS_U); const bf16_t* SCAN = (const bf16_t*)(p->ws + WS_SCAN); const float* SC2 = (const float*)(p->ws + WS_SC2);
    const float g = p->gn_g[l * 512 + c], bta = p->gn_b[l * 512 + c];
    for (int t0 = blockIdx.x * 8; t0 < T; t0 += gridDim.x * 8) {
        unsigned short yr[8], vr[8], gr[8]; float rk[8];
#pragma unroll
        for (int i = 0; i < 8; ++i) { const size_t t = t0 + i; yr[i] = MIX[t * DM + 1536 + c]; vr[i] = SCAN[(t * 8 + wave) * 384 + 320 + lane]; rk[i] = SC2[(t * 8 + wave) * 4 + 2]; gr[i] = U[t * LDU + C_RG + c]; }
#pragma unroll
        for (int i = 0; i < 8; ++i) { const size_t t = t0 + i; const float y = bf2f(yr[i]);
            const float mean = wave_sum(y) * (1.f / 64.f); const float d = y - mean; const float var = wave_sum(d * d) * (1.f / 64.f);
            const float yn = d * rsqrtf(var + GN_EPS) * g + bta + rk[i] * bf2f(vr[i]);
            MIX[t * DM + 1536 + c] = (bf16_t)f2bf(yn * silu_f(bf2f(gr[i]))); }
    }
}

__device__ __forceinline__ void phase_ln(KP p, int l, bool write_xb) {
    KP_FENCE(p);
    const float* res = (l == 0) ? p->x : p->out;
    int tid = threadIdx.x; asm volatile("" : "+v"(tid));
    const int lane = tid & 63, wave = tid >> 6;
    bf16_t* xb = (bf16_t*)(p->ws + WS_XB);
    f32x4 g[8], bb[8];
#pragma unroll
    for (int i = 0; i < 8; ++i) { g[i] = *(const f32x4*)(p->ln_g + l * DM + (i * 64 + lane) * 4); bb[i] = *(const f32x4*)(p->ln_b + l * DM + (i * 64 + lane) * 4); }
    const int rstr = gridDim.x * 8;
    int row = blockIdx.x * 8 + wave;
    u32x2 vn[8];
#pragma unroll
    for (int i = 0; i < 8; ++i) vn[i] = *(const u32x2*)(xb + (size_t)row * DM + (i * 64 + lane) * 4);
    f32x4 rn[8];
#pragma unroll
    for (int i = 0; i < 8; ++i) rn[i] = *(const f32x4*)(res + (size_t)row * DM + (i * 64 + lane) * 4);
    for (; row < T; row += rstr) {
        float* rp = p->out + (size_t)row * DM;
        f32x4 v[8]; float s = 0.f;
#pragma unroll
        for (int i = 0; i < 8; ++i) { v[i][0] = __uint_as_float(vn[i].x << 16); v[i][1] = __uint_as_float(vn[i].x & 0xffff0000u); v[i][2] = __uint_as_float(vn[i].y << 16); v[i][3] = __uint_as_float(vn[i].y & 0xffff0000u);
            v[i] = rn[i] * ALPHA + v[i]; s += v[i][0] + v[i][1] + v[i][2] + v[i][3]; }
        if (row + rstr < T) {
#pragma unroll
            for (int i = 0; i < 8; ++i) { vn[i] = *(const u32x2*)(xb + (size_t)(row + rstr) * DM + (i * 64 + lane) * 4); rn[i] = *(const f32x4*)(res + (size_t)(row + rstr) * DM + (i * 64 + lane) * 4); }
        }
        const float mean = wave_sum(s) * (1.f / DM);
        float q = 0.f;
#pragma unroll
        for (int i = 0; i < 8; ++i) { v[i] = v[i] - mean; q += v[i][0] * v[i][0] + v[i][1] * v[i][1] + v[i][2] * v[i][2] + v[i][3] * v[i][3]; }
        const float rstd = rsqrtf(wave_sum(q) * (1.f / DM) + LN_EPS);
#pragma unroll
        for (int i = 0; i < 8; ++i) { const f32x4 y = v[i] * rstd * g[i] + bb[i]; *(f32x4*)(rp + (i * 64 + lane) * 4) = y;
            if (write_xb) { u32x2 wv; wv.x = pk2(y[0], y[1]); wv.y = pk2(y[2], y[3]); *(u32x2*)(xb + (size_t)row * DM + (i * 64 + lane) * 4) = wv; } }
    }
}

#define XB_TMO      128
#define XB_XCNT(j)  (256  + 64 * (j))
#define XB_XSUB(j)  (1280 + 64 * (j))
#define XB_XGEN(j)  (2304 + 64 * (j))
#define XB_TOP      3328
#define XB_TOPGEN   3392
#define XCD_BAR_WORDS 3456
#define XB_SPIN_CAP (1u << 22)
constexpr int CW_BAR = 4096;
__device__ __forceinline__ unsigned xb_ld(unsigned* p)              { return __hip_atomic_load(p, __ATOMIC_RELAXED, __HIP_MEMORY_SCOPE_AGENT); }
__device__ __forceinline__ unsigned xb_add(unsigned* p, unsigned v) { return __hip_atomic_fetch_add(p, v, __ATOMIC_RELAXED, __HIP_MEMORY_SCOPE_AGENT); }
__device__ __forceinline__ unsigned xb_xcc_id() { return (unsigned)__builtin_amdgcn_s_getreg((3 << 11) | 20) & 0xFu; }
#define XB_SPIN(cond, bar) do { unsigned _sp = 0; while (cond) { __builtin_amdgcn_s_sleep(1); \
    if ((++_sp & 255u) == 0u) { if (xb_ld(&(bar)[XB_TMO])) break; if (_sp > XB_SPIN_CAP) { atomicAdd(&(bar)[XB_TMO], 1u); break; } } } } while (0)
struct XcdBarrier { unsigned* bar; unsigned x; volatile LAS unsigned* st; };
__device__ __forceinline__ XcdBarrier xcd_barrier_post(unsigned* bar, volatile LAS unsigned* st) {
    XcdBarrier b; b.bar = bar; b.x = xb_xcc_id(); b.st = st;
    if (threadIdx.x == 0) (void)xb_add(&bar[XB_XCNT(b.x)], 1u);
    return b;
}
__device__ __forceinline__ void xcd_barrier_complete(unsigned* bar, unsigned x, unsigned& nloc, unsigned& nx) {
    const unsigned G = gridDim.x * gridDim.y * gridDim.z;
    unsigned sum, cnt, mine, sp = 0u;
    for (;;) {
        sum = 0u; cnt = 0u; mine = 0u;
#pragma unroll
        for (unsigned j = 0; j < 16; ++j) { const unsigned c = xb_ld(&bar[XB_XCNT(j)]); sum += c; cnt += (c > 0u) ? 1u : 0u; mine = (j == x) ? c : mine; }
        if (sum == G) break;
        __builtin_amdgcn_s_sleep(1);
        if ((++sp & 255u) == 0u) { if (xb_ld(&bar[XB_TMO])) break; if (sp > XB_SPIN_CAP) { atomicAdd(&bar[XB_TMO], 1u); break; } }
    }
    nloc = mine > 0u ? mine : 1u; nx = cnt > 0u ? cnt : 1u;
}
__device__ __forceinline__ void xcd_barrier(const XcdBarrier& b) {
    asm volatile("s_waitcnt vmcnt(0)" ::: "memory");
    __syncthreads();
    if (threadIdx.x == 0) {
        unsigned* bar = b.bar;
        __builtin_amdgcn_s_waitcnt(0);
        unsigned nloc = b.st[0], nx = b.st[1];
        if (nloc == 0u) { xcd_barrier_complete(bar, b.x, nloc, nx); b.st[0] = nloc; b.st[1] = nx; }
        const unsigned old = xb_add(&bar[XB_XSUB(b.x)], 1u);
        const unsigned gen = old / nloc;
        if (old + 1u == (gen + 1u) * nloc) {
            __builtin_amdgcn_fence(__ATOMIC_RELEASE, "agent");
            asm volatile("s_waitcnt vmcnt(0)" ::: "memory");
            const unsigned og = xb_add(&bar[XB_TOP], 1u);
            const unsigned tg = og / nx;
            if (og + 1u == (tg + 1u) * nx) xb_add(&bar[XB_TOPGEN], 1u);
            else XB_SPIN(xb_ld(&bar[XB_TOPGEN]) == tg, bar);
            __builtin_amdgcn_fence(__ATOMIC_ACQUIRE, "agent");
            xb_add(&bar[XB_XGEN(b.x)], 1u);
            asm volatile("s_waitcnt vmcnt(0)" ::: "memory");
        } else {
            XB_SPIN(xb_ld(&bar[XB_XGEN(b.x)]) == gen, bar);
            __builtin_amdgcn_fence(__ATOMIC_ACQUIRE, "agent");
            asm volatile("s_waitcnt vmcnt(0)" ::: "memory");
        }
    }
    __syncthreads();
}

#define PHASE_FENCE() do { __builtin_amdgcn_sched_barrier(0); asm volatile("" ::: "memory"); __syncthreads(); __builtin_amdgcn_sched_barrier(0); } while (0)
__global__ void __launch_bounds__(512, 2) fwd_megakernel(Params p_in) {
    KP p = (KP)__builtin_amdgcn_kernarg_segment_ptr();
    extern __shared__ __attribute__((aligned(16))) unsigned char smem[];
    LAS unsigned char* lds = (LAS unsigned char*)smem;
    cg::grid_group grid = cg::this_grid();
    const int G = gridDim.x;
    bf16_t* U = (bf16_t*)(p->ws + WS_U); bf16_t* XB = (bf16_t*)(p->ws + WS_XB); bf16_t* MIX = (bf16_t*)(p->ws + WS_MIX);
    float* RSQ = (float*)(p->ws + WS_RS); float* RSKV = RSQ + T;

    unsigned long long* tsb = (unsigned long long*)(p->ws + WS_CTL + 1024);
    int nts = 0;
#define TSTAMP() do { if (TPROBE >= 0) { if (blockIdx.x == 0 && threadIdx.x == 0) tsb[nts] = __builtin_amdgcn_s_memrealtime(); ++nts; } } while (0)
    TSTAMP();
    if (threadIdx.x < 2) ((volatile LAS unsigned*)(lds + LDS_MISC + 32))[threadIdx.x] = 0u;
    __syncthreads();
    if (PH & 1) phase_p0(p, lds);
    grid.sync(); TSTAMP();
    const XcdBarrier xbar = xcd_barrier_post((unsigned*)(p->ws + WS_CTL) + CW_BAR, (volatile LAS unsigned*)(lds + LDS_MISC + 32));
#define GRID_SYNC() xcd_barrier(xbar)
    for (int l = 0; l < DEPTH; ++l) {
        for (int rep = 0; rep < ((DUP & 1) ? 2 : 1); ++rep)
        if (PH & 2) { pg8::Gemm g{XB, (const bf16_t*)(p->ws + WS_WIN), T, LDU, DM, DM, DM}; pg8::StaticOrder S; S.init(T, LDU, G, (int)blockIdx.x);
          pg8::EpiU E{U, LDU}; pg8::gemm_phase(lds, g, S, E); }
        GRID_SYNC(); TSTAMP();
        for (int rep = 0; rep < ((DUP & 2) ? 2 : 1); ++rep)
        if (PH & 4) phase_prep(p, l, lds);
        GRID_SYNC(); TSTAMP();
        for (int rep = 0; rep < ((DUP & 4) ? 2 : 1); ++rep) {
        PHASE_FENCE();
        if (PH & 8) { pg8::Gemm g{U + C_CQ, (const bf16_t*)(p->ws + WS_WUQ), T, 1536, 512, LDU, 512}; pg8::StaticOrder S; S.init(T, 1536, G, (int)blockIdx.x);
          pg8::EpiQ E{(bf16_t*)(p->ws + WS_Q), RSQ, (const float*)(p->ws + WS_COS), (const float*)(p->ws + WS_SIN)}; pg8::gemm_phase(lds, g, S, E); }
        PHASE_FENCE();
        if (PH & 1024) { pg8::Gemm g{U + C_CKV, (const bf16_t*)(p->ws + WS_WUK), T, 1024, 256, LDU, 256}; pg8::StaticOrder S; S.init(T, 1024, G, (int)blockIdx.x);
          pg8::EpiRowScale E{(bf16_t*)(p->ws + WS_KN), 1024, RSKV, 1.f}; pg8::gemm_phase(lds, g, S, E); }
        PHASE_FENCE();
        if (PH & 2048) { pg8::Gemm g{(const bf16_t*)(p->ws + WS_WUV), U + C_CKV, 1024, T, 256, 256, LDU}; pg8::StaticOrder S; S.init(1024, T, G, (int)blockIdx.x);
          pg8::EpiColScale E{(bf16_t*)(p->ws + WS_VT), T, RSKV}; pg8::gemm_phase(lds, g, S, E); }
        }
        GRID_SYNC(); TSTAMP();
        if (PH & 16) phase_mix(p, l, lds);
        GRID_SYNC(); TSTAMP();
        if (PH & 32) phase_gn(p, l);
        GRID_SYNC(); TSTAMP();
        for (int rep = 0; rep < (((DUP & 32) && l == 0) ? 2 : 1); ++rep)
        if (PH & 64) { pg8::Gemm g{MIX, (const bf16_t*)(p->ws + WS_WOUT), T, DM, DM, DM, DM}; pg8::StaticOrder S; S.init(T, DM, G, (int)blockIdx.x);
          pg8::EpiU E{XB, DM}; pg8::gemm_phase(lds, g, S, E); }
        GRID_SYNC(); TSTAMP();
        if (PH & 128) phase_ln(p, l, l + 1 < DEPTH);
        if (l + 1 < DEPTH) { if (PH & 1) convert_weights(p, l + 1, lds); GRID_SYNC(); TSTAMP(); }
    }
    if (TPROBE >= 0) {
        if (blockIdx.x == 0 && threadIdx.x == 0) {
            __threadfence();
            const unsigned long long d = tsb[TPROBE + 1] - tsb[TPROBE];
            const unsigned long long t0 = __builtin_amdgcn_s_memrealtime();
            while (__builtin_amdgcn_s_memrealtime() - t0 < 8ull * d) __builtin_amdgcn_s_sleep(8);
        }
        grid.sync();
    }
}

extern "C" void kernel_launch(void* const* d_in, const int* in_sizes, int n_in, void* d_out, int out_size, void* d_ws, size_t ws_size, hipStream_t stream) {
    static int grid = 0;
    if (grid == 0) {
        if (n_in != 21 || ws_size < WS_END) { fprintf(stderr, "kernel_launch: unexpected n_in %d or ws_size %zu (need %zu)\n", n_in, ws_size, (size_t)WS_END); grid = -1; return; }
        int dev = 0, cus = 0, per_cu = 0;
        hipGetDevice(&dev); hipDeviceGetAttribute(&cus, hipDeviceAttributeMultiprocessorCount, dev);
        if (hipFuncSetAttribute((const void*)fwd_megakernel, hipFuncAttributeMaxDynamicSharedMemorySize, LDS_BYTES) != hipSuccess) { fprintf(stderr, "kernel_launch: hipFuncSetAttribute failed\n"); grid = -1; return; }
        if (hipOccupancyMaxActiveBlocksPerMultiprocessor(&per_cu, (const void*)fwd_megakernel, 512, LDS_BYTES) != hipSuccess || per_cu < 1) { fprintf(stderr, "kernel_launch: occupancy query gave %d\n", per_cu); per_cu = 1; }
        (void)hipGetLastError();
        grid = cus * per_cu;
    }
    if (grid < 0) return;
    Params p{};
    p.x = (const float*)d_in[0]; p.pos = (const int*)d_in[1]; p.w_in = (const float*)d_in[2]; p.conv_w = (const float*)d_in[3]; p.q_norm_g = (const float*)d_in[4];
    p.w_uq = (const float*)d_in[5]; p.kv_norm_g = (const float*)d_in[6]; p.w_ukv = (const float*)d_in[7]; p.mu = (const float*)d_in[8]; p.w0 = (const float*)d_in[9];
    p.w2 = (const float*)d_in[10]; p.a0 = (const float*)d_in[11]; p.a2 = (const float*)d_in[12]; p.k_k = (const float*)d_in[13]; p.k_a = (const float*)d_in[14];
    p.r_k = (const float*)d_in[15]; p.gn_g = (const float*)d_in[16]; p.gn_b = (const float*)d_in[17]; p.w_out = (const float*)d_in[18]; p.ln_g = (const float*)d_in[19]; p.ln_b = (const float*)d_in[20];
    p.out = (float*)d_out; p.ws = (unsigned char*)d_ws;
    for (int j = 0; j < 32; ++j) p.inv_freq[j] = (float)pow(10000.0, -(double)(2 * j) / 64.0);
    void* args[] = {&p};
    hipError_t e = hipLaunchCooperativeKernel((const void*)fwd_megakernel, dim3(grid), dim3(512), args, LDS_BYTES, stream);
    if (e != hipSuccess) fprintf(stderr, "cooperative launch failed: %s (grid %d)\n", hipGetErrorString(e), grid);
}
```

```cpp
#include <hip/hip_runtime.h>
#include <hip/hip_cooperative_groups.h>
#include <cstdio>
#include <cstdint>
#include <cmath>
namespace cg = cooperative_groups;

#define LAS __attribute__((address_space(3)))
typedef unsigned short bf16_t;
typedef short bf16x8 __attribute__((ext_vector_type(8)));
typedef short s16x4 __attribute__((ext_vector_type(4)));
typedef float f32x4 __attribute__((ext_vector_type(4)));
typedef float f32x2 __attribute__((ext_vector_type(2)));
typedef float f32x16 __attribute__((ext_vector_type(16)));
typedef unsigned u32x4 __attribute__((ext_vector_type(4)));
typedef unsigned u32x2 __attribute__((ext_vector_type(2)));
typedef __bf16 bf16x2_t __attribute__((ext_vector_type(2)));

constexpr int T = 32768, SEQ = 16384, DM = 2048, NIN = 6080, LDU = 6144, DEPTH = 2;
constexpr int C_CB = 0, C_CC = 512, C_CH = 1024, C_CG = 1536, C_CQ = 2048, C_CKV = 2560, C_KPE = 2816, C_MG = 2880, C_RC = 3904, C_RG = 5568;
constexpr int NHEAD = 8;
constexpr float LN_EPS = 1e-5f, RMS_EPS = 1e-6f, GN_EPS = 64e-5f;
constexpr float ALPHA = 1.4142135623730951f;
constexpr float QSCALE = 0.07216878364870323f * 1.4426950408889634f;

constexpr size_t MiB = 1u << 20;
constexpr size_t WS_CTL = 0, WS_WIN = 1 * MiB, WS_WOUT = 25 * MiB, WS_WUQ = 33 * MiB, WS_WUK = 35 * MiB, WS_WUV = 36 * MiB, WS_RS = 37 * MiB,
                 WS_SC2 = 38 * MiB, WS_COS = 42 * MiB, WS_SIN = 46 * MiB, WS_U = 50 * MiB, WS_MIX = 434 * MiB, WS_XB = 562 * MiB, WS_Q = 562 * MiB,
                 WS_KPE = 658 * MiB, WS_KN = 690 * MiB, WS_VT = 754 * MiB, WS_SCAN = 818 * MiB, WS_END = 1010 * MiB;

constexpr int LDS_BYTES = 131072 + 256, LDS_MISC = 131072;

struct Params {
    const float* x; const int* pos; const float* w_in; const float* conv_w; const float* q_norm_g; const float* w_uq; const float* kv_norm_g; const float* w_ukv;
    const float* mu; const float* w0; const float* w2; const float* a0; const float* a2; const float* k_k; const float* k_a; const float* r_k; const float* gn_g; const float* gn_b;
    const float* w_out; const float* ln_g; const float* ln_b;
    float* out; unsigned char* ws;
    float inv_freq[32];
};

typedef const __attribute__((address_space(4))) Params* KP;
#define KP_FENCE(p) asm volatile("" : "+s"(p))
__device__ __forceinline__ float bf2f(unsigned short v) { return __uint_as_float(((unsigned)v) << 16); }
__device__ __forceinline__ unsigned f2bf(float f) { unsigned u = __float_as_uint(f); return (u + 0x7fffu + ((u >> 16) & 1u)) >> 16; }
__device__ __forceinline__ unsigned pk2(float lo, float hi) { f32x2 v = {lo, hi}; bf16x2_t b = __builtin_convertvector(v, bf16x2_t); return __builtin_bit_cast(unsigned, b); }
__device__ __forceinline__ float max3f(float a, float b, float c) { float r; asm("v_max3_f32 %0, %1, %2, %3" : "=v"(r) : "v"(a), "v"(b), "v"(c)); return r; }
__device__ __forceinline__ float silu_f(float x) { return x * __builtin_amdgcn_rcpf(1.f + __expf(-x)); }
__device__ __forceinline__ float dppf(float v, int ctrl) { return v; }
template <int CTRL> __device__ __forceinline__ float dpp_mov(float v) { return __int_as_float(__builtin_amdgcn_update_dpp(__float_as_int(v), __float_as_int(v), CTRL, 0xf, 0xf, false)); }
__device__ __forceinline__ float row16_sum(float v) {
    v += dpp_mov<0xB1>(v);
    v += dpp_mov<0x4E>(v);
    v += dpp_mov<0x141>(v);
    v += dpp_mov<0x140>(v);
    return v;
}
__device__ __forceinline__ float wave_sum(float v) { v = row16_sum(v); v += __shfl_xor(v, 16); v += __shfl_xor(v, 32); return v; }

#ifndef PH
#define PH 0xffff
#endif
#ifndef TPROBE
#define TPROBE -1
#endif
#ifndef DUP
#define DUP 0
#endif
namespace pg8 {
constexpr int BM = 256, BK = 64, HALF = 128, HTB = HALF * BK * 2, STAGE_BYTES = 8 * HTB, NXCD = 8, WGM = 8;
__host__ __device__ __forceinline__ int lds_byte(int r, int c) { const int st = (r >> 4) * 2 + (c >> 5), rr = r & 15, cc = c & 31, ob = rr * 64 + cc * 2; return st * 1024 + (ob ^ (((ob >> 9) & 1) << 5)); }
__host__ __device__ __forceinline__ void stage_rc(int b, int& R, int& C) { const int st = b / 1024, sb = b % 1024, swz = sb ^ (((sb >> 9) & 1) << 5); R = (st >> 1) * 16 + swz / 64; C = (st & 1) * 32 + (swz % 64) / 2; }
__host__ __device__ __forceinline__ int perm32(int rho) { const int n = rho >> 4, i = rho & 15; return 8 * (i >> 2) + 4 * n + (i & 3); }
struct Unit { int pm, pn; };
struct Gemm { const bf16_t* A; const bf16_t* Bt; int M, N, K, lda, ldb; };
struct StaticOrder {
    int nM, nN, nwg, G, c;
    __device__ void init(int M, int N, int G_, int c_) { nM = M / BM; nN = N / BM; nwg = nM * nN; G = G_; c = c_; }
    __device__ bool next(int i, Unit& u) const {
        const long L = (long)i * G + c; if (L >= nwg) return false;
        int wgid = (int)L; { const int q = nwg / NXCD, r = nwg % NXCD, xcd = wgid % NXCD, off = wgid / NXCD; wgid = (xcd < r ? xcd * (q + 1) : r * (q + 1) + (xcd - r) * q) + off; }
        const int nig = WGM * nN, gid = wgid / nig, fm = gid * WGM, gsz = (nM - fm) < WGM ? (nM - fm) : WGM;
        u.pm = fm + ((wgid % nig) % gsz); u.pn = (wgid % nig) / gsz; return true;
    }
};
template <class Epi>
__device__ __forceinline__ void gemm_phase(LAS unsigned char* lds, const Gemm g, const StaticOrder& S, const Epi& E) {
    int tid = threadIdx.x; asm volatile("" : "+v"(tid));
    const int wid = __builtin_amdgcn_readfirstlane(tid >> 6), lane = tid & 63, wr = wid >> 2, wc = wid & 3, fr = lane & 15, fq = lane >> 4;
    int K = g.K; asm volatile("" : "+s"(K));
    const int nt = K / BK;
    unsigned voffA[2], voffB[2];
#pragma unroll
    for (int i = 0; i < 2; ++i) { int R, C; stage_rc(tid * 16 + i * 8192, R, C); const int Rb = Epi::PERM ? ((R & ~31) + perm32(R & 31)) : R;
        voffA[i] = (unsigned)(R * g.lda + C) * 2u; voffB[i] = (unsigned)(Rb * g.ldb + C) * 2u; }
    const size_t kstep = (size_t)(BK * 2);
    const size_t hstepA = (size_t)HALF * g.lda * 2, hstepB = (size_t)HALF * g.ldb * 2;
    const size_t tstepA = 2 * hstepA, tstepB = 2 * hstepB;
    const unsigned ldsw = (unsigned)wid * 1024u;
    const int aoff = lds_byte(wr * 64 + fr, fq * 8), boff = lds_byte(wc * 32 + fr, fq * 8);
#define PG8_SA(b, h) (((b) * 2 + (h)) * HTB)
#define PG8_SB(b, h) ((4 + (b) * 2 + (h)) * HTB)
#define PG8_STAGE(bufoff, gbase, voff) do { _Pragma("unroll") for (int _i = 0; _i < 2; ++_i) \
        __builtin_amdgcn_global_load_lds((const unsigned*)((const char*)(gbase) + (voff)[_i]), (LAS unsigned*)(lds + (bufoff) + ldsw + _i * 8192), 16, 0, 0); } while (0)
#define PG8_LDA(dst, b, h) do { _Pragma("unroll") for (int m = 0; m < 4; ++m) _Pragma("unroll") for (int k = 0; k < 2; ++k) dst[m][k] = *(const LAS bf16x8*)(lds + PG8_SA(b, h) + aoff + m * 2048 + k * 1024); } while (0)
#define PG8_LDB(dst, b, h) do { _Pragma("unroll") for (int n = 0; n < 2; ++n) _Pragma("unroll") for (int k = 0; k < 2; ++k) dst[n][k] = *(const LAS bf16x8*)(lds + PG8_SB(b, h) + boff + n * 2048 + k * 1024); } while (0)
#define PG8_MMA(ai, bj, At, Bt) do { __builtin_amdgcn_s_setprio(1); _Pragma("unroll") for (int m = 0; m < 4; ++m) _Pragma("unroll") for (int n = 0; n < 2; ++n) _Pragma("unroll") for (int k = 0; k < 2; ++k) \
        acc[ai][bj][m][n] = __builtin_amdgcn_mfma_f32_16x16x32_bf16(Bt[n][k], At[m][k], acc[ai][bj][m][n], 0, 0, 0); __builtin_amdgcn_s_setprio(0); } while (0)
#define PG8_WAIT_V(n) asm volatile("s_waitcnt vmcnt(" #n ")" ::: "memory")
#define PG8_WAIT_L(n) asm volatile("s_waitcnt lgkmcnt(" #n ")" ::: "memory")
#define PG8_BAR __builtin_amdgcn_s_barrier()
#define PG8_SCHED __builtin_amdgcn_sched_barrier(0)
    Unit cur, nxt; int ui = 0;
    if (!S.next(0, cur)) return;
    f32x4 acc[2][2][4][2];
#pragma unroll
    for (int a = 0; a < 2; ++a)
#pragma unroll
        for (int b = 0; b < 2; ++b)
#pragma unroll
            for (int m = 0; m < 4; ++m)
#pragma unroll
                for (int n = 0; n < 2; ++n) acc[a][b][m][n] = (f32x4){0.f, 0.f, 0.f, 0.f};
    bf16x8 At[4][2], B0[2][2], B1[2][2];
    const char* cA = (const char*)g.A + (size_t)cur.pm * tstepA; const char* cB = (const char*)g.Bt + (size_t)cur.pn * tstepB;
    PG8_STAGE(PG8_SB(0, 0), cB, voffB); PG8_STAGE(PG8_SB(0, 1), cB + hstepB, voffB); PG8_STAGE(PG8_SA(0, 0), cA, voffA); PG8_STAGE(PG8_SA(0, 1), cA + hstepA, voffA);
    if (wr == 1) PG8_BAR;
    PG8_WAIT_V(2); PG8_BAR;
    PG8_STAGE(PG8_SB(1, 0), cB + kstep, voffB); PG8_STAGE(PG8_SA(1, 0), cA + kstep, voffA); PG8_STAGE(PG8_SB(1, 1), cB + hstepB + kstep, voffB);
    PG8_WAIT_V(6); PG8_BAR;
    for (;;) {
        const bool has_next = S.next(ui + 1, nxt);
        const char* nA = has_next ? (const char*)g.A + (size_t)nxt.pm * tstepA : cA; const char* nB = has_next ? (const char*)g.Bt + (size_t)nxt.pn * tstepB : cB;
        for (int t = 0; t < nt; t += 2) {
            const bool last = (t == nt - 2);
            const char* a1 = cA + (size_t)(t + 1) * kstep;
            const char* a2 = last ? nA : cA + (size_t)(t + 2) * kstep; const char* b2 = last ? nB : cB + (size_t)(t + 2) * kstep;
            const char* a3 = a2 + kstep; const char* b3 = b2 + kstep;
            PG8_LDB(B0, 0, 0); PG8_LDB(B1, 0, 1); PG8_SCHED; PG8_LDA(At, 0, 0); PG8_STAGE(PG8_SA(1, 1), a1 + hstepA, voffA);
            PG8_WAIT_V(8); PG8_WAIT_L(0); PG8_BAR; PG8_MMA(0, 0, At, B0); PG8_MMA(0, 1, At, B1); PG8_BAR; PG8_SCHED;
            PG8_LDA(At, 0, 1); PG8_STAGE(PG8_SB(0, 0), b2, voffB); PG8_STAGE(PG8_SB(0, 1), b2 + hstepB, voffB); PG8_STAGE(PG8_SA(0, 0), a2, voffA);
            PG8_WAIT_V(8); PG8_WAIT_L(0); PG8_BAR; PG8_MMA(1, 0, At, B0); PG8_MMA(1, 1, At, B1); PG8_BAR; PG8_SCHED;
            PG8_LDB(B0, 1, 0); PG8_LDB(B1, 1, 1); PG8_SCHED; PG8_LDA(At, 1, 0); PG8_STAGE(PG8_SA(0, 1), a2 + hstepA, voffA);
            PG8_WAIT_V(8); PG8_WAIT_L(0); PG8_BAR; PG8_MMA(0, 0, At, B0); PG8_MMA(0, 1, At, B1); PG8_BAR; PG8_SCHED;
            PG8_LDA(At, 1, 1); PG8_STAGE(PG8_SB(1, 0), b3, voffB); PG8_STAGE(PG8_SB(1, 1), b3 + hstepB, voffB); PG8_STAGE(PG8_SA(1, 0), a3, voffA);
            PG8_WAIT_V(8); PG8_WAIT_L(0); PG8_BAR; PG8_MMA(1, 0, At, B0); PG8_MMA(1, 1, At, B1); PG8_BAR; PG8_SCHED;
        }
        if (wr == 0) PG8_BAR;
        E(acc, cur, wr, wc, fr, fq);
        if (!has_next) break;
#pragma unroll
        for (int a = 0; a < 2; ++a)
#pragma unroll
            for (int b = 0; b < 2; ++b)
#pragma unroll
                for (int m = 0; m < 4; ++m)
#pragma unroll
                    for (int n = 0; n < 2; ++n) acc[a][b][m][n] = (f32x4){0.f, 0.f, 0.f, 0.f};
        cur = nxt; cA = nA; cB = nB; ++ui;
        if (wr == 1) PG8_BAR;
    }
    PG8_WAIT_V(0);
    PG8_BAR;
#undef PG8_SA
#undef PG8_SB
#undef PG8_STAGE
#undef PG8_LDA
#undef PG8_LDB
#undef PG8_MMA
#undef PG8_WAIT_V
#undef PG8_WAIT_L
#undef PG8_BAR
#undef PG8_SCHED
}

struct EpiU {
    static constexpr bool PERM = true;
    bf16_t* O; int ldc;
    __device__ __forceinline__ void operator()(const f32x4 (&acc)[2][2][4][2], const Unit& u, int wr, int wc, int fr, int fq) const {
        const int row0 = u.pm * BM + wr * 64 + fr, col0 = u.pn * BM + wc * 32 + 8 * fq;
#pragma unroll
        for (int ai = 0; ai < 2; ++ai)
#pragma unroll
            for (int m = 0; m < 4; ++m) { bf16_t* rowp = O + (size_t)(row0 + ai * HALF + m * 16) * ldc + col0;
#pragma unroll
                for (int bj = 0; bj < 2; ++bj) { const f32x4 v0 = acc[ai][bj][m][0], v1 = acc[ai][bj][m][1];
                    u32x4 w; w.x = pk2(v0[0], v0[1]); w.y = pk2(v0[2], v0[3]); w.z = pk2(v1[0], v1[1]); w.w = pk2(v1[2], v1[3]);
                    *(u32x4*)(rowp + bj * HALF) = w; }
                asm volatile("" ::: "memory"); }
    }
};
struct EpiRowScale {
    static constexpr bool PERM = true;
    bf16_t* O; int ldc; const float* rs; float sc;
    __device__ __forceinline__ void operator()(const f32x4 (&acc)[2][2][4][2], const Unit& u, int wr, int wc, int fr, int fq) const {
        const int row0 = u.pm * BM + wr * 64 + fr, col0 = u.pn * BM + wc * 32 + 8 * fq;
#pragma unroll
        for (int ai = 0; ai < 2; ++ai)
#pragma unroll
            for (int m = 0; m < 4; ++m) { const int row = row0 + ai * HALF + m * 16; const float s = rs[row] * sc; bf16_t* rowp = O + (size_t)row * ldc + col0;
#pragma unroll
                for (int bj = 0; bj < 2; ++bj) { const f32x4 v0 = acc[ai][bj][m][0] * s, v1 = acc[ai][bj][m][1] * s;
                    u32x4 w; w.x = pk2(v0[0], v0[1]); w.y = pk2(v0[2], v0[3]); w.z = pk2(v1[0], v1[1]); w.w = pk2(v1[2], v1[3]);
                    *(u32x4*)(rowp + bj * HALF) = w; }
                asm volatile("" ::: "memory"); }
    }
};
struct EpiQ {
    static constexpr bool PERM = true;
    bf16_t* O; const float* rs; const float* cosT; const float* sinT;
    __device__ __forceinline__ void operator()(const f32x4 (&acc)[2][2][4][2], const Unit& u, int wr, int wc, int fr, int fq) const {
        const int row0 = u.pm * BM + wr * 64 + fr, col0 = u.pn * BM + wc * 32 + 8 * fq;
#pragma unroll
        for (int ai = 0; ai < 2; ++ai)
#pragma unroll
            for (int m = 0; m < 4; ++m) { const int row = row0 + ai * HALF + m * 16; const float s = rs[row] * QSCALE; bf16_t* rowp = O + (size_t)row * 1536 + col0;
#pragma unroll
                for (int bj = 0; bj < 2; ++bj) { f32x4 v0 = acc[ai][bj][m][0] * s, v1 = acc[ai][bj][m][1] * s;
                    const int cin = (col0 + bj * HALF) % 192;
                    if (cin >= 128) { const int j0 = (cin - 128) >> 1;
                        const f32x4 c = *(const f32x4*)(cosT + (size_t)row * 32 + j0), sn = *(const f32x4*)(sinT + (size_t)row * 32 + j0);
                        f32x4 r0, r1;
                        r0[0] = v0[0] * c[0] - v0[1] * sn[0]; r0[1] = v0[1] * c[0] + v0[0] * sn[0];
                        r0[2] = v0[2] * c[1] - v0[3] * sn[1]; r0[3] = v0[3] * c[1] + v0[2] * sn[1];
                        r1[0] = v1[0] * c[2] - v1[1] * sn[2]; r1[1] = v1[1] * c[2] + v1[0] * sn[2];
                        r1[2] = v1[2] * c[3] - v1[3] * sn[3]; r1[3] = v1[3] * c[3] + v1[2] * sn[3];
                        v0 = r0; v1 = r1; }
                    u32x4 w; w.x = pk2(v0[0], v0[1]); w.y = pk2(v0[2], v0[3]); w.z = pk2(v1[0], v1[1]); w.w = pk2(v1[2], v1[3]);
                    *(u32x4*)(rowp + bj * HALF) = w; }
                asm volatile("" ::: "memory"); }
    }
};
struct EpiColScale {
    static constexpr bool PERM = true;
    bf16_t* O; int ldc; const float* cs;
    __device__ __forceinline__ void operator()(const f32x4 (&acc)[2][2][4][2], const Unit& u, int wr, int wc, int fr, int fq) const {
        const int row0 = u.pm * BM + wr * 64 + fr, col0 = u.pn * BM + wc * 32 + 8 * fq;
        const int pos0 = (col0 & ~15) + 4 * ((col0 >> 3) & 1);
        f32x4 sv[2][2];
#pragma unroll
        for (int bj = 0; bj < 2; ++bj)
#pragma unroll
            for (int n = 0; n < 2; ++n) sv[bj][n] = *(const f32x4*)(cs + col0 + bj * HALF + 4 * n);
#pragma unroll
        for (int ai = 0; ai < 2; ++ai)
#pragma unroll
            for (int m = 0; m < 4; ++m) { bf16_t* rowp = O + (size_t)(row0 + ai * HALF + m * 16) * ldc + pos0;
#pragma unroll
                for (int bj = 0; bj < 2; ++bj) { const f32x4 v0 = acc[ai][bj][m][0] * sv[bj][0], v1 = acc[ai][bj][m][1] * sv[bj][1];
                    u32x2 w0, w1; w0.x = pk2(v0[0], v0[1]); w0.y = pk2(v0[2], v0[3]); w1.x = pk2(v1[0], v1[1]); w1.y = pk2(v1[2], v1[3]);
                    *(u32x2*)(rowp + bj * HALF) = w0; *(u32x2*)(rowp + bj * HALF + 8) = w1; }
                asm volatile("" ::: "memory"); }
    }
};
struct EpiResB16 {
    static constexpr bool PERM = true;
    bf16_t* O; const float* res;
    __device__ __forceinline__ void operator()(const f32x4 (&acc)[2][2][4][2], const Unit& u, int wr, int wc, int fr, int fq) const {
        const int row0 = u.pm * BM + wr * 64 + fr, col0 = u.pn * BM + wc * 32 + 8 * fq;
#pragma unroll
        for (int ai = 0; ai < 2; ++ai)
#pragma unroll
            for (int m = 0; m < 4; ++m) { const size_t ro = (size_t)(row0 + ai * HALF + m * 16) * DM + col0;
#pragma unroll
                for (int bj = 0; bj < 2; ++bj) { const f32x4 r0 = *(const f32x4*)(res + ro + bj * HALF), r1 = *(const f32x4*)(res + ro + bj * HALF + 4);
                    const f32x4 v0 = r0 * ALPHA + acc[ai][bj][m][0], v1 = r1 * ALPHA + acc[ai][bj][m][1];
                    u32x4 w; w.x = pk2(v0[0], v0[1]); w.y = pk2(v0[2], v0[3]); w.z = pk2(v1[0], v1[1]); w.w = pk2(v1[2], v1[3]);
                    *(u32x4*)(O + ro + bj * HALF) = w; }
                asm volatile("" ::: "memory"); }
    }
};
struct EpiRes {
    static constexpr bool PERM = false;
    float* C; const float* res;
    __device__ __forceinline__ void operator()(const f32x4 (&acc)[2][2][4][2], const Unit& u, int wr, int wc, int fr, int fq) const {
        const int row0 = u.pm * BM + wr * 64 + fr, col0 = u.pn * BM + wc * 32 + 4 * fq;
#pragma unroll
        for (int ai = 0; ai < 2; ++ai)
#pragma unroll
            for (int m = 0; m < 4; ++m) { const size_t ro = (size_t)(row0 + ai * HALF + m * 16) * DM + col0;
#pragma unroll
                for (int bj = 0; bj < 2; ++bj)
#pragma unroll
                    for (int n = 0; n < 2; ++n) { const f32x4 r = *(const f32x4*)(res + ro + bj * HALF + n * 16);
                        *(f32x4*)(C + ro + bj * HALF + n * 16) = r * ALPHA + acc[ai][bj][m][n]; } }
    }
};
}

__device__ __forceinline__ int wmap_col(int kind, int n) {
    if (kind == 0) return n < NIN ? n : -1;
    if (kind == 1) return n;
    if (kind == 2) { const int h = n / 192, c = n % 192; if (c < 128) return n; const int j = (c - 128) >> 1, e = (c - 128) & 1; return h * 192 + 128 + j + 32 * e; }
    if (kind == 3) { const int h = n >> 7, c = n & 127; return h * 256 + c; }
    { const int h = n >> 7, c = n & 127; return h * 256 + 128 + c; }
}
__device__ __forceinline__ void convert_weights(KP p, int l, LAS unsigned char* lds) {
    KP_FENCE(p);
    int tid = threadIdx.x; asm volatile("" : "+v"(tid));
    const int tx = tid & 63, ty = tid >> 6;
    LAS float* tile = (LAS float*)lds;
    const int nK[5] = {32, 32, 8, 4, 4}, nN[5] = {96, 32, 24, 16, 16};
    const int start1 = nK[0] * nN[0], start2 = start1 + nK[1] * nN[1], start3 = start2 + nK[2] * nN[2], start4 = start3 + nK[3] * nN[3], total = start4 + nK[4] * nN[4];
    for (int it = blockIdx.x; it < total; it += gridDim.x) {
        int kind, loc;
        if (it < start1) { kind = 0; loc = it; } else if (it < start2) { kind = 1; loc = it - start1; } else if (it < start3) { kind = 2; loc = it - start2; }
        else if (it < start4) { kind = 3; loc = it - start3; } else { kind = 4; loc = it - start4; }
        const float* src; bf16_t* dst; const float* g = nullptr; int K, Nsrc, nnt;
        if (kind == 0) { src = p->w_in + (size_t)l * DM * NIN; dst = (bf16_t*)(p->ws + WS_WIN); K = 2048; Nsrc = NIN; nnt = 96; }
        else if (kind == 1) { src = p->w_out + (size_t)l * DM * DM; dst = (bf16_t*)(p->ws + WS_WOUT); K = 2048; Nsrc = DM; nnt = 32; }
        else if (kind == 2) { src = p->w_uq + (size_t)l * 512 * 1536; dst = (bf16_t*)(p->ws + WS_WUQ); K = 512; Nsrc = 1536; nnt = 24; g = p->q_norm_g + l * 512; }
        else if (kind == 3) { src = p->w_ukv + (size_t)l * 256 * 2048; dst = (bf16_t*)(p->ws + WS_WUK); K = 256; Nsrc = 2048; nnt = 16; g = p->kv_norm_g + l * 256; }
        else { src = p->w_ukv + (size_t)l * 256 * 2048; dst = (bf16_t*)(p->ws + WS_WUV); K = 256; Nsrc = 2048; nnt = 16; g = p->kv_norm_g + l * 256; }
        const int n0 = (loc % nnt) * 64, k0 = (loc / nnt) * 64;
        const int sc = wmap_col(kind, n0 + tx);
#pragma unroll
        for (int i = 0; i < 8; ++i) { const int k = k0 + ty * 8 + i; float v = 0.f; if (sc >= 0) v = src[(size_t)k * Nsrc + sc]; if (g) v *= g[k]; tile[(ty * 8 + i) * 65 + tx] = v; }
        __syncthreads();
#pragma unroll
        for (int i = 0; i < 8; ++i) { const int n = n0 + ty * 8 + i; dst[(size_t)n * K + k0 + tx] = (bf16_t)f2bf(tile[tx * 65 + ty * 8 + i]); }
        __syncthreads();
    }
}

__device__ __forceinline__ void phase_p0(KP p, LAS unsigned char* lds) {
    KP_FENCE(p);
    const int tid = threadIdx.x;
    if (blockIdx.x == 0) { unsigned* ctl = (unsigned*)(p->ws + WS_CTL); for (int i = tid; i < 16384; i += 512) ctl[i] = 0u; }
    convert_weights(p, 0, lds);
    bf16_t* xb = (bf16_t*)(p->ws + WS_XB);
    const size_t n4 = (size_t)T * DM / 4;
    const size_t xstr = (size_t)gridDim.x * 512;
    for (size_t i0 = (size_t)blockIdx.x * 512 + tid; i0 < n4; i0 += xstr * 8) {
        f32x4 v[8];
#pragma unroll
        for (int k = 0; k < 8; ++k) v[k] = *(const f32x4*)(p->x + (i0 + k * xstr) * 4);
#pragma unroll
        for (int k = 0; k < 8; ++k) { u32x2 w; w.x = pk2(v[k][0], v[k][1]); w.y = pk2(v[k][2], v[k][3]); *(u32x2*)(xb + (i0 + k * xstr) * 4) = w; } }
    float* cosT = (float*)(p->ws + WS_COS); float* sinT = (float*)(p->ws + WS_SIN);
    for (int i = blockIdx.x * 512 + tid; i < T * 32; i += gridDim.x * 512) {
        const int t = i >> 5, j = i & 31;
        const float ang = (float)p->pos[t] * p->inv_freq[j];
        double rev = (double)ang * 0.15915494309189535; rev -= rint(rev);
        cosT[i] = __builtin_amdgcn_cosf((float)rev); sinT[i] = __builtin_amdgcn_sinf((float)rev);
    }
}

__device__ __forceinline__ void phase_prep(KP p, int l, LAS unsigned char* lds) {
    KP_FENCE(p);
    int tid = threadIdx.x; asm volatile("" : "+v"(tid));
    const int lane = tid & 63, wave = tid >> 6, c = tid;
    const bf16_t* U = (const bf16_t*)(p->ws + WS_U);
    bf16_t* MIX = (bf16_t*)(p->ws + WS_MIX); bf16_t* KPEB = (bf16_t*)(p->ws + WS_KPE); bf16_t* SCAN = (bf16_t*)(p->ws + WS_SCAN);
    float* SC2 = (float*)(p->ws + WS_SC2); float* RSQ = (float*)(p->ws + WS_RS); float* RSKV = RSQ + T;
    const float* cosT = (const float*)(p->ws + WS_COS); const float* sinT = (const float*)(p->ws + WS_SIN);
    LAS float* sth = (LAS float*)lds;
    LAS float* spart = (LAS float*)(lds + 8192);
    f32x2 war[64];
#pragma unroll
    for (int j = 0; j < 64; ++j) { war[j][0] = p->w2[(size_t)l * 64 * 512 + j * 512 + c]; war[j][1] = p->a2[(size_t)l * 64 * 512 + j * 512 + c]; }
    const float* mu = p->mu + l * 1664;
    const float mu_r = mu[c], mu_k = mu[576 + c], mu_v = mu[1088 + c];
    const float w0c = p->w0[l * 512 + c], a0c = p->a0[l * 512 + c], kkc = p->k_k[l * 512 + c], kac = p->k_a[l * 512 + c], rkc = p->r_k[l * 512 + c];
    const float cw0 = p->conv_w[(l * 3 + 0) * 512 + c], cw1 = p->conv_w[(l * 3 + 1) * 512 + c], cw2 = p->conv_w[(l * 3 + 2) * 512 + c];
    for (int tile = blockIdx.x; tile < T / 128; tile += gridDim.x) {
        const int t0 = tile * 128; const bool first = (t0 % SEQ) == 0;
        float pr = 0.f, pk = 0.f, pv = 0.f, pu1 = 0.f, pu2 = 0.f, Gc = 1.f;
        if (!first) { const bf16_t* up = U + (size_t)(t0 - 1) * LDU; pr = bf2f(up[C_RC + c]); pk = bf2f(up[C_RC + 576 + c]); pv = bf2f(up[C_RC + 1088 + c]);
            pu1 = bf2f(up[C_CC + c]) * bf2f(up[C_CH + c]); const bf16_t* up2 = up - LDU; pu2 = bf2f(up2[C_CC + c]) * bf2f(up2[C_CH + c]); }
        const int s_tok0 = tid >> 7, s_jj = tid & 127, s_cr = (s_jj < 64) ? (512 + s_jj) : (1600 + s_jj - 64); const float s_mu = mu[s_cr];
        unsigned short sc_[2], sp_[2];
#define PREP_STAGE_LOAD(tb_) do { _Pragma("unroll") for (int i = 0; i < 2; ++i) { const int t = (tb_) + s_tok0 + 4 * i; \
            sc_[i] = U[(size_t)t * LDU + C_RC + s_cr]; sp_[i] = (t % SEQ) == 0 ? (unsigned short)0 : U[(size_t)(t - 1) * LDU + C_RC + s_cr]; } } while (0)
#define PREP_STAGE_STORE(buf_) do { _Pragma("unroll") for (int i = 0; i < 2; ++i) { const float cur = bf2f(sc_[i]), prev = bf2f(sp_[i]); float xv = cur + (prev - cur) * s_mu; \
            if (s_jj < 64) { const float e = __expf(2.f * xv); xv = 1.f - 2.f * __builtin_amdgcn_rcpf(e + 1.f); } sth[(buf_) * 1024 + (s_tok0 + 4 * i) * 128 + 2 * (s_jj & 63) + (s_jj >> 6)] = xv; } } while (0)
        PREP_STAGE_LOAD(t0); PREP_STAGE_STORE(0);
        __syncthreads();
        for (int sb = 0; sb < 16; ++sb) {
            const int tb = t0 + sb * 8; const LAS float* sthb = sth + (sb & 1) * 1024;
            if (sb + 1 < 16) PREP_STAGE_LOAD(tb + 8);
            unsigned short kx1 = 0, kx2 = 0; float kcs = 0.f, ksn = 0.f;
            if (tid < 256) { const int tok = tid >> 5, j = tid & 31, t = tb + tok; const bf16_t* ur = U + (size_t)t * LDU + C_KPE; kx1 = ur[j]; kx2 = ur[32 + j]; kcs = cosT[t * 32 + j]; ksn = sinT[t * 32 + j]; }
            for (int g4 = 0; g4 < 2; ++g4) {
                unsigned short raw[4][9];
#pragma unroll
                for (int i = 0; i < 4; ++i) { const bf16_t* ur = U + (size_t)(tb + g4 * 4 + i) * LDU;
                    raw[i][0] = ur[C_RC + c]; raw[i][1] = ur[C_RC + 576 + c]; raw[i][2] = ur[C_RC + 1088 + c]; raw[i][3] = ur[C_CB + c]; raw[i][4] = ur[C_CC + c]; raw[i][5] = ur[C_CH + c];
                    raw[i][6] = ur[C_CG + c]; raw[i][7] = ur[C_CQ + c]; raw[i][8] = (c < 256) ? ur[C_CKV + c] : (unsigned short)0; }
#pragma unroll
                for (int i = 0; i < 4; ++i) {
                    const int tok = g4 * 4 + i, t = tb + tok;
                    const float ur_ = bf2f(raw[i][0]), uk_ = bf2f(raw[i][1]), uv_ = bf2f(raw[i][2]);
                    const float cb = bf2f(raw[i][3]), cc = bf2f(raw[i][4]), ch = bf2f(raw[i][5]), cgt = bf2f(raw[i][6]);
                    const float cq = bf2f(raw[i][7]); const float ckv = bf2f(raw[i][8]);
                    const float uc = cc * ch; const float yc = cw0 * pu2 + cw1 * pu1 + cw2 * uc; pu2 = pu1; pu1 = uc;
                    MIX[(size_t)t * DM + c] = (bf16_t)f2bf(cb * yc * silu_f(cgt));
                    const float sq = wave_sum(cq * cq), skv = wave_sum(ckv * ckv);
                    if (lane == 0) { spart[(sb * 8 + tok) * 12 + wave] = sq; if (wave < 4) spart[(sb * 8 + tok) * 12 + 8 + wave] = skv; }
                    const float r = ur_ + (pr - ur_) * mu_r, k = uk_ + (pk - uk_) * mu_k, v = uv_ + (pv - uv_) * mu_v; pr = ur_; pk = uk_; pv = uv_;
                    f32x2 zz0 = {w0c, a0c}, zz1 = {0.f, 0.f};
#pragma unroll
                    for (int j2 = 0; j2 < 32; ++j2) { const f32x4 ta = *(const LAS f32x4*)(sthb + tok * 128 + j2 * 4);
                        const f32x2 x0 = {ta[0], ta[1]}, x1 = {ta[2], ta[3]};
                        zz0 += x0 * war[2 * j2]; zz1 += x1 * war[2 * j2 + 1]; }
                    const float zw = zz0[0] + zz1[0], za = zz0[1] + zz1[1];
                    const float sp = fmaxf(-zw, 0.f) + __logf(1.f + __expf(-fabsf(zw)));
                    const float wlog = -sp - 0.5f; const float dec = __expf(-__expf(wlog));
                    const float asig = __builtin_amdgcn_rcpf(1.f + __expf(-za));
                    const float kkr = k * kkc; const float kk = kkr * __builtin_amdgcn_rsqf(fmaxf(wave_sum(kkr * kkr), 1e-24f));
                    const float k2 = k * (1.f + (asig - 1.f) * kac);
                    const float av = -kk, bv = kk * asig;
                    const float br = wave_sum(bv * r), kr = wave_sum(k2 * r), rkb = wave_sum(r * k2 * rkc);
                    const float Gprev = ((t & 31) == 0) ? 1.f : Gc; Gc = Gprev * dec; const float Ginv = __builtin_amdgcn_rcpf(Gc);
                    bf16_t* so = SCAN + ((size_t)t * 8 + wave) * 384 + lane;
                    *(unsigned*)(so + lane) = pk2(av * Gprev, r * Gc);
                    so[128] = (bf16_t)f2bf(Gc); so[192] = (bf16_t)f2bf(bv * Ginv); so[256] = (bf16_t)f2bf(k2 * Ginv); so[320] = (bf16_t)f2bf(v);
                    if (lane == 0) { f32x4 o4 = {br, kr, rkb, 0.f}; *(f32x4*)(SC2 + ((size_t)t * 8 + wave) * 4) = o4; }
                }
            }
            if (tid < 256) { const int tok = tid >> 5, j = tid & 31, t = tb + tok; const float x1 = bf2f(kx1), x2 = bf2f(kx2);
                *(unsigned*)(KPEB + (size_t)t * 64 + 2 * j) = pk2(x1 * kcs - x2 * ksn, x2 * kcs + x1 * ksn); }
            if (sb + 1 < 16) PREP_STAGE_STORE((sb + 1) & 1);
            __syncthreads();
        }
#undef PREP_STAGE_LOAD
#undef PREP_STAGE_STORE
        if (tid < 128) { float sq = 0.f, skv = 0.f;
#pragma unroll
            for (int w = 0; w < 8; ++w) sq += spart[tid * 12 + w];
#pragma unroll
            for (int w = 0; w < 4; ++w) skv += spart[tid * 12 + 8 + w];
            RSQ[t0 + tid] = rsqrtf(sq * (1.f / 512.f) + RMS_EPS); RSKV[t0 + tid] = rsqrtf(skv * (1.f / 256.f) + RMS_EPS); }
        __syncthreads();
    }
}

namespace att {
constexpr int KNROW = 272, KPROW = 144, VROW = 144, KN_BYTES = 64 * KNROW, KP_BYTES = 64 * KPROW, V_BYTES = 128 * VROW;
constexpr int OFF_KN = 0, OFF_KP = 2 * KN_BYTES, OFF_V = OFF_KP + 2 * KP_BYTES;
constexpr int NI_KN = 17, NI_KP = 9, NI_V = 18, NI_K = NI_KN + NI_KP, NI_ALL = NI_K + NI_V;
__device__ __forceinline__ void unit(KP p, int bh, int qb, LAS unsigned char* lds) {
    KP_FENCE(p);
    int tid = threadIdx.x; asm volatile("" : "+v"(tid));
    const int lane = tid & 63, w = __builtin_amdgcn_readfirstlane(tid >> 6), ql = lane & 31, hi = lane >> 5, grp = w >> 2;
    const int b = bh >> 3, h = bh & 7, q0 = qb * 256;
    const bf16_t* Q = (const bf16_t*)(p->ws + WS_Q); const bf16_t* KN = (const bf16_t*)(p->ws + WS_KN); const bf16_t* KPEB = (const bf16_t*)(p->ws + WS_KPE);
    const bf16_t* VT = (const bf16_t*)(p->ws + WS_VT); const bf16_t* U = (const bf16_t*)(p->ws + WS_U); bf16_t* MIX = (bf16_t*)(p->ws + WS_MIX);
    const int qpos = q0 + 32 * w + ql; const size_t tq = (size_t)b * SEQ + qpos;
    const int wqmin = q0 + 32 * w, wqmax = wqmin + 31;
    bf16x8 qf[12];
    { const bf16_t* qp = Q + tq * 1536 + h * 192 + 8 * hi;
#pragma unroll
      for (int ks = 0; ks < 12; ++ks) qf[ks] = *(const bf16x8*)(qp + 16 * ks); }
    f32x16 o[4];
#pragma unroll
    for (int d = 0; d < 4; ++d)
#pragma unroll
        for (int i = 0; i < 16; ++i) o[d][i] = 0.f;
    f32x16 st0, st1;
#pragma unroll
    for (int i = 0; i < 16; ++i) { st0[i] = 0.f; st1[i] = 0.f; }
    bf16x8 pf[4];
#pragma unroll
    for (int i = 0; i < 4; ++i) pf[i] = (bf16x8){0, 0, 0, 0, 0, 0, 0, 0};
    float mrow = -1e30f, lsum = 0.f;
    const int nj = 4 * (qb + 1);
    int doff[11];
    const bf16_t* kn0 = KN + (size_t)b * SEQ * 1024 + h * 128; const bf16_t* kp0 = KPEB + (size_t)b * SEQ * 64; const bf16_t* vt0 = VT + (size_t)h * 128 * T + (size_t)b * SEQ;
#pragma unroll
    for (int i = 0; i < 11; ++i) { const int n = (w & 3) + 4 * i;
        if (n < NI_KN) { const int ci = 64 * n + lane, row = ci / 17, col = ci % 17; doff[i] = row * 1024 + 8 * (col < 15 ? col : 15); }
        else if (n < NI_K) { const int ci = 64 * (n - NI_KN) + lane, row = ci / 9, col = ci % 9; doff[i] = row * 64 + 8 * (col < 7 ? col : 7); }
        else { const int ci = 64 * (n - NI_K) + lane, row = ci / 9, col = ci % 9; doff[i] = row * T + 8 * (col < 7 ? col : 7); } }
#define ATT_DMA(tk, tv) do { if (grp) { _Pragma("unroll") for (int i = 0; i < 11; ++i) { const int n = (w & 3) + 4 * i; \
        if (n < NI_KN) { if ((tk) >= 0 && (tk) < nj) __builtin_amdgcn_global_load_lds((const unsigned*)(kn0 + (size_t)(tk) * 65536 + doff[i]), (LAS unsigned*)(lds + OFF_KN + ((tk) & 1) * KN_BYTES + n * 1024), 16, 0, 0); } \
        else if (n < NI_K) { if ((tk) >= 0 && (tk) < nj) __builtin_amdgcn_global_load_lds((const unsigned*)(kp0 + (size_t)(tk) * 4096 + doff[i]), (LAS unsigned*)(lds + OFF_KP + ((tk) & 1) * KP_BYTES + (n - NI_KN) * 1024), 16, 0, 0); } \
        else if (n < NI_ALL) { if ((tv) >= 0 && (tv) < nj) __builtin_amdgcn_global_load_lds((const unsigned*)(vt0 + (size_t)(tv) * 64 + doff[i]), (LAS unsigned*)(lds + OFF_V + ((tv) & 1) * V_BYTES + (n - NI_K) * 1024), 16, 0, 0); } } } } while (0)
#define ATT_BAR() do { asm volatile("s_waitcnt lgkmcnt(0)" ::: "memory"); __builtin_amdgcn_s_barrier(); } while (0)
#define ATT_WAITV() asm volatile("s_waitcnt vmcnt(0)" ::: "memory")
#define ATT_SOFTMAX(j_) do { const int kt0 = 64 * (j_); \
        if (kt0 <= wqmax) { \
            if (kt0 + 63 > wqmin) { \
                _Pragma("unroll") for (int i = 0; i < 16; ++i) { const int key = kt0 + 8 * (i >> 2) + 4 * hi + (i & 3); if (key > qpos) st0[i] = -1e30f; if (key + 32 > qpos) st1[i] = -1e30f; } } \
            float mx = max3f(st0[0], st1[0], st0[1]), mx2 = max3f(st1[1], st0[2], st1[2]);     \
            _Pragma("unroll") for (int i = 3; i < 15; i += 2) { mx = max3f(mx, st0[i], st1[i]); mx2 = max3f(mx2, st0[i + 1], st1[i + 1]); } \
            mx = max3f(mx, st0[15], st1[15]); mx = fmaxf(mx, mx2); \
            { const auto sw = __builtin_amdgcn_permlane32_swap(__float_as_uint(mx), __float_as_uint(mx), false, false); mx = fmaxf(__uint_as_float(sw[0]), __uint_as_float(sw[1])); }     \
            const float mnew = fmaxf(mrow, mx); const float alpha = __builtin_amdgcn_exp2f(mrow - mnew); mrow = mnew; \
            float ps = 0.f; \
            _Pragma("unroll") for (int i = 0; i < 16; ++i) { st0[i] = __builtin_amdgcn_exp2f(st0[i] - mnew); st1[i] = __builtin_amdgcn_exp2f(st1[i] - mnew); ps += st0[i] + st1[i]; } \
            lsum = lsum * alpha + ps; \
            if (__builtin_amdgcn_ballot_w64(alpha != 1.f) != 0ull) {     \
                _Pragma("unroll") for (int d = 0; d < 4; ++d) _Pragma("unroll") for (int i = 0; i < 16; ++i) o[d][i] *= alpha; } \
            _Pragma("unroll") for (int s2 = 0; s2 < 2; ++s2) { u32x4 pw; \
                pw.x = pk2(st0[8 * s2 + 0], st0[8 * s2 + 1]); pw.y = pk2(st0[8 * s2 + 2], st0[8 * s2 + 3]); pw.z = pk2(st0[8 * s2 + 4], st0[8 * s2 + 5]); pw.w = pk2(st0[8 * s2 + 6], st0[8 * s2 + 7]); \
                pf[s2] = __builtin_bit_cast(bf16x8, pw); \
                pw.x = pk2(st1[8 * s2 + 0], st1[8 * s2 + 1]); pw.y = pk2(st1[8 * s2 + 2], st1[8 * s2 + 3]); pw.z = pk2(st1[8 * s2 + 4], st1[8 * s2 + 5]); pw.w = pk2(st1[8 * s2 + 6], st1[8 * s2 + 7]); \
                pf[2 + s2] = __builtin_bit_cast(bf16x8, pw); } \
        } } while (0)
#define ATT_PV(j_) do { if (64 * (j_) <= wqmax) { \
            const LAS unsigned char* vb = lds + OFF_V + ((j_) & 1) * V_BYTES + ql * VROW + 16 * hi; \
            bf16x8 vf[5]; \
            _Pragma("unroll") for (int it = 0; it < 4; ++it) vf[it] = *(const LAS bf16x8*)(vb + (it & 3) * 32 * VROW + 32 * (it >> 2)); \
            _Pragma("unroll") for (int it = 0; it < 16; ++it) { const int d = it & 3, s2 = it >> 2;     \
                if (it + 4 < 16) { const int d2 = (it + 4) & 3, s22 = (it + 4) >> 2; vf[(it + 4) % 5] = *(const LAS bf16x8*)(vb + d2 * 32 * VROW + 32 * s22); } \
                o[d] = __builtin_amdgcn_mfma_f32_32x32x16_bf16(vf[it % 5], pf[s2], o[d], 0, 0, 0); \
                __builtin_amdgcn_sched_barrier(0); } \
        } } while (0)
#define ATT_KADDR(ks_) (((ks_) < 8) ? (kb + 32 * (ks_)) : (kpb + 32 * ((ks_) - 8)))
#define ATT_KROWB(ks_) (((ks_) < 8) ? 32 * KNROW : 32 * KPROW)
#define ATT_QK(j_) do { if (64 * (j_) <= wqmax) { \
            const f32x16 zero16 = {0.f, 0.f, 0.f, 0.f, 0.f, 0.f, 0.f, 0.f, 0.f, 0.f, 0.f, 0.f, 0.f, 0.f, 0.f, 0.f}; \
            const LAS unsigned char* kb = lds + OFF_KN + ((j_) & 1) * KN_BYTES + ql * KNROW + 16 * hi; \
            const LAS unsigned char* kpb = lds + OFF_KP + ((j_) & 1) * KP_BYTES + ql * KPROW + 16 * hi; \
            bf16x8 kf0[3], kf1[3]; \
            kf0[0] = *(const LAS bf16x8*)(ATT_KADDR(0)); kf1[0] = *(const LAS bf16x8*)(ATT_KADDR(0) + ATT_KROWB(0)); \
            kf0[1] = *(const LAS bf16x8*)(ATT_KADDR(1)); kf1[1] = *(const LAS bf16x8*)(ATT_KADDR(1) + ATT_KROWB(1)); \
            _Pragma("unroll") for (int ks = 0; ks < 12; ++ks) { \
                if (ks + 2 < 12) { kf0[(ks + 2) % 3] = *(const LAS bf16x8*)(ATT_KADDR(ks + 2)); kf1[(ks + 2) % 3] = *(const LAS bf16x8*)(ATT_KADDR(ks + 2) + ATT_KROWB(ks + 2)); } \
                st0 = __builtin_amdgcn_mfma_f32_32x32x16_bf16(kf0[ks % 3], qf[ks], ks == 0 ? zero16 : st0, 0, 0, 0);     \
                st1 = __builtin_amdgcn_mfma_f32_32x32x16_bf16(kf1[ks % 3], qf[ks], ks == 0 ? zero16 : st1, 0, 0, 0); \
                __builtin_amdgcn_sched_barrier(0); } \
        } } while (0)
    ATT_DMA(0, -1);
    ATT_WAITV();
    __builtin_amdgcn_s_barrier();
    if (grp == 0) {
        ATT_DMA(1, 0); ATT_QK(0); ATT_BAR();
        for (int j = 0; j < nj; ++j) {
            ATT_SOFTMAX(j); ATT_WAITV(); ATT_BAR();
            ATT_DMA(j + 2, j + 1); ATT_PV(j); if (j + 1 < nj) ATT_QK(j + 1); ATT_BAR();
        }
        ATT_WAITV(); ATT_BAR();
    } else {
        ATT_DMA(1, 0); ATT_BAR();
        for (int j = 0; j < nj; ++j) {
            if (j >= 1) ATT_PV(j - 1); ATT_QK(j); ATT_WAITV(); ATT_BAR();
            ATT_DMA(j + 2, j + 1); ATT_SOFTMAX(j); ATT_BAR();
        }
        ATT_PV(nj - 1); ATT_WAITV(); ATT_BAR();
    }
#undef ATT_SOFTMAX
#undef ATT_PV
#undef ATT_QK
#undef ATT_KADDR
#undef ATT_KROWB
#undef ATT_BAR
#undef ATT_WAITV
#undef ATT_DMA
    const float ltot = lsum + __shfl_xor(lsum, 32); const float inv = 1.f / ltot;
    const bf16_t* gp = U + tq * LDU + C_MG + h * 128; bf16_t* op = MIX + tq * DM + 512 + h * 128;
    u32x2 gwv[16];
#pragma unroll
    for (int d = 0; d < 4; ++d)
#pragma unroll
        for (int g4 = 0; g4 < 4; ++g4) gwv[d * 4 + g4] = *(const u32x2*)(gp + 32 * d + 8 * g4 + 4 * hi);
#pragma unroll
    for (int d = 0; d < 4; ++d)
#pragma unroll
        for (int g4 = 0; g4 < 4; ++g4) { const int dv0 = 32 * d + 8 * g4 + 4 * hi;
            const u32x2 gw = gwv[d * 4 + g4];
            const float g0 = __uint_as_float(gw.x << 16), g1 = __uint_as_float(gw.x & 0xffff0000u), g2 = __uint_as_float(gw.y << 16), g3 = __uint_as_float(gw.y & 0xffff0000u);
            u32x2 ow; ow.x = pk2(o[d][4 * g4 + 0] * inv * silu_f(g0), o[d][4 * g4 + 1] * inv * silu_f(g1)); ow.y = pk2(o[d][4 * g4 + 2] * inv * silu_f(g2), o[d][4 * g4 + 3] * inv * silu_f(g3));
            *(u32x2*)(op + dv0) = ow; }
}
}

namespace scan {
constexpr int CT = 32;
constexpr int RW = 16;
constexpr int IN_BYTES = CT * 6 * 64 * 4;
constexpr int OFF_IN = 0, OFF_SC2 = 2 * IN_BYTES, OFF_Y = OFF_SC2 + 2 * CT * 8, Y_BYTES = CT * RW * 4;
__device__ __forceinline__ void run(KP p, int wg, LAS unsigned char* lds) {
    KP_FENCE(p);
    int tid = threadIdx.x; asm volatile("" : "+v"(tid));
    const int lane = tid & 63, w = __builtin_amdgcn_readfirstlane(tid >> 6);
    const int bh = wg >> 2, part = wg & 3, b = bh >> 3, h = bh & 7;
    const bf16_t* SCAN = (const bf16_t*)(p->ws + WS_SCAN); const float* SC2 = (const float*)(p->ws + WS_SC2); bf16_t* MIX = (bf16_t*)(p->ws + WS_MIX);
    const int nch = SEQ / CT;
    const bool stager = (w >= 4); const int stid = tid - 256;
    const int rg = lane >> 4, kq = lane & 15; const int rl = 4 * (w & 3) + rg;
    f32x4 s0 = {0.f, 0.f, 0.f, 0.f};
    u32x4 ld[6]; f32x2 ld2 = {0.f, 0.f};
#define SC_GLOAD(c) do { const size_t tb = (size_t)b * SEQ + (size_t)(c) * CT; \
        _Pragma("unroll") for (int i = 0; i < 6; ++i) { const int idx = stid + 256 * i, tok = idx / 48, pt = idx % 48; ld[i] = *(const u32x4*)(SCAN + ((tb + tok) * 8 + h) * 384 + 8 * pt); } \
        if (stid < CT) ld2 = *(const f32x2*)(SC2 + ((tb + stid) * 8 + h) * 4); } while (0)
#define SC_LSTORE(c) do { const int bo = OFF_IN + ((c) & 1) * IN_BYTES; \
        _Pragma("unroll") for (int i = 0; i < 6; ++i) { const int idx = stid + 256 * i, tok = idx / 48, pt = idx % 48; \
            f32x4 lo = {__uint_as_float(ld[i].x << 16), __uint_as_float(ld[i].x & 0xffff0000u), __uint_as_float(ld[i].y << 16), __uint_as_float(ld[i].y & 0xffff0000u)}; \
            f32x4 hi4 = {__uint_as_float(ld[i].z << 16), __uint_as_float(ld[i].z & 0xffff0000u), __uint_as_float(ld[i].w << 16), __uint_as_float(ld[i].w & 0xffff0000u)}; \
            const int o_lo = (pt < 16) ? pt * 4 : pt * 8, o_hi = (pt < 16) ? 64 + pt * 4 : pt * 8 + 4;     \
            *(LAS f32x4*)(lds + bo + (tok * 384 + o_lo) * 4) = lo; *(LAS f32x4*)(lds + bo + (tok * 384 + o_hi) * 4) = hi4; } \
        if (stid < CT) *(LAS f32x2*)(lds + OFF_SC2 + ((c) & 1) * CT * 8 + stid * 8) = ld2; } while (0)
#define SC_YOUT(c) do { const size_t tb = (size_t)b * SEQ + (size_t)(c) * CT; const int tok = stid >> 3, r2 = (stid & 7) * 2; \
        const f32x2 y2 = *(const LAS f32x2*)(lds + OFF_Y + ((c) & 1) * Y_BYTES + (tok * RW + r2) * 4); \
        *(unsigned*)(MIX + (tb + tok) * DM + 1536 + h * 64 + RW * part + r2) = pk2(y2[0], y2[1]); } while (0)
    if (stager) { SC_GLOAD(0); SC_LSTORE(0); }
    __syncthreads();
    for (int c = 0; c < nch; ++c) {
        if (stager) {
            if (c + 1 < nch) SC_GLOAD(c + 1);
            if (c >= 1) SC_YOUT(c - 1);
            if (c + 1 < nch) SC_LSTORE(c + 1);
        } else {
            const LAS unsigned char* ib = lds + OFF_IN + (c & 1) * IN_BYTES;
            const LAS unsigned char* pa = ib + kq * 16;
            const LAS unsigned char* pw = ib + 512 + kq * 16;
            const LAS unsigned char* pv = ib + (320 + RW * part + rl) * 4;
            const LAS unsigned char* sb = lds + OFF_SC2 + (c & 1) * CT * 8;
            LAS unsigned char* yb = lds + OFF_Y + (c & 1) * Y_BYTES + rl * 4;
            f32x4 aw01 = *(const LAS f32x4*)(pa), aw23 = *(const LAS f32x4*)(pa + 256), b4 = *(const LAS f32x4*)(pw + 256), k4 = *(const LAS f32x4*)(pw + 512);
            float v1 = *(const LAS float*)(pv); f32x2 bk = *(const LAS f32x2*)(sb);
            for (int blk = 0; blk < CT / 16; ++blk) {
                float yk0 = 0.f;
#pragma unroll
                for (int j = 0; j < 16; ++j) {
                    const int tok = blk * 16 + j, tn = (tok + 1 < CT) ? tok + 1 : tok;
                    const f32x4 naw01 = *(const LAS f32x4*)(pa + tn * 1536), naw23 = *(const LAS f32x4*)(pa + tn * 1536 + 256),
                                nb4 = *(const LAS f32x4*)(pw + tn * 1536 + 256), nk4 = *(const LAS f32x4*)(pw + tn * 1536 + 512);
                    const float nv1 = *(const LAS float*)(pv + tn * 1536); const f32x2 nbk = *(const LAS f32x2*)(sb + tn * 8);
                    const f32x2 a0 = {aw01[0], aw01[1]}, a1 = {aw01[2], aw01[3]}, a2 = {aw23[0], aw23[1]}, a3 = {aw23[2], aw23[3]};
                    const f32x2 pqa = a0 * s0[0] + a1 * s0[1], pqb = a2 * s0[2] + a3 * s0[3];
                    const f32x2 pq0 = pqa + pqb;
                    const f32x4 e0 = s0 + k4 * v1;
                    float p0 = pq0[0], q0 = pq0[1];
                    asm volatile("s_nop 1\n\t"
                        "v_add_f32_dpp %0, %0, %0 quad_perm:[1,0,3,2] row_mask:0xf bank_mask:0xf\n\t"
                        "v_add_f32_dpp %1, %1, %1 quad_perm:[1,0,3,2] row_mask:0xf bank_mask:0xf\n\t"
                        "s_nop 0\n\t"
                        "v_add_f32_dpp %0, %0, %0 quad_perm:[2,3,0,1] row_mask:0xf bank_mask:0xf\n\t"
                        "v_add_f32_dpp %1, %1, %1 quad_perm:[2,3,0,1] row_mask:0xf bank_mask:0xf\n\t"
                        "s_nop 0\n\t"
                        "v_add_f32_dpp %0, %0, %0 row_half_mirror row_mask:0xf bank_mask:0xf\n\t"
                        "v_add_f32_dpp %1, %1, %1 row_half_mirror row_mask:0xf bank_mask:0xf\n\t"
                        "s_nop 0\n\t"
                        "v_add_f32_dpp %0, %0, %0 row_mirror row_mask:0xf bank_mask:0xf\n\t"
                        "v_add_f32_dpp %1, %1, %1 row_mirror row_mask:0xf bank_mask:0xf\n\t"
                        "s_nop 1"
                        : "+v"(p0), "+v"(q0));
                    s0 = e0 + b4 * p0;
                    const float y0 = q0 + p0 * bk[0] + v1 * bk[1];
                    yk0 = (kq == j) ? y0 : yk0;
                    aw01 = naw01; aw23 = naw23; b4 = nb4; k4 = nk4; v1 = nv1; bk = nbk;
                }
                *(LAS float*)(yb + (blk * 16 + kq) * (RW * 4)) = yk0;
            }
            s0 = s0 * *(const LAS f32x4*)(pw + (CT - 1) * 1536);
        }
        __syncthreads();
    }
    if (stager) SC_YOUT(nch - 1);
#undef SC_GLOAD
#undef SC_LSTORE
#undef SC_YOUT
    __syncthreads();
}
}

constexpr int N_SCAN_WG = 64, N_ATT_UNITS = 1024;
__device__ __forceinline__ void phase_mix(KP p, int l, LAS unsigned char* lds) {
    KP_FENCE(p);
    if ((PH & 256) && (int)blockIdx.x < N_SCAN_WG) { scan::run(p, blockIdx.x, lds); if (DUP & 8) scan::run(p, blockIdx.x, lds); }
    LAS int* qword = (LAS int*)(lds + LDS_MISC);
    for (int rep = 0; rep < ((DUP & 16) ? 2 : 1); ++rep) {
    unsigned* ctr = (unsigned*)(p->ws + WS_CTL) + l + 2 * rep;
    for (;;) {
        if (threadIdx.x == 0) *qword = (int)atomicAdd(ctr, 1u);
        __syncthreads();
        const int n = *qword;
        __syncthreads();
        if (n >= N_ATT_UNITS) break;
        if (PH & 512) att::unit(p, n & 15, 63 - (n >> 4), lds);
    }
    }
}

__device__ __forceinline__ void phase_gn(KP p, int l) {
    KP_FENCE(p);
    int tid = threadIdx.x; asm volatile("" : "+v"(tid));
    const int lane = tid & 63, wave = tid >> 6, c = tid;
    bf16_t* MIX = (bf16_t*)(p->ws + WS_MIX); const bf16_t* U = (const bf16_t*)(p->ws + WS_U); const bf16_t* SCAN = (const bf16_t*)(p->ws + WS_SCAN); const float* SC2 = (const float*)(p->ws + WS_SC2);
    const float g = p->gn_g[l * 512 + c], bta = p->gn_b[l * 512 + c];
    for (int t0 = blockIdx.x * 8; t0 < T; t0 += gridDim.x * 8) {
        unsigned short yr[8], vr[8], gr[8]; float rk[8];
#pragma unroll
        for (int i = 0; i < 8; ++i) { const size_t t = t0 + i; yr[i] = MIX[t * DM + 1536 + c]; vr[i] = SCAN[(t * 8 + wave) * 384 + 320 + lane]; rk[i] = SC2[(t * 8 + wave) * 4 + 2]; gr[i] = U[t * LDU + C_RG + c]; }
#pragma unroll
        for (int i = 0; i < 8; ++i) { const size_t t = t0 + i; const float y = bf2f(yr[i]);
            const float mean = wave_sum(y) * (1.f / 64.f); const float d = y - mean; const float var = wave_sum(d * d) * (1.f / 64.f);
            const float yn = d * rsqrtf(var + GN_EPS) * g + bta + rk[i] * bf2f(vr[i]);
            MIX[t * DM + 1536 + c] = (bf16_t)f2bf(yn * silu_f(bf2f(gr[i]))); }
    }
}

__device__ __forceinline__ void phase_ln(KP p, int l, bool write_xb) {
    KP_FENCE(p);
    const float* res = (l == 0) ? p->x : p->out;
    int tid = threadIdx.x; asm volatile("" : "+v"(tid));
    const int lane = tid & 63, wave = tid >> 6;
    bf16_t* xb = (bf16_t*)(p->ws + WS_XB);
    f32x4 g[8], bb[8];
#pragma unroll
    for (int i = 0; i < 8; ++i) { g[i] = *(const f32x4*)(p->ln_g + l * DM + (i * 64 + lane) * 4); bb[i] = *(const f32x4*)(p->ln_b + l * DM + (i * 64 + lane) * 4); }
    const int rstr = gridDim.x * 8;
    int row = blockIdx.x * 8 + wave;
    u32x2 vn[8];
#pragma unroll
    for (int i = 0; i < 8; ++i) vn[i] = *(const u32x2*)(xb + (size_t)row * DM + (i * 64 + lane) * 4);
    f32x4 rn[8];
#pragma unroll
    for (int i = 0; i < 8; ++i) rn[i] = *(const f32x4*)(res + (size_t)row * DM + (i * 64 + lane) * 4);
    for (; row < T; row += rstr) {
        float* rp = p->out + (size_t)row * DM;
        f32x4 v[8]; float s = 0.f;
#pragma unroll
        for (int i = 0; i < 8; ++i) { v[i][0] = __uint_as_float(vn[i].x << 16); v[i][1] = __uint_as_float(vn[i].x & 0xffff0000u); v[i][2] = __uint_as_float(vn[i].y << 16); v[i][3] = __uint_as_float(vn[i].y & 0xffff0000u);
            v[i] = rn[i] * ALPHA + v[i]; s += v[i][0] + v[i][1] + v[i][2] + v[i][3]; }
        if (row + rstr < T) {
#pragma unroll
            for (int i = 0; i < 8; ++i) { vn[i] = *(const u32x2*)(xb + (size_t)(row + rstr) * DM + (i * 64 + lane) * 4); rn[i] = *(const f32x4*)(res + (size_t)(row + rstr) * DM + (i * 64 + lane) * 4); }
        }
        const float mean = wave_sum(s) * (1.f / DM);
        float q = 0.f;
#pragma unroll
        for (int i = 0; i < 8; ++i) { v[i] = v[i] - mean; q += v[i][0] * v[i][0] + v[i][1] * v[i][1] + v[i][2] * v[i][2] + v[i][3] * v[i][3]; }
        const float rstd = rsqrtf(wave_sum(q) * (1.f / DM) + LN_EPS);
#pragma unroll
        for (int i = 0; i < 8; ++i) { const f32x4 y = v[i] * rstd * g[i] + bb[i]; *(f32x4*)(rp + (i * 64 + lane) * 4) = y;
            if (write_xb) { u32x2 wv; wv.x = pk2(y[0], y[1]); wv.y = pk2(y[2], y[3]); *(u32x2*)(xb + (size_t)row * DM + (i * 64 + lane) * 4) = wv; } }
    }
}

#define XB_TMO      128
#define XB_XCNT(j)  (256  + 64 * (j))
#define XB_XSUB(j)  (1280 + 64 * (j))
#define XB_XGEN(j)  (2304 + 64 * (j))
#define XB_TOP      3328
#define XB_TOPGEN   3392
#define XCD_BAR_WORDS 3456
#define XB_SPIN_CAP (1u << 22)
constexpr int CW_BAR = 4096;
__device__ __forceinline__ unsigned xb_ld(unsigned* p)              { return __hip_atomic_load(p, __ATOMIC_RELAXED, __HIP_MEMORY_SCOPE_AGENT); }
__device__ __forceinline__ unsigned xb_add(unsigned* p, unsigned v) { return __hip_atomic_fetch_add(p, v, __ATOMIC_RELAXED, __HIP_MEMORY_SCOPE_AGENT); }
__device__ __forceinline__ unsigned xb_xcc_id() { return (unsigned)__builtin_amdgcn_s_getreg((3 << 11) | 20) & 0xFu; }
#define XB_SPIN(cond, bar) do { unsigned _sp = 0; while (cond) { __builtin_amdgcn_s_sleep(1); \
    if ((++_sp & 255u) == 0u) { if (xb_ld(&(bar)[XB_TMO])) break; if (_sp > XB_SPIN_CAP) { atomicAdd(&(bar)[XB_TMO], 1u); break; } } } } while (0)
struct XcdBarrier { unsigned* bar; unsigned x; volatile LAS unsigned* st; };
__device__ __forceinline__ XcdBarrier xcd_barrier_post(unsigned* bar, volatile LAS unsigned* st) {
    XcdBarrier b; b.bar = bar; b.x = xb_xcc_id(); b.st = st;
    if (threadIdx.x == 0) (void)xb_add(&bar[XB_XCNT(b.x)], 1u);
    return b;
}
__device__ __forceinline__ void xcd_barrier_complete(unsigned* bar, unsigned x, unsigned& nloc, unsigned& nx) {
    const unsigned G = gridDim.x * gridDim.y * gridDim.z;
    unsigned sum, cnt, mine, sp = 0u;
    for (;;) {
        sum = 0u; cnt = 0u; mine = 0u;
#pragma unroll
        for (unsigned j = 0; j < 16; ++j) { const unsigned c = xb_ld(&bar[XB_XCNT(j)]); sum += c; cnt += (c > 0u) ? 1u : 0u; mine = (j == x) ? c : mine; }
        if (sum == G) break;
        __builtin_amdgcn_s_sleep(1);
        if ((++sp & 255u) == 0u) { if (xb_ld(&bar[XB_TMO])) break; if (sp > XB_SPIN_CAP) { atomicAdd(&bar[XB_TMO], 1u); break; } }
    }
    nloc = mine > 0u ? mine : 1u; nx = cnt > 0u ? cnt : 1u;
}
__device__ __forceinline__ void xcd_barrier(const XcdBarrier& b) {
    asm volatile("s_waitcnt vmcnt(0)" ::: "memory");
    __syncthreads();
    if (threadIdx.x == 0) {
        unsigned* bar = b.bar;
        __builtin_amdgcn_s_waitcnt(0);
        unsigned nloc = b.st[0], nx = b.st[1];
        if (nloc == 0u) { xcd_barrier_complete(bar, b.x, nloc, nx); b.st[0] = nloc; b.st[1] = nx; }
        const unsigned old = xb_add(&bar[XB_XSUB(b.x)], 1u);
        const unsigned gen = old / nloc;
        if (old + 1u == (gen + 1u) * nloc) {
            __builtin_amdgcn_fence(__ATOMIC_RELEASE, "agent");
            asm volatile("s_waitcnt vmcnt(0)" ::: "memory");
            const unsigned og = xb_add(&bar[XB_TOP], 1u);
            const unsigned tg = og / nx;
            if (og + 1u == (tg + 1u) * nx) xb_add(&bar[XB_TOPGEN], 1u);
            else XB_SPIN(xb_ld(&bar[XB_TOPGEN]) == tg, bar);
            __builtin_amdgcn_fence(__ATOMIC_ACQUIRE, "agent");
            xb_add(&bar[XB_XGEN(b.x)], 1u);
            asm volatile("s_waitcnt vmcnt(0)" ::: "memory");
        } else {
            XB_SPIN(xb_ld(&bar[XB_XGEN(b.x)]) == gen, bar);
            __builtin_amdgcn_fence(__ATOMIC_ACQUIRE, "agent");
            asm volatile("s_waitcnt vmcnt(0)" ::: "memory");
        }
    }
    __syncthreads();
}

#define PHASE_FENCE() do { __builtin_amdgcn_sched_barrier(0); asm volatile("" ::: "memory"); __syncthreads(); __builtin_amdgcn_sched_barrier(0); } while (0)
__global__ void __launch_bounds__(512, 2) fwd_megakernel(Params p_in) {
    KP p = (KP)__builtin_amdgcn_kernarg_segment_ptr();
    extern __shared__ __attribute__((aligned(16))) unsigned char smem[];
    LAS unsigned char* lds = (LAS unsigned char*)smem;
    cg::grid_group grid = cg::this_grid();
    const int G = gridDim.x;
    bf16_t* U = (bf16_t*)(p->ws + WS_U); bf16_t* XB = (bf16_t*)(p->ws + WS_XB); bf16_t* MIX = (bf16_t*)(p->ws + WS_MIX);
    float* RSQ = (float*)(p->ws + WS_RS); float* RSKV = RSQ + T;

    unsigned long long* tsb = (unsigned long long*)(p->ws + WS_CTL + 1024);
    int nts = 0;
#define TSTAMP() do { if (TPROBE >= 0) { if (blockIdx.x == 0 && threadIdx.x == 0) tsb[nts] = __builtin_amdgcn_s_memrealtime(); ++nts; } } while (0)
    TSTAMP();
    if (threadIdx.x < 2) ((volatile LAS unsigned*)(lds + LDS_MISC + 32))[threadIdx.x] = 0u;
    __syncthreads();
    if (PH & 1) phase_p0(p, lds);
    grid.sync(); TSTAMP();
    const XcdBarrier xbar = xcd_barrier_post((unsigned*)(p->ws + WS_CTL) + CW_BAR, (volatile LAS unsigned*)(lds + LDS_MISC + 32));
#define GRID_SYNC() xcd_barrier(xbar)
    for (int l = 0; l < DEPTH; ++l) {
        for (int rep = 0; rep < ((DUP & 1) ? 2 : 1); ++rep)
        if (PH & 2) { pg8::Gemm g{XB, (const bf16_t*)(p->ws + WS_WIN), T, LDU, DM, DM, DM}; pg8::StaticOrder S; S.init(T, LDU, G, (int)blockIdx.x);
          pg8::EpiU E{U, LDU}; pg8::gemm_phase(lds, g, S, E); }
        GRID_SYNC(); TSTAMP();
        for (int rep = 0; rep < ((DUP & 2) ? 2 : 1); ++rep)
        if (PH & 4) phase_prep(p, l, lds);
        GRID_SYNC(); TSTAMP();
        for (int rep = 0; rep < ((DUP & 4) ? 2 : 1); ++rep) {
        PHASE_FENCE();
        if (PH & 8) { pg8::Gemm g{U + C_CQ, (const bf16_t*)(p->ws + WS_WUQ), T, 1536, 512, LDU, 512}; pg8::StaticOrder S; S.init(T, 1536, G, (int)blockIdx.x);
          pg8::EpiQ E{(bf16_t*)(p->ws + WS_Q), RSQ, (const float*)(p->ws + WS_COS), (const float*)(p->ws + WS_SIN)}; pg8::gemm_phase(lds, g, S, E); }
        PHASE_FENCE();
        if (PH & 1024) { pg8::Gemm g{U + C_CKV, (const bf16_t*)(p->ws + WS_WUK), T, 1024, 256, LDU, 256}; pg8::StaticOrder S; S.init(T, 1024, G, (int)blockIdx.x);
          pg8::EpiRowScale E{(bf16_t*)(p->ws + WS_KN), 1024, RSKV, 1.f}; pg8::gemm_phase(lds, g, S, E); }
        PHASE_FENCE();
        if (PH & 2048) { pg8::Gemm g{(const bf16_t*)(p->ws + WS_WUV), U + C_CKV, 1024, T, 256, 256, LDU}; pg8::StaticOrder S; S.init(1024, T, G, (int)blockIdx.x);
          pg8::EpiColScale E{(bf16_t*)(p->ws + WS_VT), T, RSKV}; pg8::gemm_phase(lds, g, S, E); }
        }
        GRID_SYNC(); TSTAMP();
        if (PH & 16) phase_mix(p, l, lds);
        GRID_SYNC(); TSTAMP();
        if (PH & 32) phase_gn(p, l);
        GRID_SYNC(); TSTAMP();
        for (int rep = 0; rep < (((DUP & 32) && l == 0) ? 2 : 1); ++rep)
        if (PH & 64) { pg8::Gemm g{MIX, (const bf16_t*)(p->ws + WS_WOUT), T, DM, DM, DM, DM}; pg8::StaticOrder S; S.init(T, DM, G, (int)blockIdx.x);
          pg8::EpiU E{XB, DM}; pg8::gemm_phase(lds, g, S, E); }
        GRID_SYNC(); TSTAMP();
        if (PH & 128) phase_ln(p, l, l + 1 < DEPTH);
        if (l + 1 < DEPTH) { if (PH & 1) convert_weights(p, l + 1, lds); GRID_SYNC(); TSTAMP(); }
    }
    if (TPROBE >= 0) {
        if (blockIdx.x == 0 && threadIdx.x == 0) {
            __threadfence();
            const unsigned long long d = tsb[TPROBE + 1] - tsb[TPROBE];
            const unsigned long long t0 = __builtin_amdgcn_s_memrealtime();
            while (__builtin_amdgcn_s_memrealtime() - t0 < 8ull * d) __builtin_amdgcn_s_sleep(8);
        }
        grid.sync();
    }
}

extern "C" void kernel_launch(void* const* d_in, const int* in_sizes, int n_in, void* d_out, int out_size, void* d_ws, size_t ws_size, hipStream_t stream) {
    static int grid = 0;
    if (grid == 0) {
        if (n_in != 21 || ws_size < WS_END) { fprintf(stderr, "kernel_launch: unexpected n_in %d or ws_size %zu (need %zu)\n", n_in, ws_size, (size_t)WS_END); grid = -1; return; }
        int dev = 0, cus = 0, per_cu = 0;
        hipGetDevice(&dev); hipDeviceGetAttribute(&cus, hipDeviceAttributeMultiprocessorCount, dev);
        if (hipFuncSetAttribute((const void*)fwd_megakernel, hipFuncAttributeMaxDynamicSharedMemorySize, LDS_BYTES) != hipSuccess) { fprintf(stderr, "kernel_launch: hipFuncSetAttribute failed\n"); grid = -1; return; }
        if (hipOccupancyMaxActiveBlocksPerMultiprocessor(&per_cu, (const void*)fwd_megakernel, 512, LDS_BYTES) != hipSuccess || per_cu < 1) { fprintf(stderr, "kernel_launch: occupancy query gave %d\n", per_cu); per_cu = 1; }
        (void)hipGetLastError();
        grid = cus * per_cu;
    }
    if (grid < 0) return;
    Params p{};
    p.x = (const float*)d_in[0]; p.pos = (const int*)d_in[1]; p.w_in = (const float*)d_in[2]; p.conv_w = (const float*)d_in[3]; p.q_norm_g = (const float*)d_in[4];
    p.w_uq = (const float*)d_in[5]; p.kv_norm_g = (const float*)d_in[6]; p.w_ukv = (const float*)d_in[7]; p.mu = (const float*)d_in[8]; p.w0 = (const float*)d_in[9];
    p.w2 = (const float*)d_in[10]; p.a0 = (const float*)d_in[11]; p.a2 = (const float*)d_in[12]; p.k_k = (const float*)d_in[13]; p.k_a = (const float*)d_in[14];
    p.r_k = (const float*)d_in[15]; p.gn_g = (const float*)d_in[16]; p.gn_b = (const float*)d_in[17]; p.w_out = (const float*)d_in[18]; p.ln_g = (const float*)d_in[19]; p.ln_b = (const float*)d_in[20];
    p.out = (float*)d_out; p.ws = (unsigned char*)d_ws;
    for (int j = 0; j < 32; ++j) p.inv_freq[j] = (float)pow(10000.0, -(double)(2 * j) / 64.0);
    void* args[] = {&p};
    hipError_t e = hipLaunchCooperativeKernel((const void*)fwd_megakernel, dim3(grid), dim3(512), args, LDS_BYTES, stream);
    if (e != hipSuccess) fprintf(stderr, "cooperative launch failed: %s (grid %d)\n", hipGetErrorString(e), grid);
}
```

```cpp
#include <hip/hip_runtime.h>
#include <hip/hip_cooperative_groups.h>
#include <cstdio>
#include <cstdint>
#include <cmath>
namespace cg = cooperative_groups;

#define LAS __attribute__((address_space(3)))
typedef unsigned short bf16_t;
typedef short bf16x8 __attribute__((ext_vector_type(8)));
typedef short s16x4 __attribute__((ext_vector_type(4)));
typedef float f32x4 __attribute__((ext_vector_type(4)));
typedef float f32x2 __attribute__((ext_vector_type(2)));
typedef float f32x16 __attribute__((ext_vector_type(16)));
typedef unsigned u32x4 __attribute__((ext_vector_type(4)));
typedef unsigned u32x2 __attribute__((ext_vector_type(2)));
typedef __bf16 bf16x2_t __attribute__((ext_vector_type(2)));

constexpr int T = 32768, SEQ = 16384, DM = 2048, NIN = 6080, LDU = 6144, DEPTH = 2;
constexpr int C_CB = 0, C_CC = 512, C_CH = 1024, C_CG = 1536, C_CQ = 2048, C_CKV = 2560, C_KPE = 2816, C_MG = 2880, C_RC = 3904, C_RG = 5568;
constexpr int NHEAD = 8;
constexpr float LN_EPS = 1e-5f, RMS_EPS = 1e-6f, GN_EPS = 64e-5f;
constexpr float ALPHA = 1.4142135623730951f;
constexpr float QSCALE = 0.07216878364870323f * 1.4426950408889634f;

constexpr size_t MiB = 1u << 20;
constexpr size_t WS_CTL = 0, WS_WIN = 1 * MiB, WS_WOUT = 25 * MiB, WS_WUQ = 33 * MiB, WS_WUK = 35 * MiB, WS_WUV = 36 * MiB, WS_RS = 37 * MiB,
                 WS_SC2 = 38 * MiB, WS_COS = 42 * MiB, WS_SIN = 46 * MiB, WS_U = 50 * MiB, WS_MIX = 434 * MiB, WS_XB = 562 * MiB, WS_Q = 562 * MiB,
                 WS_KPE = 658 * MiB, WS_KN = 690 * MiB, WS_VT = 754 * MiB, WS_SCAN = 818 * MiB, WS_END = 1010 * MiB;

constexpr int LDS_BYTES = 131072 + 256, LDS_MISC = 131072;

struct Params {
    const float* x; const int* pos; const float* w_in; const float* conv_w; const float* q_norm_g; const float* w_uq; const float* kv_norm_g; const float* w_ukv;
    const float* mu; const float* w0; const float* w2; const float* a0; const float* a2; const float* k_k; const float* k_a; const float* r_k; const float* gn_g; const float* gn_b;
    const float* w_out; const float* ln_g; const float* ln_b;
    float* out; unsigned char* ws;
    float inv_freq[32];
};

typedef const __attribute__((address_space(4))) Params* KP;
#define KP_FENCE(p) asm volatile("" : "+s"(p))
__device__ __forceinline__ float bf2f(unsigned short v) { return __uint_as_float(((unsigned)v) << 16); }
__device__ __forceinline__ unsigned f2bf(float f) { unsigned u = __float_as_uint(f); return (u + 0x7fffu + ((u >> 16) & 1u)) >> 16; }
__device__ __forceinline__ unsigned pk2(float lo, float hi) { f32x2 v = {lo, hi}; bf16x2_t b = __builtin_convertvector(v, bf16x2_t); return __builtin_bit_cast(unsigned, b); }
__device__ __forceinline__ float max3f(float a, float b, float c) { float r; asm("v_max3_f32 %0, %1, %2, %3" : "=v"(r) : "v"(a), "v"(b), "v"(c)); return r; }
__device__ __forceinline__ float silu_f(float x) { return x * __builtin_amdgcn_rcpf(1.f + __expf(-x)); }
__device__ __forceinline__ float dppf(float v, int ctrl) { return v; }
template <int CTRL> __device__ __forceinline__ float dpp_mov(float v) { return __int_as_float(__builtin_amdgcn_update_dpp(__float_as_int(v), __float_as_int(v), CTRL, 0xf, 0xf, false)); }
__device__ __forceinline__ float row16_sum(float v) {
    v += dpp_mov<0xB1>(v);
    v += dpp_mov<0x4E>(v);
    v += dpp_mov<0x141>(v);
    v += dpp_mov<0x140>(v);
    return v;
}
__device__ __forceinline__ float wave_sum(float v) { v = row16_sum(v); v += __shfl_xor(v, 16); v += __shfl_xor(v, 32); return v; }

#ifndef PH
#define PH 0xffff
#endif
#ifndef TPROBE
#define TPROBE -1
#endif
#ifndef DUP
#define DUP 0
#endif
namespace pg8 {
constexpr int BM = 256, BK = 64, HALF = 128, HTB = HALF * BK * 2, STAGE_BYTES = 8 * HTB, NXCD = 8, WGM = 8;
__host__ __device__ __forceinline__ int lds_byte(int r, int c) { const int st = (r >> 4) * 2 + (c >> 5), rr = r & 15, cc = c & 31, ob = rr * 64 + cc * 2; return st * 1024 + (ob ^ (((ob >> 9) & 1) << 5)); }
__host__ __device__ __forceinline__ void stage_rc(int b, int& R, int& C) { const int st = b / 1024, sb = b % 1024, swz = sb ^ (((sb >> 9) & 1) << 5); R = (st >> 1) * 16 + swz / 64; C = (st & 1) * 32 + (swz % 64) / 2; }
__host__ __device__ __forceinline__ int perm32(int rho) { const int n = rho >> 4, i = rho & 15; return 8 * (i >> 2) + 4 * n + (i & 3); }
struct Unit { int pm, pn; };
struct Gemm { const bf16_t* A; const bf16_t* Bt; int M, N, K, lda, ldb; };
struct StaticOrder {
    int nM, nN, nwg, G, c;
    __device__ void init(int M, int N, int G_, int c_) { nM = M / BM; nN = N / BM; nwg = nM * nN; G = G_; c = c_; }
    __device__ bool next(int i, Unit& u) const {
        const long L = (long)i * G + c; if (L >= nwg) return false;
        int wgid = (int)L; { const int q = nwg / NXCD, r = nwg % NXCD, xcd = wgid % NXCD, off = wgid / NXCD; wgid = (xcd < r ? xcd * (q + 1) : r * (q + 1) + (xcd - r) * q) + off; }
        const int nig = WGM * nN, gid = wgid / nig, fm = gid * WGM, gsz = (nM - fm) < WGM ? (nM - fm) : WGM;
        u.pm = fm + ((wgid % nig) % gsz); u.pn = (wgid % nig) / gsz; return true;
    }
};
template <class Epi>
__device__ __forceinline__ void gemm_phase(LAS unsigned char* lds, const Gemm g, const StaticOrder& S, const Epi& E) {
    int tid = threadIdx.x; asm volatile("" : "+v"(tid));
    const int wid = __builtin_amdgcn_readfirstlane(tid >> 6), lane = tid & 63, wr = wid >> 2, wc = wid & 3, fr = lane & 15, fq = lane >> 4;
    int K = g.K; asm volatile("" : "+s"(K));
    const int nt = K / BK;
    unsigned voffA[2], voffB[2];
#pragma unroll
    for (int i = 0; i < 2; ++i) { int R, C; stage_rc(tid * 16 + i * 8192, R, C); const int Rb = Epi::PERM ? ((R & ~31) + perm32(R & 31)) : R;
        voffA[i] = (unsigned)(R * g.lda + C) * 2u; voffB[i] = (unsigned)(Rb * g.ldb + C) * 2u; }
    const size_t kstep = (size_t)(BK * 2);
    const size_t hstepA = (size_t)HALF * g.lda * 2, hstepB = (size_t)HALF * g.ldb * 2;
    const size_t tstepA = 2 * hstepA, tstepB = 2 * hstepB;
    const unsigned ldsw = (unsigned)wid * 1024u;
    const int aoff = lds_byte(wr * 64 + fr, fq * 8), boff = lds_byte(wc * 32 + fr, fq * 8);
#define PG8_SA(b, h) (((b) * 2 + (h)) * HTB)
#define PG8_SB(b, h) ((4 + (b) * 2 + (h)) * HTB)
#define PG8_STAGE(bufoff, gbase, voff) do { _Pragma("unroll") for (int _i = 0; _i < 2; ++_i) \
        __builtin_amdgcn_global_load_lds((const unsigned*)((const char*)(gbase) + (voff)[_i]), (LAS unsigned*)(lds + (bufoff) + ldsw + _i * 8192), 16, 0, 0); } while (0)
#define PG8_LDA(dst, b, h) do { _Pragma("unroll") for (int m = 0; m < 4; ++m) _Pragma("unroll") for (int k = 0; k < 2; ++k) dst[m][k] = *(const LAS bf16x8*)(lds + PG8_SA(b, h) + aoff + m * 2048 + k * 1024); } while (0)
#define PG8_LDB(dst, b, h) do { _Pragma("unroll") for (int n = 0; n < 2; ++n) _Pragma("unroll") for (int k = 0; k < 2; ++k) dst[n][k] = *(const LAS bf16x8*)(lds + PG8_SB(b, h) + boff + n * 2048 + k * 1024); } while (0)
#define PG8_MMA(ai, bj, At, Bt) do { __builtin_amdgcn_s_setprio(1); _Pragma("unroll") for (int m = 0; m < 4; ++m) _Pragma("unroll") for (int n = 0; n < 2; ++n) _Pragma("unroll") for (int k = 0; k < 2; ++k) \
        acc[ai][bj][m][n] = __builtin_amdgcn_mfma_f32_16x16x32_bf16(Bt[n][k], At[m][k], acc[ai][bj][m][n], 0, 0, 0); __builtin_amdgcn_s_setprio(0); } while (0)
#define PG8_WAIT_V(n) asm volatile("s_waitcnt vmcnt(" #n ")" ::: "memory")
#define PG8_WAIT_L(n) asm volatile("s_waitcnt lgkmcnt(" #n ")" ::: "memory")
#define PG8_BAR __builtin_amdgcn_s_barrier()
#define PG8_SCHED __builtin_amdgcn_sched_barrier(0)
    Unit cur, nxt; int ui = 0;
    if (!S.next(0, cur)) return;
    f32x4 acc[2][2][4][2];
#pragma unroll
    for (int a = 0; a < 2; ++a)
#pragma unroll
        for (int b = 0; b < 2; ++b)
#pragma unroll
            for (int m = 0; m < 4; ++m)
#pragma unroll
                for (int n = 0; n < 2; ++n) acc[a][b][m][n] = (f32x4){0.f, 0.f, 0.f, 0.f};
    bf16x8 At[4][2], B0[2][2], B1[2][2];
    const char* cA = (const char*)g.A + (size_t)cur.pm * tstepA; const char* cB = (const char*)g.Bt + (size_t)cur.pn * tstepB;
    PG8_STAGE(PG8_SB(0, 0), cB, voffB); PG8_STAGE(PG8_SB(0, 1), cB + hstepB, voffB); PG8_STAGE(PG8_SA(0, 0), cA, voffA); PG8_STAGE(PG8_SA(0, 1), cA + hstepA, voffA);
    if (wr == 1) PG8_BAR;
    PG8_WAIT_V(2); PG8_BAR;
    PG8_STAGE(PG8_SB(1, 0), cB + kstep, voffB); PG8_STAGE(PG8_SA(1, 0), cA + kstep, voffA); PG8_STAGE(PG8_SB(1, 1), cB + hstepB + kstep, voffB);
    PG8_WAIT_V(6); PG8_BAR;
    for (;;) {
        const bool has_next = S.next(ui + 1, nxt);
        const char* nA = has_next ? (const char*)g.A + (size_t)nxt.pm * tstepA : cA; const char* nB = has_next ? (const char*)g.Bt + (size_t)nxt.pn * tstepB : cB;
        for (int t = 0; t < nt; t += 2) {
            const bool last = (t == nt - 2);
            const char* a1 = cA + (size_t)(t + 1) * kstep;
            const char* a2 = last ? nA : cA + (size_t)(t + 2) * kstep; const char* b2 = last ? nB : cB + (size_t)(t + 2) * kstep;
            const char* a3 = a2 + kstep; const char* b3 = b2 + kstep;
            PG8_LDB(B0, 0, 0); PG8_LDB(B1, 0, 1); PG8_SCHED; PG8_LDA(At, 0, 0); PG8_STAGE(PG8_SA(1, 1), a1 + hstepA, voffA);
            PG8_WAIT_V(8); PG8_WAIT_L(0); PG8_BAR; PG8_MMA(0, 0, At, B0); PG8_MMA(0, 1, At, B1); PG8_BAR; PG8_SCHED;
            PG8_LDA(At, 0, 1); PG8_STAGE(PG8_SB(0, 0), b2, voffB); PG8_STAGE(PG8_SB(0, 1), b2 + hstepB, voffB); PG8_STAGE(PG8_SA(0, 0), a2, voffA);
            PG8_WAIT_V(8); PG8_WAIT_L(0); PG8_BAR; PG8_MMA(1, 0, At, B0); PG8_MMA(1, 1, At, B1); PG8_BAR; PG8_SCHED;
            PG8_LDB(B0, 1, 0); PG8_LDB(B1, 1, 1); PG8_SCHED; PG8_LDA(At, 1, 0); PG8_STAGE(PG8_SA(0, 1), a2 + hstepA, voffA);
            PG8_WAIT_V(8); PG8_WAIT_L(0); PG8_BAR; PG8_MMA(0, 0, At, B0); PG8_MMA(0, 1, At, B1); PG8_BAR; PG8_SCHED;
            PG8_LDA(At, 1, 1); PG8_STAGE(PG8_SB(1, 0), b3, voffB); PG8_STAGE(PG8_SB(1, 1), b3 + hstepB, voffB); PG8_STAGE(PG8_SA(1, 0), a3, voffA);
            PG8_WAIT_V(8); PG8_WAIT_L(0); PG8_BAR; PG8_MMA(1, 0, At, B0); PG8_MMA(1, 1, At, B1); PG8_BAR; PG8_SCHED;
        }
        if (wr == 0) PG8_BAR;
        E(acc, cur, wr, wc, fr, fq);
        if (!has_next) break;
#pragma unroll
        for (int a = 0; a < 2; ++a)
#pragma unroll
            for (int b = 0; b < 2; ++b)
#pragma unroll
                for (int m = 0; m < 4; ++m)
#pragma unroll
                    for (int n = 0; n < 2; ++n) acc[a][b][m][n] = (f32x4){0.f, 0.f, 0.f, 0.f};
        cur = nxt; cA = nA; cB = nB; ++ui;
        if (wr == 1) PG8_BAR;
    }
    PG8_WAIT_V(0);
    PG8_BAR;
#undef PG8_SA
#undef PG8_SB
#undef PG8_STAGE
#undef PG8_LDA
#undef PG8_LDB
#undef PG8_MMA
#undef PG8_WAIT_V
#undef PG8_WAIT_L
#undef PG8_BAR
#undef PG8_SCHED
}

struct EpiU {
    static constexpr bool PERM = true;
    bf16_t* O; int ldc;
    __device__ __forceinline__ void operator()(const f32x4 (&acc)[2][2][4][2], const Unit& u, int wr, int wc, int fr, int fq) const {
        const int row0 = u.pm * BM + wr * 64 + fr, col0 = u.pn * BM + wc * 32 + 8 * fq;
#pragma unroll
        for (int ai = 0; ai < 2; ++ai)
#pragma unroll
            for (int m = 0; m < 4; ++m) { bf16_t* rowp = O + (size_t)(row0 + ai * HALF + m * 16) * ldc + col0;
#pragma unroll
                for (int bj = 0; bj < 2; ++bj) { const f32x4 v0 = acc[ai][bj][m][0], v1 = acc[ai][bj][m][1];
                    u32x4 w; w.x = pk2(v0[0], v0[1]); w.y = pk2(v0[2], v0[3]); w.z = pk2(v1[0], v1[1]); w.w = pk2(v1[2], v1[3]);
                    *(u32x4*)(rowp + bj * HALF) = w; }
                asm volatile("" ::: "memory"); }
    }
};
struct EpiRowScale {
    static constexpr bool PERM = true;
    bf16_t* O; int ldc; const float* rs; float sc;
    __device__ __forceinline__ void operator()(const f32x4 (&acc)[2][2][4][2], const Unit& u, int wr, int wc, int fr, int fq) const {
        const int row0 = u.pm * BM + wr * 64 + fr, col0 = u.pn * BM + wc * 32 + 8 * fq;
#pragma unroll
        for (int ai = 0; ai < 2; ++ai)
#pragma unroll
            for (int m = 0; m < 4; ++m) { const int row = row0 + ai * HALF + m * 16; const float s = rs[row] * sc; bf16_t* rowp = O + (size_t)row * ldc + col0;
#pragma unroll
                for (int bj = 0; bj < 2; ++bj) { const f32x4 v0 = acc[ai][bj][m][0] * s, v1 = acc[ai][bj][m][1] * s;
                    u32x4 w; w.x = pk2(v0[0], v0[1]); w.y = pk2(v0[2], v0[3]); w.z = pk2(v1[0], v1[1]); w.w = pk2(v1[2], v1[3]);
                    *(u32x4*)(rowp + bj * HALF) = w; }
                asm volatile("" ::: "memory"); }
    }
};
struct EpiQ {
    static constexpr bool PERM = true;
    bf16_t* O; const float* rs; const float* cosT; const float* sinT;
    __device__ __forceinline__ void operator()(const f32x4 (&acc)[2][2][4][2], const Unit& u, int wr, int wc, int fr, int fq) const {
        const int row0 = u.pm * BM + wr * 64 + fr, col0 = u.pn * BM + wc * 32 + 8 * fq;
#pragma unroll
        for (int ai = 0; ai < 2; ++ai)
#pragma unroll
            for (int m = 0; m < 4; ++m) { const int row = row0 + ai * HALF + m * 16; const float s = rs[row] * QSCALE; bf16_t* rowp = O + (size_t)row * 1536 + col0;
#pragma unroll
                for (int bj = 0; bj < 2; ++bj) { f32x4 v0 = acc[ai][bj][m][0] * s, v1 = acc[ai][bj][m][1] * s;
                    const int cin = (col0 + bj * HALF) % 192;
                    if (cin >= 128) { const int j0 = (cin - 128) >> 1;
                        const f32x4 c = *(const f32x4*)(cosT + (size_t)row * 32 + j0), sn = *(const f32x4*)(sinT + (size_t)row * 32 + j0);
                        f32x4 r0, r1;
                        r0[0] = v0[0] * c[0] - v0[1] * sn[0]; r0[1] = v0[1] * c[0] + v0[0] * sn[0];
                        r0[2] = v0[2] * c[1] - v0[3] * sn[1]; r0[3] = v0[3] * c[1] + v0[2] * sn[1];
                        r1[0] = v1[0] * c[2] - v1[1] * sn[2]; r1[1] = v1[1] * c[2] + v1[0] * sn[2];
                        r1[2] = v1[2] * c[3] - v1[3] * sn[3]; r1[3] = v1[3] * c[3] + v1[2] * sn[3];
                        v0 = r0; v1 = r1; }
                    u32x4 w; w.x = pk2(v0[0], v0[1]); w.y = pk2(v0[2], v0[3]); w.z = pk2(v1[0], v1[1]); w.w = pk2(v1[2], v1[3]);
                    *(u32x4*)(rowp + bj * HALF) = w; }
                asm volatile("" ::: "memory"); }
    }
};
struct EpiColScale {
    static constexpr bool PERM = true;
    bf16_t* O; int ldc; const float* cs;
    __device__ __forceinline__ void operator()(const f32x4 (&acc)[2][2][4][2], const Unit& u, int wr, int wc, int fr, int fq) const {
        const int row0 = u.pm * BM + wr * 64 + fr, col0 = u.pn * BM + wc * 32 + 8 * fq;
        const int pos0 = (col0 & ~15) + 4 * ((col0 >> 3) & 1);
        f32x4 sv[2][2];
#pragma unroll
        for (int bj = 0; bj < 2; ++bj)
#pragma unroll
            for (int n = 0; n < 2; ++n) sv[bj][n] = *(const f32x4*)(cs + col0 + bj * HALF + 4 * n);
#pragma unroll
        for (int ai = 0; ai < 2; ++ai)
#pragma unroll
            for (int m = 0; m < 4; ++m) { bf16_t* rowp = O + (size_t)(row0 + ai * HALF + m * 16) * ldc + pos0;
#pragma unroll
                for (int bj = 0; bj < 2; ++bj) { const f32x4 v0 = acc[ai][bj][m][0] * sv[bj][0], v1 = acc[ai][bj][m][1] * sv[bj][1];
                    u32x2 w0, w1; w0.x = pk2(v0[0], v0[1]); w0.y = pk2(v0[2], v0[3]); w1.x = pk2(v1[0], v1[1]); w1.y = pk2(v1[2], v1[3]);
                    *(u32x2*)(rowp + bj * HALF) = w0; *(u32x2*)(rowp + bj * HALF + 8) = w1; }
                asm volatile("" ::: "memory"); }
    }
};
struct EpiResB16 {
    static constexpr bool PERM = true;
    bf16_t* O; const float* res;
    __device__ __forceinline__ void operator()(const f32x4 (&acc)[2][2][4][2], const Unit& u, int wr, int wc, int fr, int fq) const {
        const int row0 = u.pm * BM + wr * 64 + fr, col0 = u.pn * BM + wc * 32 + 8 * fq;
#pragma unroll
        for (int ai = 0; ai < 2; ++ai)
#pragma unroll
            for (int m = 0; m < 4; ++m) { const size_t ro = (size_t)(row0 + ai * HALF + m * 16) * DM + col0;
#pragma unroll
                for (int bj = 0; bj < 2; ++bj) { const f32x4 r0 = *(const f32x4*)(res + ro + bj * HALF), r1 = *(const f32x4*)(res + ro + bj * HALF + 4);
                    const f32x4 v0 = r0 * ALPHA + acc[ai][bj][m][0], v1 = r1 * ALPHA + acc[ai][bj][m][1];
                    u32x4 w; w.x = pk2(v0[0], v0[1]); w.y = pk2(v0[2], v0[3]); w.z = pk2(v1[0], v1[1]); w.w = pk2(v1[2], v1[3]);
                    *(u32x4*)(O + ro + bj * HALF) = w; }
                asm volatile("" ::: "memory"); }
    }
};
struct EpiRes {
    static constexpr bool PERM = false;
    float* C; const float* res;
    __device__ __forceinline__ void operator()(const f32x4 (&acc)[2][2][4][2], const Unit& u, int wr, int wc, int fr, int fq) const {
        const int row0 = u.pm * BM + wr * 64 + fr, col0 = u.pn * BM + wc * 32 + 4 * fq;
#pragma unroll
        for (int ai = 0; ai < 2; ++ai)
#pragma unroll
            for (int m = 0; m < 4; ++m) { const size_t ro = (size_t)(row0 + ai * HALF + m * 16) * DM + col0;
#pragma unroll
                for (int bj = 0; bj < 2; ++bj)
#pragma unroll
                    for (int n = 0; n < 2; ++n) { const f32x4 r = *(const f32x4*)(res + ro + bj * HALF + n * 16);
                        *(f32x4*)(C + ro + bj * HALF + n * 16) = r * ALPHA + acc[ai][bj][m][n]; } }
    }
};
}

__device__ __forceinline__ int wmap_col(int kind, int n) {
    if (kind == 0) return n < NIN ? n : -1;
    if (kind == 1) return n;
    if (kind == 2) { const int h = n / 192, c = n % 192; if (c < 128) return n; const int j = (c - 128) >> 1, e = (c - 128) & 1; return h * 192 + 128 + j + 32 * e; }
    if (kind == 3) { const int h = n >> 7, c = n & 127; return h * 256 + c; }
    { const int h = n >> 7, c = n & 127; return h * 256 + 128 + c; }
}
__device__ __forceinline__ void convert_weights(KP p, int l, LAS unsigned char* lds) {
    KP_FENCE(p);
    int tid = threadIdx.x; asm volatile("" : "+v"(tid));
    const int tx = tid & 63, ty = tid >> 6;
    LAS float* tile = (LAS float*)lds;
    const int nK[5] = {32, 32, 8, 4, 4}, nN[5] = {96, 32, 24, 16, 16};
    const int start1 = nK[0] * nN[0], start2 = start1 + nK[1] * nN[1], start3 = start2 + nK[2] * nN[2], start4 = start3 + nK[3] * nN[3], total = start4 + nK[4] * nN[4];
    for (int it = blockIdx.x; it < total; it += gridDim.x) {
        int kind, loc;
        if (it < start1) { kind = 0; loc = it; } else if (it < start2) { kind = 1; loc = it - start1; } else if (it < start3) { kind = 2; loc = it - start2; }
        else if (it < start4) { kind = 3; loc = it - start3; } else { kind = 4; loc = it - start4; }
        const float* src; bf16_t* dst; const float* g = nullptr; int K, Nsrc, nnt;
        if (kind == 0) { src = p->w_in + (size_t)l * DM * NIN; dst = (bf16_t*)(p->ws + WS_WIN); K = 2048; Nsrc = NIN; nnt = 96; }
        else if (kind == 1) { src = p->w_out + (size_t)l * DM * DM; dst = (bf16_t*)(p->ws + WS_WOUT); K = 2048; Nsrc = DM; nnt = 32; }
        else if (kind == 2) { src = p->w_uq + (size_t)l * 512 * 1536; dst = (bf16_t*)(p->ws + WS_WUQ); K = 512; Nsrc = 1536; nnt = 24; g = p->q_norm_g + l * 512; }
        else if (kind == 3) { src = p->w_ukv + (size_t)l * 256 * 2048; dst = (bf16_t*)(p->ws + WS_WUK); K = 256; Nsrc = 2048; nnt = 16; g = p->kv_norm_g + l * 256; }
        else { src = p->w_ukv + (size_t)l * 256 * 2048; dst = (bf16_t*)(p->ws + WS_WUV); K = 256; Nsrc = 2048; nnt = 16; g = p->kv_norm_g + l * 256; }
        const int n0 = (loc % nnt) * 64, k0 = (loc / nnt) * 64;
        const int sc = wmap_col(kind, n0 + tx);
#pragma unroll
        for (int i = 0; i < 8; ++i) { const int k = k0 + ty * 8 + i; float v = 0.f; if (sc >= 0) v = src[(size_t)k * Nsrc + sc]; if (g) v *= g[k]; tile[(ty * 8 + i) * 65 + tx] = v; }
        __syncthreads();
#pragma unroll
        for (int i = 0; i < 8; ++i) { const int n = n0 + ty * 8 + i; dst[(size_t)n * K + k0 + tx] = (bf16_t)f2bf(tile[tx * 65 + ty * 8 + i]); }
        __syncthreads();
    }
}

__device__ __forceinline__ void phase_p0(KP p, LAS unsigned char* lds) {
    KP_FENCE(p);
    const int tid = threadIdx.x;
    if (blockIdx.x == 0) { unsigned* ctl = (unsigned*)(p->ws + WS_CTL); for (int i = tid; i < 16384; i += 512) ctl[i] = 0u; }
    convert_weights(p, 0, lds);
    bf16_t* xb = (bf16_t*)(p->ws + WS_XB);
    const size_t n4 = (size_t)T * DM / 4;
    const size_t xstr = (size_t)gridDim.x * 512;
    for (size_t i0 = (size_t)blockIdx.x * 512 + tid; i0 < n4; i0 += xstr * 8) {
        f32x4 v[8];
#pragma unroll
        for (int k = 0; k < 8; ++k) v[k] = *(const f32x4*)(p->x + (i0 + k * xstr) * 4);
#pragma unroll
        for (int k = 0; k < 8; ++k) { u32x2 w; w.x = pk2(v[k][0], v[k][1]); w.y = pk2(v[k][2], v[k][3]); *(u32x2*)(xb + (i0 + k * xstr) * 4) = w; } }
    float* cosT = (float*)(p->ws + WS_COS); float* sinT = (float*)(p->ws + WS_SIN);
    for (int i = blockIdx.x * 512 + tid; i < T * 32; i += gridDim.x * 512) {
        const int t = i >> 5, j = i & 31;
        const float ang = (float)p->pos[t] * p->inv_freq[j];
        double rev = (double)ang * 0.15915494309189535; rev -= rint(rev);
        cosT[i] = __builtin_amdgcn_cosf((float)rev); sinT[i] = __builtin_amdgcn_sinf((float)rev);
    }
}

__device__ __forceinline__ void phase_prep(KP p, int l, LAS unsigned char* lds) {
    KP_FENCE(p);
    int tid = threadIdx.x; asm volatile("" : "+v"(tid));
    const int lane = tid & 63, wave = tid >> 6, c = tid;
    const bf16_t* U = (const bf16_t*)(p->ws + WS_U);
    bf16_t* MIX = (bf16_t*)(p->ws + WS_MIX); bf16_t* KPEB = (bf16_t*)(p->ws + WS_KPE); bf16_t* SCAN = (bf16_t*)(p->ws + WS_SCAN);
    float* SC2 = (float*)(p->ws + WS_SC2); float* RSQ = (float*)(p->ws + WS_RS); float* RSKV = RSQ + T;
    const float* cosT = (const float*)(p->ws + WS_COS); const float* sinT = (const float*)(p->ws + WS_SIN);
    LAS float* sth = (LAS float*)lds;
    LAS float* spart = (LAS float*)(lds + 8192);
    f32x2 war[64];
#pragma unroll
    for (int j = 0; j < 64; ++j) { war[j][0] = p->w2[(size_t)l * 64 * 512 + j * 512 + c]; war[j][1] = p->a2[(size_t)l * 64 * 512 + j * 512 + c]; }
    const float* mu = p->mu + l * 1664;
    const float mu_r = mu[c], mu_k = mu[576 + c], mu_v = mu[1088 + c];
    const float w0c = p->w0[l * 512 + c], a0c = p->a0[l * 512 + c], kkc = p->k_k[l * 512 + c], kac = p->k_a[l * 512 + c], rkc = p->r_k[l * 512 + c];
    const float cw0 = p->conv_w[(l * 3 + 0) * 512 + c], cw1 = p->conv_w[(l * 3 + 1) * 512 + c], cw2 = p->conv_w[(l * 3 + 2) * 512 + c];
    for (int tile = blockIdx.x; tile < T / 128; tile += gridDim.x) {
        const int t0 = tile * 128; const bool first = (t0 % SEQ) == 0;
        float pr = 0.f, pk = 0.f, pv = 0.f, pu1 = 0.f, pu2 = 0.f, Gc = 1.f;
        if (!first) { const bf16_t* up = U + (size_t)(t0 - 1) * LDU; pr = bf2f(up[C_RC + c]); pk = bf2f(up[C_RC + 576 + c]); pv = bf2f(up[C_RC + 1088 + c]);
            pu1 = bf2f(up[C_CC + c]) * bf2f(up[C_CH + c]); const bf16_t* up2 = up - LDU; pu2 = bf2f(up2[C_CC + c]) * bf2f(up2[C_CH + c]); }
        const int s_tok0 = tid >> 7, s_jj = tid & 127, s_cr = (s_jj < 64) ? (512 + s_jj) : (1600 + s_jj - 64); const float s_mu = mu[s_cr];
        unsigned short sc_[2], sp_[2];
#define PREP_STAGE_LOAD(tb_) do { _Pragma("unroll") for (int i = 0; i < 2; ++i) { const int t = (tb_) + s_tok0 + 4 * i; \
            sc_[i] = U[(size_t)t * LDU + C_RC + s_cr]; sp_[i] = (t % SEQ) == 0 ? (unsigned short)0 : U[(size_t)(t - 1) * LDU + C_RC + s_cr]; } } while (0)
#define PREP_STAGE_STORE(buf_) do { _Pragma("unroll") for (int i = 0; i < 2; ++i) { const float cur = bf2f(sc_[i]), prev = bf2f(sp_[i]); float xv = cur + (prev - cur) * s_mu; \
            if (s_jj < 64) { const float e = __expf(2.f * xv); xv = 1.f - 2.f * __builtin_amdgcn_rcpf(e + 1.f); } sth[(buf_) * 1024 + (s_tok0 + 4 * i) * 128 + 2 * (s_jj & 63) + (s_jj >> 6)] = xv; } } while (0)
        PREP_STAGE_LOAD(t0); PREP_STAGE_STORE(0);
        __syncthreads();
        for (int sb = 0; sb < 16; ++sb) {
            const int tb = t0 + sb * 8; const LAS float* sthb = sth + (sb & 1) * 1024;
            if (sb + 1 < 16) PREP_STAGE_LOAD(tb + 8);
            unsigned short kx1 = 0, kx2 = 0; float kcs = 0.f, ksn = 0.f;
            if (tid < 256) { const int tok = tid >> 5, j = tid & 31, t = tb + tok; const bf16_t* ur = U + (size_t)t * LDU + C_KPE; kx1 = ur[j]; kx2 = ur[32 + j]; kcs = cosT[t * 32 + j]; ksn = sinT[t * 32 + j]; }
            for (int g4 = 0; g4 < 2; ++g4) {
                unsigned short raw[4][9];
#pragma unroll
                for (int i = 0; i < 4; ++i) { const bf16_t* ur = U + (size_t)(tb + g4 * 4 + i) * LDU;
                    raw[i][0] = ur[C_RC + c]; raw[i][1] = ur[C_RC + 576 + c]; raw[i][2] = ur[C_RC + 1088 + c]; raw[i][3] = ur[C_CB + c]; raw[i][4] = ur[C_CC + c]; raw[i][5] = ur[C_CH + c];
                    raw[i][6] = ur[C_CG + c]; raw[i][7] = ur[C_CQ + c]; raw[i][8] = (c < 256) ? ur[C_CKV + c] : (unsigned short)0; }
#pragma unroll
                for (int i = 0; i < 4; ++i) {
                    const int tok = g4 * 4 + i, t = tb + tok;
                    const float ur_ = bf2f(raw[i][0]), uk_ = bf2f(raw[i][1]), uv_ = bf2f(raw[i][2]);
                    const float cb = bf2f(raw[i][3]), cc = bf2f(raw[i][4]), ch = bf2f(raw[i][5]), cgt = bf2f(raw[i][6]);
                    const float cq = bf2f(raw[i][7]); const float ckv = bf2f(raw[i][8]);
                    const float uc = cc * ch; const float yc = cw0 * pu2 + cw1 * pu1 + cw2 * uc; pu2 = pu1; pu1 = uc;
                    MIX[(size_t)t * DM + c] = (bf16_t)f2bf(cb * yc * silu_f(cgt));
                    const float sq = wave_sum(cq * cq), skv = wave_sum(ckv * ckv);
                    if (lane == 0) { spart[(sb * 8 + tok) * 12 + wave] = sq; if (wave < 4) spart[(sb * 8 + tok) * 12 + 8 + wave] = skv; }
                    const float r = ur_ + (pr - ur_) * mu_r, k = uk_ + (pk - uk_) * mu_k, v = uv_ + (pv - uv_) * mu_v; pr = ur_; pk = uk_; pv = uv_;
                    f32x2 zz0 = {w0c, a0c}, zz1 = {0.f, 0.f};
#pragma unroll
                    for (int j2 = 0; j2 < 32; ++j2) { const f32x4 ta = *(const LAS f32x4*)(sthb + tok * 128 + j2 * 4);
                        const f32x2 x0 = {ta[0], ta[1]}, x1 = {ta[2], ta[3]};
                        zz0 += x0 * war[2 * j2]; zz1 += x1 * war[2 * j2 + 1]; }
                    const float zw = zz0[0] + zz1[0], za = zz0[1] + zz1[1];
                    const float sp = fmaxf(-zw, 0.f) + __logf(1.f + __expf(-fabsf(zw)));
                    const float wlog = -sp - 0.5f; const float dec = __expf(-__expf(wlog));
                    const float asig = __builtin_amdgcn_rcpf(1.f + __expf(-za));
                    const float kkr = k * kkc; const float kk = kkr * __builtin_amdgcn_rsqf(fmaxf(wave_sum(kkr * kkr), 1e-24f));
                    const float k2 = k * (1.f + (asig - 1.f) * kac);
                    const float av = -kk, bv = kk * asig;
                    const float br = wave_sum(bv * r), kr = wave_sum(k2 * r), rkb = wave_sum(r * k2 * rkc);
                    const float Gprev = ((t & 31) == 0) ? 1.f : Gc; Gc = Gprev * dec; const float Ginv = __builtin_amdgcn_rcpf(Gc);
                    bf16_t* so = SCAN + ((size_t)t * 8 + wave) * 384 + lane;
                    *(unsigned*)(so + lane) = pk2(av * Gprev, r * Gc);
                    so[128] = (bf16_t)f2bf(Gc); so[192] = (bf16_t)f2bf(bv * Ginv); so[256] = (bf16_t)f2bf(k2 * Ginv); so[320] = (bf16_t)f2bf(v);
                    if (lane == 0) { f32x4 o4 = {br, kr, rkb, 0.f}; *(f32x4*)(SC2 + ((size_t)t * 8 + wave) * 4) = o4; }
                }
            }
            if (tid < 256) { const int tok = tid >> 5, j = tid & 31, t = tb + tok; const float x1 = bf2f(kx1), x2 = bf2f(kx2);
                *(unsigned*)(KPEB + (size_t)t * 64 + 2 * j) = pk2(x1 * kcs - x2 * ksn, x2 * kcs + x1 * ksn); }
            if (sb + 1 < 16) PREP_STAGE_STORE((sb + 1) & 1);
            __syncthreads();
        }
#undef PREP_STAGE_LOAD
#undef PREP_STAGE_STORE
        if (tid < 128) { float sq = 0.f, skv = 0.f;
#pragma unroll
            for (int w = 0; w < 8; ++w) sq += spart[tid * 12 + w];
#pragma unroll
            for (int w = 0; w < 4; ++w) skv += spart[tid * 12 + 8 + w];
            RSQ[t0 + tid] = rsqrtf(sq * (1.f / 512.f) + RMS_EPS); RSKV[t0 + tid] = rsqrtf(skv * (1.f / 256.f) + RMS_EPS); }
        __syncthreads();
    }
}

namespace att {
constexpr int KNROW = 272, KPROW = 144, VROW = 144, KN_BYTES = 64 * KNROW, KP_BYTES = 64 * KPROW, V_BYTES = 128 * VROW;
constexpr int OFF_KN = 0, OFF_KP = 2 * KN_BYTES, OFF_V = OFF_KP + 2 * KP_BYTES;
constexpr int NI_KN = 17, NI_KP = 9, NI_V = 18, NI_K = NI_KN + NI_KP, NI_ALL = NI_K + NI_V;
__device__ __forceinline__ void unit(KP p, int bh, int qb, LAS unsigned char* lds) {
    KP_FENCE(p);
    int tid = threadIdx.x; asm volatile("" : "+v"(tid));
    const int lane = tid & 63, w = __builtin_amdgcn_readfirstlane(tid >> 6), ql = lane & 31, hi = lane >> 5, grp = w >> 2;
    const int b = bh >> 3, h = bh & 7, q0 = qb * 256;
    const bf16_t* Q = (const bf16_t*)(p->ws + WS_Q); const bf16_t* KN = (const bf16_t*)(p->ws + WS_KN); const bf16_t* KPEB = (const bf16_t*)(p->ws + WS_KPE);
    const bf16_t* VT = (const bf16_t*)(p->ws + WS_VT); const bf16_t* U = (const bf16_t*)(p->ws + WS_U); bf16_t* MIX = (bf16_t*)(p->ws + WS_MIX);
    const int qpos = q0 + 32 * w + ql; const size_t tq = (size_t)b * SEQ + qpos;
    const int wqmin = q0 + 32 * w, wqmax = wqmin + 31;
    bf16x8 qf[12];
    { const bf16_t* qp = Q + tq * 1536 + h * 192 + 8 * hi;
#pragma unroll
      for (int ks = 0; ks < 12; ++ks) qf[ks] = *(const bf16x8*)(qp + 16 * ks); }
    f32x16 o[4];
#pragma unroll
    for (int d = 0; d < 4; ++d)
#pragma unroll
        for (int i = 0; i < 16; ++i) o[d][i] = 0.f;
    f32x16 st0, st1;
#pragma unroll
    for (int i = 0; i < 16; ++i) { st0[i] = 0.f; st1[i] = 0.f; }
    bf16x8 pf[4];
#pragma unroll
    for (int i = 0; i < 4; ++i) pf[i] = (bf16x8){0, 0, 0, 0, 0, 0, 0, 0};
    float mrow = -1e30f, lsum = 0.f;
    const int nj = 4 * (qb + 1);
    int doff[11];
    const bf16_t* kn0 = KN + (size_t)b * SEQ * 1024 + h * 128; const bf16_t* kp0 = KPEB + (size_t)b * SEQ * 64; const bf16_t* vt0 = VT + (size_t)h * 128 * T + (size_t)b * SEQ;
#pragma unroll
    for (int i = 0; i < 11; ++i) { const int n = (w & 3) + 4 * i;
        if (n < NI_KN) { const int ci = 64 * n + lane, row = ci / 17, col = ci % 17; doff[i] = row * 1024 + 8 * (col < 15 ? col : 15); }
        else if (n < NI_K) { const int ci = 64 * (n - NI_KN) + lane, row = ci / 9, col = ci % 9; doff[i] = row * 64 + 8 * (col < 7 ? col : 7); }
        else { const int ci = 64 * (n - NI_K) + lane, row = ci / 9, col = ci % 9; doff[i] = row * T + 8 * (col < 7 ? col : 7); } }
#define ATT_DMA(tk, tv) do { if (grp) { _Pragma("unroll") for (int i = 0; i < 11; ++i) { const int n = (w & 3) + 4 * i; \
        if (n < NI_KN) { if ((tk) >= 0 && (tk) < nj) __builtin_amdgcn_global_load_lds((const unsigned*)(kn0 + (size_t)(tk) * 65536 + doff[i]), (LAS unsigned*)(lds + OFF_KN + ((tk) & 1) * KN_BYTES + n * 1024), 16, 0, 0); } \
        else if (n < NI_K) { if ((tk) >= 0 && (tk) < nj) __builtin_amdgcn_global_load_lds((const unsigned*)(kp0 + (size_t)(tk) * 4096 + doff[i]), (LAS unsigned*)(lds + OFF_KP + ((tk) & 1) * KP_BYTES + (n - NI_KN) * 1024), 16, 0, 0); } \
        else if (n < NI_ALL) { if ((tv) >= 0 && (tv) < nj) __builtin_amdgcn_global_load_lds((const unsigned*)(vt0 + (size_t)(tv) * 64 + doff[i]), (LAS unsigned*)(lds + OFF_V + ((tv) & 1) * V_BYTES + (n - NI_K) * 1024), 16, 0, 0); } } } } while (0)
#define ATT_BAR() do { asm volatile("s_waitcnt lgkmcnt(0)" ::: "memory"); __builtin_amdgcn_s_barrier(); } while (0)
#define ATT_WAITV() asm volatile("s_waitcnt vmcnt(0)" ::: "memory")
#define ATT_SOFTMAX(j_) do { const int kt0 = 64 * (j_); \
        if (kt0 <= wqmax) { \
            if (kt0 + 63 > wqmin) { \
                _Pragma("unroll") for (int i = 0; i < 16; ++i) { const int key = kt0 + 8 * (i >> 2) + 4 * hi + (i & 3); if (key > qpos) st0[i] = -1e30f; if (key + 32 > qpos) st1[i] = -1e30f; } } \
            float mx = max3f(st0[0], st1[0], st0[1]), mx2 = max3f(st1[1], st0[2], st1[2]);     \
            _Pragma("unroll") for (int i = 3; i < 15; i += 2) { mx = max3f(mx, st0[i], st1[i]); mx2 = max3f(mx2, st0[i + 1], st1[i + 1]); } \
            mx = max3f(mx, st0[15], st1[15]); mx = fmaxf(mx, mx2); \
            { const auto sw = __builtin_amdgcn_permlane32_swap(__float_as_uint(mx), __float_as_uint(mx), false, false); mx = fmaxf(__uint_as_float(sw[0]), __uint_as_float(sw[1])); }     \
            const float mnew = fmaxf(mrow, mx); const float alpha = __builtin_amdgcn_exp2f(mrow - mnew); mrow = mnew; \
            float ps = 0.f; \
            _Pragma("unroll") for (int i = 0; i < 16; ++i) { st0[i] = __builtin_amdgcn_exp2f(st0[i] - mnew); st1[i] = __builtin_amdgcn_exp2f(st1[i] - mnew); ps += st0[i] + st1[i]; } \
            lsum = lsum * alpha + ps; \
            if (__builtin_amdgcn_ballot_w64(alpha != 1.f) != 0ull) {     \
                _Pragma("unroll") for (int d = 0; d < 4; ++d) _Pragma("unroll") for (int i = 0; i < 16; ++i) o[d][i] *= alpha; } \
            _Pragma("unroll") for (int s2 = 0; s2 < 2; ++s2) { u32x4 pw; \
                pw.x = pk2(st0[8 * s2 + 0], st0[8 * s2 + 1]); pw.y = pk2(st0[8 * s2 + 2], st0[8 * s2 + 3]); pw.z = pk2(st0[8 * s2 + 4], st0[8 * s2 + 5]); pw.w = pk2(st0[8 * s2 + 6], st0[8 * s2 + 7]); \
                pf[s2] = __builtin_bit_cast(bf16x8, pw); \
                pw.x = pk2(st1[8 * s2 + 0], st1[8 * s2 + 1]); pw.y = pk2(st1[8 * s2 + 2], st1[8 * s2 + 3]); pw.z = pk2(st1[8 * s2 + 4], st1[8 * s2 + 5]); pw.w = pk2(st1[8 * s2 + 6], st1[8 * s2 + 7]); \
                pf[2 + s2] = __builtin_bit_cast(bf16x8, pw); } \
        } } while (0)
#define ATT_PV(j_) do { if (64 * (j_) <= wqmax) { \
            const LAS unsigned char* vb = lds + OFF_V + ((j_) & 1) * V_BYTES + ql * VROW + 16 * hi; \
            bf16x8 vf[5]; \
            _Pragma("unroll") for (int it = 0; it < 4; ++it) vf[it] = *(const LAS bf16x8*)(vb + (it & 3) * 32 * VROW + 32 * (it >> 2)); \
            _Pragma("unroll") for (int it = 0; it < 16; ++it) { const int d = it & 3, s2 = it >> 2;     \
                if (it + 4 < 16) { const int d2 = (it + 4) & 3, s22 = (it + 4) >> 2; vf[(it + 4) % 5] = *(const LAS bf16x8*)(vb + d2 * 32 * VROW + 32 * s22); } \
                o[d] = __builtin_amdgcn_mfma_f32_32x32x16_bf16(vf[it % 5], pf[s2], o[d], 0, 0, 0); \
                __builtin_amdgcn_sched_barrier(0); } \
        } } while (0)
#define ATT_KADDR(ks_) (((ks_) < 8) ? (kb + 32 * (ks_)) : (kpb + 32 * ((ks_) - 8)))
#define ATT_KROWB(ks_) (((ks_) < 8) ? 32 * KNROW : 32 * KPROW)
#define ATT_QK(j_) do { if (64 * (j_) <= wqmax) { \
            const f32x16 zero16 = {0.f, 0.f, 0.f, 0.f, 0.f, 0.f, 0.f, 0.f, 0.f, 0.f, 0.f, 0.f, 0.f, 0.f, 0.f, 0.f}; \
            const LAS unsigned char* kb = lds + OFF_KN + ((j_) & 1) * KN_BYTES + ql * KNROW + 16 * hi; \
            const LAS unsigned char* kpb = lds + OFF_KP + ((j_) & 1) * KP_BYTES + ql * KPROW + 16 * hi; \
            bf16x8 kf0[3], kf1[3]; \
            kf0[0] = *(const LAS bf16x8*)(ATT_KADDR(0)); kf1[0] = *(const LAS bf16x8*)(ATT_KADDR(0) + ATT_KROWB(0)); \
            kf0[1] = *(const LAS bf16x8*)(ATT_KADDR(1)); kf1[1] = *(const LAS bf16x8*)(ATT_KADDR(1) + ATT_KROWB(1)); \
            _Pragma("unroll") for (int ks = 0; ks < 12; ++ks) { \
                if (ks + 2 < 12) { kf0[(ks + 2) % 3] = *(const LAS bf16x8*)(ATT_KADDR(ks + 2)); kf1[(ks + 2) % 3] = *(const LAS bf16x8*)(ATT_KADDR(ks + 2) + ATT_KROWB(ks + 2)); } \
                st0 = __builtin_amdgcn_mfma_f32_32x32x16_bf16(kf0[ks % 3], qf[ks], ks == 0 ? zero16 : st0, 0, 0, 0);     \
                st1 = __builtin_amdgcn_mfma_f32_32x32x16_bf16(kf1[ks % 3], qf[ks], ks == 0 ? zero16 : st1, 0, 0, 0); \
                __builtin_amdgcn_sched_barrier(0); } \
        } } while (0)
    ATT_DMA(0, -1);
    ATT_WAITV();
    __builtin_amdgcn_s_barrier();
    if (grp == 0) {
        ATT_DMA(1, 0); ATT_QK(0); ATT_BAR();
        for (int j = 0; j < nj; ++j) {
            ATT_SOFTMAX(j); ATT_WAITV(); ATT_BAR();
            ATT_DMA(j + 2, j + 1); ATT_PV(j); if (j + 1 < nj) ATT_QK(j + 1); ATT_BAR();
        }
        ATT_WAITV(); ATT_BAR();
    } else {
        ATT_DMA(1, 0); ATT_BAR();
        for (int j = 0; j < nj; ++j) {
            if (j >= 1) ATT_PV(j - 1); ATT_QK(j); ATT_WAITV(); ATT_BAR();
            ATT_DMA(j + 2, j + 1); ATT_SOFTMAX(j); ATT_BAR();
        }
        ATT_PV(nj - 1); ATT_WAITV(); ATT_BAR();
    }
#undef ATT_SOFTMAX
#undef ATT_PV
#undef ATT_QK
#undef ATT_KADDR
#undef ATT_KROWB
#undef ATT_BAR
#undef ATT_WAITV
#undef ATT_DMA
    const float ltot = lsum + __shfl_xor(lsum, 32); const float inv = 1.f / ltot;
    const bf16_t* gp = U + tq * LDU + C_MG + h * 128; bf16_t* op = MIX + tq * DM + 512 + h * 128;
    u32x2 gwv[16];
#pragma unroll
    for (int d = 0; d < 4; ++d)
#pragma unroll
        for (int g4 = 0; g4 < 4; ++g4) gwv[d * 4 + g4] = *(const u32x2*)(gp + 32 * d + 8 * g4 + 4 * hi);
#pragma unroll
    for (int d = 0; d < 4; ++d)
#pragma unroll
        for (int g4 = 0; g4 < 4; ++g4) { const int dv0 = 32 * d + 8 * g4 + 4 * hi;
            const u32x2 gw = gwv[d * 4 + g4];
            const float g0 = __uint_as_float(gw.x << 16), g1 = __uint_as_float(gw.x & 0xffff0000u), g2 = __uint_as_float(gw.y << 16), g3 = __uint_as_float(gw.y & 0xffff0000u);
            u32x2 ow; ow.x = pk2(o[d][4 * g4 + 0] * inv * silu_f(g0), o[d][4 * g4 + 1] * inv * silu_f(g1)); ow.y = pk2(o[d][4 * g4 + 2] * inv * silu_f(g2), o[d][4 * g4 + 3] * inv * silu_f(g3));
            *(u32x2*)(op + dv0) = ow; }
}
}

namespace scan {
constexpr int CT = 32;
constexpr int RW = 16;
constexpr int IN_BYTES = CT * 6 * 64 * 4;
constexpr int OFF_IN = 0, OFF_SC2 = 2 * IN_BYTES, OFF_Y = OFF_SC2 + 2 * CT * 8, Y_BYTES = CT * RW * 4;
__device__ __forceinline__ void run(KP p, int wg, LAS unsigned char* lds) {
    KP_FENCE(p);
    int tid = threadIdx.x; asm volatile("" : "+v"(tid));
    const int lane = tid & 63, w = __builtin_amdgcn_readfirstlane(tid >> 6);
    const int bh = (wg & 7) + 8 * (wg >> 5), part = (wg >> 3) & 3, b = bh >> 3, h = bh & 7;
    const bf16_t* SCAN = (const bf16_t*)(p->ws + WS_SCAN); const float* SC2 = (const float*)(p->ws + WS_SC2); bf16_t* MIX = (bf16_t*)(p->ws + WS_MIX);
    const int nch = SEQ / CT;
    const bool stager = (w >= 4); const int stid = tid - 256;
    const int rg = lane >> 4, kq = lane & 15; const int rl = 4 * (w & 3) + rg;
    f32x4 s0 = {0.f, 0.f, 0.f, 0.f};
    u32x4 ld[6]; f32x2 ld2 = {0.f, 0.f};
#define SC_GLOAD(c) do { const size_t tb = (size_t)b * SEQ + (size_t)(c) * CT; \
        _Pragma("unroll") for (int i = 0; i < 6; ++i) { const int idx = stid + 256 * i, tok = idx / 48, pt = idx % 48; ld[i] = *(const u32x4*)(SCAN + ((tb + tok) * 8 + h) * 384 + 8 * pt); } \
        if (stid < CT) ld2 = *(const f32x2*)(SC2 + ((tb + stid) * 8 + h) * 4); } while (0)
#define SC_LSTORE(c) do { const int bo = OFF_IN + ((c) & 1) * IN_BYTES; \
        _Pragma("unroll") for (int i = 0; i < 6; ++i) { const int idx = stid + 256 * i, tok = idx / 48, pt = idx % 48; \
            f32x4 lo = {__uint_as_float(ld[i].x << 16), __uint_as_float(ld[i].x & 0xffff0000u), __uint_as_float(ld[i].y << 16), __uint_as_float(ld[i].y & 0xffff0000u)}; \
            f32x4 hi4 = {__uint_as_float(ld[i].z << 16), __uint_as_float(ld[i].z & 0xffff0000u), __uint_as_float(ld[i].w << 16), __uint_as_float(ld[i].w & 0xffff0000u)}; \
            const int o_lo = (pt < 16) ? pt * 4 : pt * 8, o_hi = (pt < 16) ? 64 + pt * 4 : pt * 8 + 4;     \
            *(LAS f32x4*)(lds + bo + (tok * 384 + o_lo) * 4) = lo; *(LAS f32x4*)(lds + bo + (tok * 384 + o_hi) * 4) = hi4; } \
        if (stid < CT) *(LAS f32x2*)(lds + OFF_SC2 + ((c) & 1) * CT * 8 + stid * 8) = ld2; } while (0)
#define SC_YOUT(c) do { const size_t tb = (size_t)b * SEQ + (size_t)(c) * CT; const int tok = stid >> 3, r2 = (stid & 7) * 2; \
        const f32x2 y2 = *(const LAS f32x2*)(lds + OFF_Y + ((c) & 1) * Y_BYTES + (tok * RW + r2) * 4); \
        *(unsigned*)(MIX + (tb + tok) * DM + 1536 + h * 64 + RW * part + r2) = pk2(y2[0], y2[1]); } while (0)
    if (stager) { SC_GLOAD(0); SC_LSTORE(0); }
    __syncthreads();
    for (int c = 0; c < nch; ++c) {
        if (stager) {
            if (c + 1 < nch) SC_GLOAD(c + 1);
            if (c >= 1) SC_YOUT(c - 1);
            if (c + 1 < nch) SC_LSTORE(c + 1);
        } else {
            const LAS unsigned char* ib = lds + OFF_IN + (c & 1) * IN_BYTES;
            const LAS unsigned char* pa = ib + kq * 16;
            const LAS unsigned char* pw = ib + 512 + kq * 16;
            const LAS unsigned char* pv = ib + (320 + RW * part + rl) * 4;
            const LAS unsigned char* sb = lds + OFF_SC2 + (c & 1) * CT * 8;
            LAS unsigned char* yb = lds + OFF_Y + (c & 1) * Y_BYTES + rl * 4;
            f32x4 aw01 = *(const LAS f32x4*)(pa), aw23 = *(const LAS f32x4*)(pa + 256), b4 = *(const LAS f32x4*)(pw + 256), k4 = *(const LAS f32x4*)(pw + 512);
            float v1 = *(const LAS float*)(pv); f32x2 bk = *(const LAS f32x2*)(sb);
            for (int blk = 0; blk < CT / 16; ++blk) {
                float yk0 = 0.f;
#pragma unroll
                for (int j = 0; j < 16; ++j) {
                    const int tok = blk * 16 + j, tn = (tok + 1 < CT) ? tok + 1 : tok;
                    const f32x4 naw01 = *(const LAS f32x4*)(pa + tn * 1536), naw23 = *(const LAS f32x4*)(pa + tn * 1536 + 256),
                                nb4 = *(const LAS f32x4*)(pw + tn * 1536 + 256), nk4 = *(const LAS f32x4*)(pw + tn * 1536 + 512);
                    const float nv1 = *(const LAS float*)(pv + tn * 1536); const f32x2 nbk = *(const LAS f32x2*)(sb + tn * 8);
                    const f32x2 a0 = {aw01[0], aw01[1]}, a1 = {aw01[2], aw01[3]}, a2 = {aw23[0], aw23[1]}, a3 = {aw23[2], aw23[3]};
                    const f32x2 pqa = a0 * s0[0] + a1 * s0[1], pqb = a2 * s0[2] + a3 * s0[3];
                    const f32x2 pq0 = pqa + pqb;
                    const f32x4 e0 = s0 + k4 * v1;
                    float p0 = pq0[0], q0 = pq0[1];
                    asm volatile("s_nop 1\n\t"
                        "v_add_f32_dpp %0, %0, %0 quad_perm:[1,0,3,2] row_mask:0xf bank_mask:0xf\n\t"
                        "v_add_f32_dpp %1, %1, %1 quad_perm:[1,0,3,2] row_mask:0xf bank_mask:0xf\n\t"
                        "s_nop 0\n\t"
                        "v_add_f32_dpp %0, %0, %0 quad_perm:[2,3,0,1] row_mask:0xf bank_mask:0xf\n\t"
                        "v_add_f32_dpp %1, %1, %1 quad_perm:[2,3,0,1] row_mask:0xf bank_mask:0xf\n\t"
                        "s_nop 0\n\t"
                        "v_add_f32_dpp %0, %0, %0 row_half_mirror row_mask:0xf bank_mask:0xf\n\t"
                        "v_add_f32_dpp %1, %1, %1 row_half_mirror row_mask:0xf bank_mask:0xf\n\t"
                        "s_nop 0\n\t"
                        "v_add_f32_dpp %0, %0, %0 row_mirror row_mask:0xf bank_mask:0xf\n\t"
                        "v_add_f32_dpp %1, %1, %1 row_mirror row_mask:0xf bank_mask:0xf\n\t"
                        "s_nop 1"
                        : "+v"(p0), "+v"(q0));
                    s0 = e0 + b4 * p0;
                    const float y0 = q0 + p0 * bk[0] + v1 * bk[1];
                    yk0 = (kq == j) ? y0 : yk0;
                    aw01 = naw01; aw23 = naw23; b4 = nb4; k4 = nk4; v1 = nv1; bk = nbk;
                }
                *(LAS float*)(yb + (blk * 16 + kq) * (RW * 4)) = yk0;
            }
            s0 = s0 * *(const LAS f32x4*)(pw + (CT - 1) * 1536);
        }
        __syncthreads();
    }
    if (stager) SC_YOUT(nch - 1);
#undef SC_GLOAD
#undef SC_LSTORE
#undef SC_YOUT
    __syncthreads();
}
}

constexpr int N_SCAN_WG = 64, N_ATT_UNITS = 1024;
__device__ __forceinline__ void phase_mix(KP p, int l, LAS unsigned char* lds) {
    KP_FENCE(p);
    if ((PH & 256) && (int)blockIdx.x < N_SCAN_WG) { scan::run(p, blockIdx.x, lds); if (DUP & 8) scan::run(p, blockIdx.x, lds); }
    LAS int* qword = (LAS int*)(lds + LDS_MISC);
    for (int rep = 0; rep < ((DUP & 16) ? 2 : 1); ++rep) {
    unsigned* ctr = (unsigned*)(p->ws + WS_CTL) + l + 2 * rep;
    for (;;) {
        if (threadIdx.x == 0) *qword = (int)atomicAdd(ctr, 1u);
        __syncthreads();
        const int n = *qword;
        __syncthreads();
        if (n >= N_ATT_UNITS) break;
        if (PH & 512) att::unit(p, n & 15, 63 - (n >> 4), lds);
    }
    }
}

__device__ __forceinline__ void phase_gn(KP p, int l) {
    KP_FENCE(p);
    int tid = threadIdx.x; asm volatile("" : "+v"(tid));
    const int lane = tid & 63, wave = tid >> 6, c = tid;
    bf16_t* MIX = (bf16_t*)(p->ws + WS_MIX); const bf16_t* U = (const bf16_t*)(p->ws + WS_U); const bf16_t* SCAN = (const bf16_t*)(p->ws + WS_SCAN); const float* SC2 = (const float*)(p->ws + WS_SC2);
    const float g = p->gn_g[l * 512 + c], bta = p->gn_b[l * 512 + c];
    for (int t0 = blockIdx.x * 8; t0 < T; t0 += gridDim.x * 8) {
        unsigned short yr[8], vr[8], gr[8]; float rk[8];
#pragma unroll
        for (int i = 0; i < 8; ++i) { const size_t t = t0 + i; yr[i] = MIX[t * DM + 1536 + c]; vr[i] = SCAN[(t * 8 + wave) * 384 + 320 + lane]; rk[i] = SC2[(t * 8 + wave) * 4 + 2]; gr[i] = U[t * LDU + C_RG + c]; }
#pragma unroll
        for (int i = 0; i < 8; ++i) { const size_t t = t0 + i; const float y = bf2f(yr[i]);
            const float mean = wave_sum(y) * (1.f / 64.f); const float d = y - mean; const float var = wave_sum(d * d) * (1.f / 64.f);
            const float yn = d * rsqrtf(var + GN_EPS) * g + bta + rk[i] * bf2f(vr[i]);
            MIX[t * DM + 1536 + c] = (bf16_t)f2bf(yn * silu_f(bf2f(gr[i]))); }
    }
}

__device__ __forceinline__ void phase_ln(KP p, int l, bool write_xb) {
    KP_FENCE(p);
    const float* res = (l == 0) ? p->x : p->out;
    int tid = threadIdx.x; asm volatile("" : "+v"(tid));
    const int lane = tid & 63, wave = tid >> 6;
    bf16_t* xb = (bf16_t*)(p->ws + WS_XB);
    f32x4 g[8], bb[8];
#pragma unroll
    for (int i = 0; i < 8; ++i) { g[i] = *(const f32x4*)(p->ln_g + l * DM + (i * 64 + lane) * 4); bb[i] = *(const f32x4*)(p->ln_b + l * DM + (i * 64 + lane) * 4); }
    const int rstr = gridDim.x * 8;
    int row = blockIdx.x * 8 + wave;
    u32x2 vn[8];
#pragma unroll
    for (int i = 0; i < 8; ++i) vn[i] = *(const u32x2*)(xb + (size_t)row * DM + (i * 64 + lane) * 4);
    f32x4 rn[8];
#pragma unroll
    for (int i = 0; i < 8; ++i) rn[i] = *(const f32x4*)(res + (size_t)row * DM + (i * 64 + lane) * 4);
    for (; row < T; row += rstr) {
        float* rp = p->out + (size_t)row * DM;
        f32x4 v[8]; float s = 0.f;
#pragma unroll
        for (int i = 0; i < 8; ++i) { v[i][0] = __uint_as_float(vn[i].x << 16); v[i][1] = __uint_as_float(vn[i].x & 0xffff0000u); v[i][2] = __uint_as_float(vn[i].y << 16); v[i][3] = __uint_as_float(vn[i].y & 0xffff0000u);
            v[i] = rn[i] * ALPHA + v[i]; s += v[i][0] + v[i][1] + v[i][2] + v[i][3]; }
        if (row + rstr < T) {
#pragma unroll
            for (int i = 0; i < 8; ++i) { vn[i] = *(const u32x2*)(xb + (size_t)(row + rstr) * DM + (i * 64 + lane) * 4); rn[i] = *(const f32x4*)(res + (size_t)(row + rstr) * DM + (i * 64 + lane) * 4); }
        }
        const float mean = wave_sum(s) * (1.f / DM);
        float q = 0.f;
#pragma unroll
        for (int i = 0; i < 8; ++i) { v[i] = v[i] - mean; q += v[i][0] * v[i][0] + v[i][1] * v[i][1] + v[i][2] * v[i][2] + v[i][3] * v[i][3]; }
        const float rstd = rsqrtf(wave_sum(q) * (1.f / DM) + LN_EPS);
#pragma unroll
        for (int i = 0; i < 8; ++i) { const f32x4 y = v[i] * rstd * g[i] + bb[i]; *(f32x4*)(rp + (i * 64 + lane) * 4) = y;
            if (write_xb) { u32x2 wv; wv.x = pk2(y[0], y[1]); wv.y = pk2(y[2], y[3]); *(u32x2*)(xb + (size_t)row * DM + (i * 64 + lane) * 4) = wv; } }
    }
}

#define XB_TMO      128
#define XB_XCNT(j)  (256  + 64 * (j))
#define XB_XSUB(j)  (1280 + 64 * (j))
#define XB_XGEN(j)  (2304 + 64 * (j))
#define XB_TOP      3328
#define XB_TOPGEN   3392
#define XCD_BAR_WORDS 3456
#define XB_SPIN_CAP (1u << 22)
constexpr int CW_BAR = 4096;
__device__ __forceinline__ unsigned xb_ld(unsigned* p)              { return __hip_atomic_load(p, __ATOMIC_RELAXED, __HIP_MEMORY_SCOPE_AGENT); }
__device__ __forceinline__ unsigned xb_add(unsigned* p, unsigned v) { return __hip_atomic_fetch_add(p, v, __ATOMIC_RELAXED, __HIP_MEMORY_SCOPE_AGENT); }
__device__ __forceinline__ unsigned xb_xcc_id() { return (unsigned)__builtin_amdgcn_s_getreg((3 << 11) | 20) & 0xFu; }
#define XB_SPIN(cond, bar) do { unsigned _sp = 0; while (cond) { __builtin_amdgcn_s_sleep(1); \
    if ((++_sp & 255u) == 0u) { if (xb_ld(&(bar)[XB_TMO])) break; if (_sp > XB_SPIN_CAP) { atomicAdd(&(bar)[XB_TMO], 1u); break; } } } } while (0)
struct XcdBarrier { unsigned* bar; unsigned x; volatile LAS unsigned* st; };
__device__ __forceinline__ XcdBarrier xcd_barrier_post(unsigned* bar, volatile LAS unsigned* st) {
    XcdBarrier b; b.bar = bar; b.x = xb_xcc_id(); b.st = st;
    if (threadIdx.x == 0) (void)xb_add(&bar[XB_XCNT(b.x)], 1u);
    return b;
}
__device__ __forceinline__ void xcd_barrier_complete(unsigned* bar, unsigned x, unsigned& nloc, unsigned& nx) {
    const unsigned G = gridDim.x * gridDim.y * gridDim.z;
    unsigned sum, cnt, mine, sp = 0u;
    for (;;) {
        sum = 0u; cnt = 0u; mine = 0u;
#pragma unroll
        for (unsigned j = 0; j < 16; ++j) { const unsigned c = xb_ld(&bar[XB_XCNT(j)]); sum += c; cnt += (c > 0u) ? 1u : 0u; mine = (j == x) ? c : mine; }
        if (sum == G) break;
        __builtin_amdgcn_s_sleep(1);
        if ((++sp & 255u) == 0u) { if (xb_ld(&bar[XB_TMO])) break; if (sp > XB_SPIN_CAP) { atomicAdd(&bar[XB_TMO], 1u); break; } }
    }
    nloc = mine > 0u ? mine : 1u; nx = cnt > 0u ? cnt : 1u;
}
__device__ __forceinline__ void xcd_barrier(const XcdBarrier& b) {
    asm volatile("s_waitcnt vmcnt(0)" ::: "memory");
    __syncthreads();
    if (threadIdx.x == 0) {
        unsigned* bar = b.bar;
        __builtin_amdgcn_s_waitcnt(0);
        unsigned nloc = b.st[0], nx = b.st[1];
        if (nloc == 0u) { xcd_barrier_complete(bar, b.x, nloc, nx); b.st[0] = nloc; b.st[1] = nx; }
        const unsigned old = xb_add(&bar[XB_XSUB(b.x)], 1u);
        const unsigned gen = old / nloc;
        if (old + 1u == (gen + 1u) * nloc) {
            __builtin_amdgcn_fence(__ATOMIC_RELEASE, "agent");
            asm volatile("s_waitcnt vmcnt(0)" ::: "memory");
            const unsigned og = xb_add(&bar[XB_TOP], 1u);
            const unsigned tg = og / nx;
            if (og + 1u == (tg + 1u) * nx) xb_add(&bar[XB_TOPGEN], 1u);
            else XB_SPIN(xb_ld(&bar[XB_TOPGEN]) == tg, bar);
            __builtin_amdgcn_fence(__ATOMIC_ACQUIRE, "agent");
            xb_add(&bar[XB_XGEN(b.x)], 1u);
            asm volatile("s_waitcnt vmcnt(0)" ::: "memory");
        } else {
            XB_SPIN(xb_ld(&bar[XB_XGEN(b.x)]) == gen, bar);
            __builtin_amdgcn_fence(__ATOMIC_ACQUIRE, "agent");
            asm volatile("s_waitcnt vmcnt(0)" ::: "memory");
        }
    }
    __syncthreads();
}

#define PHASE_FENCE() do { __builtin_amdgcn_sched_barrier(0); asm volatile("" ::: "memory"); __syncthreads(); __builtin_amdgcn_sched_barrier(0); } while (0)
__global__ void __launch_bounds__(512, 2) fwd_megakernel(Params p_in) {
    KP p = (KP)__builtin_amdgcn_kernarg_segment_ptr();
    extern __shared__ __attribute__((aligned(16))) unsigned char smem[];
    LAS unsigned char* lds = (LAS unsigned char*)smem;
    cg::grid_group grid = cg::this_grid();
    const int G = gridDim.x;
    bf16_t* U = (bf16_t*)(p->ws + WS_U); bf16_t* XB = (bf16_t*)(p->ws + WS_XB); bf16_t* MIX = (bf16_t*)(p->ws + WS_MIX);
    float* RSQ = (float*)(p->ws + WS_RS); float* RSKV = RSQ + T;

    unsigned long long* tsb = (unsigned long long*)(p->ws + WS_CTL + 1024);
    int nts = 0;
#define TSTAMP() do { if (TPROBE >= 0) { if (blockIdx.x == 0 && threadIdx.x == 0) tsb[nts] = __builtin_amdgcn_s_memrealtime(); ++nts; } } while (0)
    TSTAMP();
    if (threadIdx.x < 2) ((volatile LAS unsigned*)(lds + LDS_MISC + 32))[threadIdx.x] = 0u;
    __syncthreads();
    if (PH & 1) phase_p0(p, lds);
    grid.sync(); TSTAMP();
    const XcdBarrier xbar = xcd_barrier_post((unsigned*)(p->ws + WS_CTL) + CW_BAR, (volatile LAS unsigned*)(lds + LDS_MISC + 32));
#define GRID_SYNC() xcd_barrier(xbar)
    for (int l = 0; l < DEPTH; ++l) {
        for (int rep = 0; rep < ((DUP & 1) ? 2 : 1); ++rep)
        if (PH & 2) { pg8::Gemm g{XB, (const bf16_t*)(p->ws + WS_WIN), T, LDU, DM, DM, DM}; pg8::StaticOrder S; S.init(T, LDU, G, (int)blockIdx.x);
          pg8::EpiU E{U, LDU}; pg8::gemm_phase(lds, g, S, E); }
        GRID_SYNC(); TSTAMP();
        for (int rep = 0; rep < ((DUP & 2) ? 2 : 1); ++rep)
        if (PH & 4) phase_prep(p, l, lds);
        GRID_SYNC(); TSTAMP();
        for (int rep = 0; rep < ((DUP & 4) ? 2 : 1); ++rep) {
        PHASE_FENCE();
        if (PH & 8) { pg8::Gemm g{U + C_CQ, (const bf16_t*)(p->ws + WS_WUQ), T, 1536, 512, LDU, 512}; pg8::StaticOrder S; S.init(T, 1536, G, (int)blockIdx.x);
          pg8::EpiQ E{(bf16_t*)(p->ws + WS_Q), RSQ, (const float*)(p->ws + WS_COS), (const float*)(p->ws + WS_SIN)}; pg8::gemm_phase(lds, g, S, E); }
        PHASE_FENCE();
        if (PH & 1024) { pg8::Gemm g{U + C_CKV, (const bf16_t*)(p->ws + WS_WUK), T, 1024, 256, LDU, 256}; pg8::StaticOrder S; S.init(T, 1024, G, (int)blockIdx.x);
          pg8::EpiRowScale E{(bf16_t*)(p->ws + WS_KN), 1024, RSKV, 1.f}; pg8::gemm_phase(lds, g, S, E); }
        PHASE_FENCE();
        if (PH & 2048) { pg8::Gemm g{(const bf16_t*)(p->ws + WS_WUV), U + C_CKV, 1024, T, 256, 256, LDU}; pg8::StaticOrder S; S.init(1024, T, G, (int)blockIdx.x);
          pg8::EpiColScale E{(bf16_t*)(p->ws + WS_VT), T, RSKV}; pg8::gemm_phase(lds, g, S, E); }
        }
        GRID_SYNC(); TSTAMP();
        if (PH & 16) phase_mix(p, l, lds);
        GRID_SYNC(); TSTAMP();
        if (PH & 32) phase_gn(p, l);
        GRID_SYNC(); TSTAMP();
        for (int rep = 0; rep < (((DUP & 32) && l == 0) ? 2 : 1); ++rep)
        if (PH & 64) { pg8::Gemm g{MIX, (const bf16_t*)(p->ws + WS_WOUT), T, DM, DM, DM, DM}; pg8::StaticOrder S; S.init(T, DM, G, (int)blockIdx.x);
          pg8::EpiU E{XB, DM}; pg8::gemm_phase(lds, g, S, E); }
        GRID_SYNC(); TSTAMP();
        if (PH & 128) phase_ln(p, l, l + 1 < DEPTH);
        if (l + 1 < DEPTH) { if (PH & 1) convert_weights(p, l + 1, lds); GRID_SYNC(); TSTAMP(); }
    }
    if (TPROBE >= 0) {
        if (blockIdx.x == 0 && threadIdx.x == 0) {
            __threadfence();
            const unsigned long long d = tsb[TPROBE + 1] - tsb[TPROBE];
            const unsigned long long t0 = __builtin_amdgcn_s_memrealtime();
            while (__builtin_amdgcn_s_memrealtime() - t0 < 8ull * d) __builtin_amdgcn_s_sleep(8);
        }
        grid.sync();
    }
}

extern "C" void kernel_launch(void* const* d_in, const int* in_sizes, int n_in, void* d_out, int out_size, void* d_ws, size_t ws_size, hipStream_t stream) {
    static int grid = 0;
    if (grid == 0) {
        if (n_in != 21 || ws_size < WS_END) { fprintf(stderr, "kernel_launch: unexpected n_in %d or ws_size %zu (need %zu)\n", n_in, ws_size, (size_t)WS_END); grid = -1; return; }
        int dev = 0, cus = 0, per_cu = 0;
        hipGetDevice(&dev); hipDeviceGetAttribute(&cus, hipDeviceAttributeMultiprocessorCount, dev);
        if (hipFuncSetAttribute((const void*)fwd_megakernel, hipFuncAttributeMaxDynamicSharedMemorySize, LDS_BYTES) != hipSuccess) { fprintf(stderr, "kernel_launch: hipFuncSetAttribute failed\n"); grid = -1; return; }
        if (hipOccupancyMaxActiveBlocksPerMultiprocessor(&per_cu, (const void*)fwd_megakernel, 512, LDS_BYTES) != hipSuccess || per_cu < 1) { fprintf(stderr, "kernel_launch: occupancy query gave %d\n", per_cu); per_cu = 1; }
        (void)hipGetLastError();
        grid = cus * per_cu;
    }
    if (grid < 0) return;
    Params p{};
    p.x = (const float*)d_in[0]; p.pos = (const int*)d_in[1]; p.w_in = (const float*)d_in[2]; p.conv_w = (const float*)d_in[3]; p.q_norm_g = (const float*)d_in[4];
    p.w_uq = (const float*)d_in[5]; p.kv_norm_g = (const float*)d_in[6]; p.w_ukv = (const float*)d_in[7]; p.mu = (const float*)d_in[8]; p.w0 = (const float*)d_in[9];
    p.w2 = (const float*)d_in[10]; p.a0 = (const float*)d_in[11]; p.a2 = (const float*)d_in[12]; p.k_k = (const float*)d_in[13]; p.k_a = (const float*)d_in[14];
    p.r_k = (const float*)d_in[15]; p.gn_g = (const float*)d_in[16]; p.gn_b = (const float*)d_in[17]; p.w_out = (const float*)d_in[18]; p.ln_g = (const float*)d_in[19]; p.ln_b = (const float*)d_in[20];
    p.out = (float*)d_out; p.ws = (unsigned char*)d_ws;
    for (int j = 0; j < 32; ++j) p.inv_freq[j] = (float)pow(10000.0, -(double)(2 * j) / 64.0);
    void* args[] = {&p};
    hipError_t e = hipLaunchCooperativeKernel((const void*)fwd_megakernel, dim3(grid), dim3(512), args, LDS_BYTES, stream);
    if (e != hipSuccess) fprintf(stderr, "cooperative launch failed: %s (grid %d)\n", hipGetErrorString(e), grid);
}
```
